# Optimizing an MI355X kernel written in HIP

```python
import jax, jax.numpy as jnp
from jax import lax
import numpy as np

D_MODEL = 1024
BATCH = 4
SEQ = 4096
DEPTH = 1

MEM_LEN = 256
RET_WIDTH = D_MODEL // 2
RET_HEADS = 4
RET_DK = RET_WIDTH // RET_HEADS
RET_DV = RET_WIDTH // RET_HEADS
SB_WIDTH = D_MODEL - RET_WIDTH
SB_HEADS = 8
SB_DH = SB_WIDTH // SB_HEADS
MIX_WIDTH = RET_WIDTH + SB_WIDTH
IN_COLS = 4 * RET_WIDTH + 3 * SB_WIDTH
X_HEADS = 4
X_DH = D_MODEL // X_HEADS
D_FF = 4 * D_MODEL
CHUNK = 128
Q_BLOCK = 128
ROPE_BASE = 10000.0
EPS = 1e-6

kernel_name = "hybrid_retention_stickbreaking_block"


def rms_norm(t, gain):
    tf = t.astype(jnp.float32)
    return tf * lax.rsqrt(jnp.mean(tf * tf, axis=-1, keepdims=True) + EPS) * gain.astype(jnp.float32)


def split_heads(t, n_heads):
    b, s, _ = t.shape
    return t.reshape(b, s, n_heads, -1).transpose(0, 2, 1, 3)


def merge_heads(t):
    b, h, s, d = t.shape
    return t.transpose(0, 2, 1, 3).reshape(b, s, h * d)


def rotary(t, positions):
    d = t.shape[-1]
    inv_freq = ROPE_BASE ** (-jnp.arange(0, d, 2, dtype=jnp.float32) / d)
    ang = positions.astype(jnp.float32)[:, None, :, None] * inv_freq
    cos, sin = jnp.cos(ang), jnp.sin(ang)
    tf = t.astype(jnp.float32)
    t1, t2 = tf[..., : d // 2], tf[..., d // 2:]
    return jnp.concatenate([t1 * cos - t2 * sin, t2 * cos + t1 * sin], axis=-1)


def chunkwise_retention(q, k, v):
    b, h, s, dk = q.shape
    dv = v.shape[-1]
    n_chunks = s // CHUNK
    log_gamma = jnp.log1p(-(2.0 ** (-5.0 - jnp.arange(h, dtype=jnp.float32))))
    idx = jnp.arange(CHUNK, dtype=jnp.float32)
    rel = idx[:, None] - idx[None, :]
    causal = rel >= 0
    decay_in = jnp.where(causal, jnp.exp(log_gamma[:, None, None] * jnp.where(causal, rel, 0.0)), 0.0)
    q_decay = jnp.exp(log_gamma[:, None] * (idx + 1.0))
    k_decay = jnp.exp(log_gamma[:, None] * (CHUNK - 1.0 - idx))
    chunk_decay = jnp.exp(log_gamma * CHUNK)

    def to_chunks(t):
        return t.astype(jnp.float32).reshape(b, h, n_chunks, CHUNK, -1).transpose(2, 0, 1, 3, 4)

    qc, kc, vc = to_chunks(q), to_chunks(k), to_chunks(v)

    def step(state, inp):
        qi, ki, vi = inp
        scores = jnp.einsum('bhqd,bhkd->bhqk', qi, ki) * decay_in
        out = (jnp.einsum('bhqk,bhkv->bhqv', scores, vi)
               + jnp.einsum('bhqd,bhdv->bhqv', qi * q_decay[None, :, :, None], state))
        state = (state * chunk_decay[None, :, None, None]
                 + jnp.einsum('bhkd,bhkv->bhdv', ki * k_decay[None, :, :, None], vi))
        return state, out

    state0 = jnp.zeros((b, h, dk, dv), jnp.float32)
    _, out = lax.scan(step, state0, (qc, kc, vc))
    return out.transpose(1, 2, 0, 3, 4).reshape(b, h, s, dv)


def stick_breaking_attention(q, k, v):
    b, h, s, d = q.shape
    scale = d ** -0.5
    n_blocks = s // Q_BLOCK
    qb = q.astype(jnp.float32).reshape(b, h, n_blocks, Q_BLOCK, d).transpose(2, 0, 1, 3, 4)
    kf = k.astype(jnp.float32)
    vf = v.astype(jnp.float32)
    kpos = jnp.arange(s)

    def block(args):
        qi, start = args
        z = jnp.einsum('bhqd,bhkd->bhqk', qi, kf) * scale
        qpos = start + jnp.arange(Q_BLOCK)
        mask = kpos[None, :] < qpos[:, None]
        log_beta = jax.nn.log_sigmoid(z)
        log_one_minus = jnp.where(mask, jax.nn.log_sigmoid(-z), 0.0)
        tail = lax.cumsum(log_one_minus, axis=3, reverse=True) - log_one_minus
        w = jnp.where(mask, jnp.exp(log_beta + tail), 0.0)
        return jnp.einsum('bhqk,bhkd->bhqd', w, vf)

    starts = jnp.arange(n_blocks, dtype=jnp.int32) * Q_BLOCK
    out = lax.map(block, (qb, starts))
    return out.transpose(1, 2, 0, 3, 4).reshape(b, h, s, d)


def setup_inputs(seed: int = 0) -> dict:
    key = jax.random.key(seed)
    ks = jax.random.split(key, 20)

    def w(k, shape, fan_in):
        return jax.random.normal(k, shape, jnp.float32) * (fan_in ** -0.5)

    def gain(k, shape):
        return 1.0 + 0.02 * jax.random.normal(k, shape, jnp.float32)

    x = jax.random.normal(ks[0], (BATCH, SEQ, D_MODEL), jnp.float32)
    mem = jax.random.normal(ks[1], (BATCH, MEM_LEN, D_MODEL), jnp.float32)
    offset = jax.random.randint(ks[2], (BATCH,), 0, 1024, dtype=jnp.int32)
    positions = (offset[:, None] + jnp.arange(SEQ, dtype=jnp.int32)[None, :]).astype(jnp.int32)
    return {
        "x": x,
        "mem": mem,
        "positions": positions,
        "g_mix": gain(ks[3], (DEPTH, D_MODEL)),
        "w_in": w(ks[4], (DEPTH, D_MODEL, IN_COLS), D_MODEL),
        "ret_gn_g": gain(ks[5], (DEPTH, RET_HEADS, RET_DV)),
        "sb_q_g": gain(ks[6], (DEPTH, SB_HEADS, SB_DH)),
        "sb_k_g": gain(ks[7], (DEPTH, SB_HEADS, SB_DH)),
        "w_out": w(ks[8], (DEPTH, MIX_WIDTH, D_MODEL), MIX_WIDTH),
        "g_xattn": gain(ks[9], (DEPTH, D_MODEL)),
        "g_mem": gain(ks[10], (DEPTH, D_MODEL)),
        "w_xq": w(ks[11], (DEPTH, D_MODEL, D_MODEL), D_MODEL),
        "w_xkv": w(ks[12], (DEPTH, D_MODEL, 2 * D_MODEL), D_MODEL),
        "xq_g": gain(ks[13], (DEPTH, X_HEADS, X_DH)),
        "xk_g": gain(ks[14], (DEPTH, X_HEADS, X_DH)),
        "w_xo": w(ks[15], (DEPTH, D_MODEL, D_MODEL), D_MODEL),
        "g_mlp": gain(ks[16], (DEPTH, D_MODEL)),
        "w_up": w(ks[17], (DEPTH, D_MODEL, D_FF), D_MODEL),
        "w_down": w(ks[18], (DEPTH, D_FF, D_MODEL), D_FF),
    }


def reference(x, mem, positions, g_mix, w_in, ret_gn_g, sb_q_g, sb_k_g, w_out,
              g_xattn, g_mem, w_xq, w_xkv, xq_g, xk_g, w_xo, g_mlp, w_up, w_down):
    R, S = RET_WIDTH, SB_WIDTH
    for layer in range(DEPTH):
        h = rms_norm(x, g_mix[layer])
        proj = h @ w_in[layer].astype(jnp.float32)
        rq, rk, rv, rg, sq, sk, sv = jnp.split(
            proj, [R, 2 * R, 3 * R, 4 * R, 4 * R + S, 4 * R + 2 * S], axis=-1)

        rq = rotary(split_heads(rq, RET_HEADS), positions)
        rk = rotary(split_heads(rk, RET_HEADS), positions) * (RET_DK ** -0.5)
        ro = chunkwise_retention(rq, rk, split_heads(rv, RET_HEADS))
        ro = rms_norm(ro, ret_gn_g[layer][None, :, None, :])
        ro = merge_heads(ro) * jax.nn.silu(rg)

        sq = rms_norm(split_heads(sq, SB_HEADS), sb_q_g[layer][None, :, None, :])
        sk = rms_norm(split_heads(sk, SB_HEADS), sb_k_g[layer][None, :, None, :])
        so = merge_heads(stick_breaking_attention(sq, sk, split_heads(sv, SB_HEADS)))

        mix = jnp.concatenate([ro, so], axis=-1)
        x = x + (mix @ w_out[layer].astype(jnp.float32)).astype(x.dtype)

        hx = rms_norm(x, g_xattn[layer])
        m = rms_norm(mem, g_mem[layer])
        xq = rms_norm(split_heads(hx @ w_xq[layer].astype(jnp.float32), X_HEADS),
                      xq_g[layer][None, :, None, :])
        xk, xv = jnp.split(m @ w_xkv[layer].astype(jnp.float32), 2, axis=-1)
        xk = rms_norm(split_heads(xk, X_HEADS), xk_g[layer][None, :, None, :])
        xv = split_heads(xv, X_HEADS)
        scores = jnp.einsum('bhqd,bhkd->bhqk', xq, xk) * (X_DH ** -0.5)
        probs = jax.nn.softmax(scores, axis=-1)
        xo = merge_heads(jnp.einsum('bhqk,bhkd->bhqd', probs, xv))
        x = x + (xo @ w_xo[layer].astype(jnp.float32)).astype(x.dtype)

        hm = rms_norm(x, g_mlp[layer])
        up = jnp.square(jax.nn.relu(hm @ w_up[layer].astype(jnp.float32)))
        x = x + (up @ w_down[layer].astype(jnp.float32)).astype(x.dtype)
    return x
```

```cpp
#include <hip/hip_runtime.h>
#include <stdint.h>
#include <cstdio>

#define LAS __attribute__((address_space(3)))
#define GAS __attribute__((address_space(1)))
typedef unsigned short bf16;
typedef short bf16x8 __attribute__((ext_vector_type(8)));
typedef float f32x4 __attribute__((ext_vector_type(4)));
typedef unsigned u32x4 __attribute__((ext_vector_type(4)));
typedef unsigned u32x2 __attribute__((ext_vector_type(2)));
typedef GAS unsigned gu32;

#ifndef MK_N_LAUNCHES
#define MK_N_LAUNCHES 1
#endif
constexpr int NPHASE = 9;
constexpr int NWAVES = 8, NTHR = 512;

constexpr int BATCH = 4, SEQ = 4096, DM = 1024, M = BATCH * SEQ;
constexpr int NIN = 3584, FF = 4096, MEML = 256, MROWS = BATCH * MEML;
constexpr int C_RQ = 0, C_RK = 512, C_RV = 1024, C_RG = 1536, C_SQ = 2048, C_SK = 2560, C_SV = 3072;
constexpr float EPS = 1e-6f;

constexpr size_t MiB = 1u << 20;
constexpr size_t WS_CTL = 0, CTL_ZERO_BYTES = 64 * 1024;
constexpr size_t WS_WIN = 1 * MiB, WS_WOUT = 8 * MiB, WS_WXQ = 10 * MiB, WS_WXKV = 12 * MiB, WS_WXO = 16 * MiB, WS_WUP = 18 * MiB, WS_WDN = 26 * MiB;
constexpr size_t WS_RINV1 = 34 * MiB, WS_RINVM = 34 * MiB + 64 * 1024, WS_SSQ2 = 34 * MiB + 128 * 1024, WS_SSQ3 = 34 * MiB + 384 * 1024;
constexpr size_t WS_MEMB = 35 * MiB, WS_MEMK = 37 * MiB, WS_MEMV = 39 * MiB;
constexpr size_t WS_ROPE = 41 * MiB;
constexpr size_t WS_XB = 49 * MiB, WS_MIX = 49 * MiB;
constexpr size_t WS_PROJ = 81 * MiB;
constexpr size_t WS_X1B = 81 * MiB, WS_XQ = 113 * MiB, WS_XO = 145 * MiB;
constexpr size_t WS_KV = 193 * MiB, WS_X2B = 193 * MiB;
constexpr size_t WS_HID = 49 * MiB;
constexpr size_t WS_END = 225 * MiB;

constexpr int LDS_BYTES = 147456;
constexpr int MISC_OFF = 144 * 1024 - 256;

__device__ const double INVF[64] = {1.0, 0.8659643233600653, 0.7498942093324559, 0.6493816315762113, 0.5623413251903491, 0.4869675251658631, 0.4216965034285822, 0.3651741272548377, 0.31622776601683794, 0.27384196342643613, 0.23713737056616552, 0.2053525026457146, 0.1778279410038923, 0.1539926526059492, 0.1333521432163324, 0.11547819846894582, 0.1, 0.08659643233600653, 0.07498942093324558, 0.06493816315762113, 0.05623413251903491, 0.04869675251658631, 0.042169650342858224, 0.03651741272548377, 0.03162277660168379, 0.027384196342643614, 0.023713737056616554, 0.02053525026457146, 0.01778279410038923, 0.01539926526059492, 0.01333521432163324, 0.011547819846894581, 0.01, 0.008659643233600654, 0.007498942093324558, 0.006493816315762113, 0.005623413251903491, 0.004869675251658631, 0.004216965034285823, 0.003651741272548377, 0.0031622776601683794, 0.0027384196342643613, 0.0023713737056616554, 0.002053525026457146, 0.0017782794100389228, 0.001539926526059492, 0.001333521432163324, 0.0011547819846894581, 0.001, 0.0008659643233600654, 0.0007498942093324559, 0.0006493816315762113, 0.0005623413251903491, 0.0004869675251658631, 0.00042169650342858224, 0.0003651741272548377, 0.00031622776601683794, 0.0002738419634264361, 0.00023713737056616554, 0.0002053525026457146, 0.00017782794100389227, 0.0001539926526059492, 0.0001333521432163324, 0.00011547819846894582};

__device__ __forceinline__ float bflo(unsigned u) { return __uint_as_float(u << 16); }
__device__ __forceinline__ float bfhi(unsigned u) { return __uint_as_float(u & 0xffff0000u); }
__device__ __forceinline__ float bf2f(bf16 v) { return __uint_as_float(((unsigned)v) << 16); }
__device__ __forceinline__ unsigned f2bf(float f) { unsigned u = __float_as_uint(f); return (u + 0x7fffu + ((u >> 16) & 1u)) >> 16; }
__device__ __forceinline__ unsigned pk2(float lo, float hi) { return f2bf(lo) | (f2bf(hi) << 16); }
__device__ __forceinline__ float wave_sum(float v) {
#pragma unroll
    for (int o = 1; o < 64; o <<= 1) v += __shfl_xor(v, o);
    return v;
}
__device__ __forceinline__ float wave_max(float v) {
#pragma unroll
    for (int o = 1; o < 64; o <<= 1) v = fmaxf(v, __shfl_xor(v, o));
    return v;
}
#define CBAR() asm volatile("" ::: "memory")

#define XB_TMO      128
#define XB_XCNT(j)  (256  + 64 * (j))
#define XB_XSUB(j)  (1280 + 64 * (j))
#define XB_XGEN(j)  (2304 + 64 * (j))
#define XB_TOP      3328
#define XB_TOPGEN   3392
#define XCD_BAR_WORDS 3456
#define XB_SPIN_CAP (1u << 22)
__device__ __forceinline__ unsigned xb_ld(unsigned* p)              { return __hip_atomic_load(p, __ATOMIC_RELAXED, __HIP_MEMORY_SCOPE_AGENT); }
__device__ __forceinline__ unsigned xb_add(unsigned* p, unsigned v) { return __hip_atomic_fetch_add(p, v, __ATOMIC_RELAXED, __HIP_MEMORY_SCOPE_AGENT); }
__device__ __forceinline__ unsigned xb_xcc_id() { return (unsigned)__builtin_amdgcn_s_getreg((3 << 11) | 20) & 0xFu; }
#define XB_SPIN(cond, bar) do { unsigned _sp = 0; while (cond) { __builtin_amdgcn_s_sleep(1); \
    if ((++_sp & 255u) == 0u) { if (xb_ld(&(bar)[XB_TMO])) break; if (_sp > XB_SPIN_CAP) { atomicAdd(&(bar)[XB_TMO], 1u); break; } } } } while (0)
struct XcdBarrier { unsigned* bar; unsigned x; volatile LAS unsigned* st; };
__device__ __forceinline__ XcdBarrier xcd_barrier_post(unsigned* bar, volatile LAS unsigned* st) {
    XcdBarrier b; b.bar = bar; b.x = xb_xcc_id(); b.st = st;
    if (threadIdx.x == 0) (void)xb_add(&bar[XB_XCNT(b.x)], 1u);
    return b;
}
__device__ __forceinline__ void xcd_barrier_complete(unsigned* bar, unsigned x, unsigned& nloc, unsigned& nx) {
    const unsigned G = gridDim.x * gridDim.y * gridDim.z;
    unsigned sum, cnt, mine, sp = 0u;
    for (;;) {
        sum = 0u; cnt = 0u; mine = 0u;
#pragma unroll
        for (unsigned j = 0; j < 16; ++j) { const unsigned c = xb_ld(&bar[XB_XCNT(j)]); sum += c; cnt += (c > 0u) ? 1u : 0u; mine = (j == x) ? c : mine; }
        if (sum == G) break;
        __builtin_amdgcn_s_sleep(1);
        if ((++sp & 255u) == 0u) { if (xb_ld(&bar[XB_TMO])) break; if (sp > XB_SPIN_CAP) { atomicAdd(&bar[XB_TMO], 1u); break; } }
    }
    nloc = mine > 0u ? mine : 1u; nx = cnt > 0u ? cnt : 1u;
}
__device__ __forceinline__ void xcd_barrier(const XcdBarrier& b) {
    asm volatile("s_waitcnt vmcnt(0)" ::: "memory");
    __syncthreads();
    if (threadIdx.x == 0) {
        unsigned* bar = b.bar;
        __builtin_amdgcn_s_waitcnt(0);
        unsigned nloc = b.st[0], nx = b.st[1];
        if (nloc == 0u) { xcd_barrier_complete(bar, b.x, nloc, nx); b.st[0] = nloc; b.st[1] = nx; }
        const unsigned old = xb_add(&bar[XB_XSUB(b.x)], 1u);
        const unsigned gen = old / nloc;
        if (old + 1u == (gen + 1u) * nloc) {
            __builtin_amdgcn_fence(__ATOMIC_RELEASE, "agent");
            asm volatile("s_waitcnt vmcnt(0)" ::: "memory");
            const unsigned og = xb_add(&bar[XB_TOP], 1u);
            const unsigned tg = og / nx;
            if (og + 1u == (tg + 1u) * nx) xb_add(&bar[XB_TOPGEN], 1u);
            else XB_SPIN(xb_ld(&bar[XB_TOPGEN]) == tg, bar);
            __builtin_amdgcn_fence(__ATOMIC_ACQUIRE, "agent");
            xb_add(&bar[XB_XGEN(b.x)], 1u);
            asm volatile("s_waitcnt vmcnt(0)" ::: "memory");
        } else {
            XB_SPIN(xb_ld(&bar[XB_XGEN(b.x)]) == gen, bar);
            __builtin_amdgcn_fence(__ATOMIC_ACQUIRE, "agent");
            asm volatile("s_waitcnt vmcnt(0)" ::: "memory");
        }
    }
    __syncthreads();
}

struct Args { const void* in[19]; float* out; unsigned char* ws; int ph_lo, ph_hi, li, pad; };
struct Frame {
    LAS unsigned char* lds;
    int tid, lane, wave, G, bid;
    const float *x, *mem; const int* pos;
    const float *g_mix, *w_in, *ret_gn_g, *sb_q_g, *sb_k_g, *w_out, *g_xattn, *g_mem, *w_xq, *w_xkv, *xq_g, *xk_g, *w_xo, *g_mlp, *w_up, *w_down;
    float* out; unsigned char* ws;
};

__device__ void conv_weight(const Frame& F, const float* W, const float* g, bf16* Wt, int K, int N) {
    LAS float* T = (LAS float*)F.lds;
    const int tk = K / 64, tn = N / 64, nt = tk * tn;
    for (int t = F.bid; t < nt; t += F.G) {
        const int k0 = (t / tn) * 64, n0 = (t % tn) * 64;
        __syncthreads();
#pragma unroll
        for (int i = 0; i < 2; ++i) {
            const int r = (F.tid >> 4) + 32 * i, c = (F.tid & 15) * 4;
            f32x4 v = *(const f32x4*)(W + (size_t)(k0 + r) * N + n0 + c);
            const float gg = g ? g[k0 + r] : 1.f;
            T[r * 65 + c + 0] = v[0] * gg; T[r * 65 + c + 1] = v[1] * gg; T[r * 65 + c + 2] = v[2] * gg; T[r * 65 + c + 3] = v[3] * gg;
        }
        __syncthreads();
#pragma unroll
        for (int i = 0; i < 2; ++i) {
            const int n = (F.tid >> 4) + 32 * i, k = (F.tid & 15) * 4;
            u32x2 o; o[0] = pk2(T[(k + 0) * 65 + n], T[(k + 1) * 65 + n]); o[1] = pk2(T[(k + 2) * 65 + n], T[(k + 3) * 65 + n]);
            *(u32x2*)(Wt + (size_t)(n0 + n) * K + k0 + k) = o;
        }
    }
    __syncthreads();
}
__device__ void rows_prep(const Frame& F, const float* X, bf16* Xb, float* rinv, int rows) {
    const int gw = F.bid * NWAVES + F.wave, GW = F.G * NWAVES;
    for (int r = gw; r < rows; r += GW) {
        float ss = 0.f;
#pragma unroll
        for (int i = 0; i < 4; ++i) {
            const int c = i * 256 + F.lane * 4;
            f32x4 v = *(const f32x4*)(X + (size_t)r * DM + c);
            ss += v[0] * v[0] + v[1] * v[1] + v[2] * v[2] + v[3] * v[3];
            u32x2 o; o[0] = pk2(v[0], v[1]); o[1] = pk2(v[2], v[3]);
            *(u32x2*)(Xb + (size_t)r * DM + c) = o;
        }
        ss = wave_sum(ss);
        if (F.lane == 0) rinv[r] = rsqrtf(ss * (1.f / DM) + EPS);
    }
}
__device__ void rope_table(const Frame& F, float2* cs) {
    const int total = M * 64;
    for (int e = F.bid * NTHR + F.tid; e < total; e += F.G * NTHR) {
        const int row = e >> 6, j = e & 63;
        const double ang = (double)F.pos[row] * INVF[j];
        const double rev = ang * 0.15915494309189535;
        const float fr = (float)(rev - floor(rev));
        float2 o; o.x = __builtin_amdgcn_cosf(fr); o.y = __builtin_amdgcn_sinf(fr);
        cs[e] = o;
    }
}

constexpr int LDA_S = 72, LDC_S = 260;
template <class Epi>
__device__ void gemm_phase(const Frame& F, const bf16* A, const bf16* Bt, int Mr, int N, int K, const Epi& E) {
    const int tid = F.tid, lane = F.lane, wave = F.wave;
    const int wr = wave >> 2, wc = wave & 3;
    const int nN = N / 256, nU = (Mr / 128) * nN, nk = K / 64;
    LAS bf16* As = (LAS bf16*)F.lds;
    LAS bf16* Bs = (LAS bf16*)(F.lds + 128 * LDA_S * 2);
    LAS float* Cs = (LAS float*)F.lds;
    const int lr = tid >> 3, lc = (tid & 7) * 8;
    for (int u = F.bid; u < nU; u += F.G) {
        const int pm = u / nN, pn = u % nN;
        const bf16* Ag = A + (size_t)(pm * 128 + lr) * K + lc;
        const bf16* Bg = Bt + (size_t)(pn * 256 + lr) * K + lc;
        f32x4 acc[4][4];
#pragma unroll
        for (int i = 0; i < 4; ++i)
#pragma unroll
            for (int j = 0; j < 4; ++j) acc[i][j] = (f32x4){0.f, 0.f, 0.f, 0.f};
        u32x4 ra[2], rb[4];
#pragma unroll
        for (int i = 0; i < 2; ++i) ra[i] = *(const u32x4*)(Ag + (size_t)(64 * i) * K);
#pragma unroll
        for (int i = 0; i < 4; ++i) rb[i] = *(const u32x4*)(Bg + (size_t)(64 * i) * K);
        for (int kt = 0; kt < nk; ++kt) {
            __syncthreads();
#pragma unroll
            for (int i = 0; i < 2; ++i) *(LAS u32x4*)(As + (lr + 64 * i) * LDA_S + lc) = ra[i];
#pragma unroll
            for (int i = 0; i < 4; ++i) *(LAS u32x4*)(Bs + (lr + 64 * i) * LDA_S + lc) = rb[i];
            __syncthreads();
            if (kt + 1 < nk) {
#pragma unroll
                for (int i = 0; i < 2; ++i) ra[i] = *(const u32x4*)(Ag + (size_t)(64 * i) * K + (kt + 1) * 64);
#pragma unroll
                for (int i = 0; i < 4; ++i) rb[i] = *(const u32x4*)(Bg + (size_t)(64 * i) * K + (kt + 1) * 64);
            }
#pragma unroll
            for (int kk = 0; kk < 2; ++kk) {
                bf16x8 a[4], b[4];
#pragma unroll
                for (int i = 0; i < 4; ++i) a[i] = *(LAS bf16x8*)(As + (wr * 64 + i * 16 + (lane & 15)) * LDA_S + kk * 32 + (lane >> 4) * 8);
#pragma unroll
                for (int j = 0; j < 4; ++j) b[j] = *(LAS bf16x8*)(Bs + (wc * 64 + j * 16 + (lane & 15)) * LDA_S + kk * 32 + (lane >> 4) * 8);
#pragma unroll
                for (int i = 0; i < 4; ++i)
#pragma unroll
                    for (int j = 0; j < 4; ++j) acc[i][j] = __builtin_amdgcn_mfma_f32_16x16x32_bf16(a[i], b[j], acc[i][j], 0, 0, 0);
            }
        }
        __syncthreads();
#pragma unroll
        for (int i = 0; i < 4; ++i)
#pragma unroll
            for (int j = 0; j < 4; ++j)
#pragma unroll
                for (int r = 0; r < 4; ++r) Cs[(wr * 64 + i * 16 + (lane >> 4) * 4 + r) * LDC_S + wc * 64 + j * 16 + (lane & 15)] = acc[i][j][r];
        __syncthreads();
        for (int rr = 0; rr < 16; ++rr) {
            const int row = wave * 16 + rr;
            f32x4 v = *(LAS f32x4*)(Cs + row * LDC_S + lane * 4);
            E(v, pm * 128 + row, pn, lane);
        }
    }
    __syncthreads();
}

struct EpiInProj {
    bf16* proj; const float* rinv1; const float2* cs; const float* sb_q_g; const float* sb_k_g;
    __device__ __forceinline__ void operator()(f32x4 v, int gr, int pn, int lane) const {
        const int col0 = pn * 256, seg = col0 >> 9;
        const float s = rinv1[gr];
        v = v * s;
        if (seg <= 1) {
            f32x4 p; p[0] = __shfl_xor(v[0], 16); p[1] = __shfl_xor(v[1], 16); p[2] = __shfl_xor(v[2], 16); p[3] = __shfl_xor(v[3], 16);
            const int jj = (4 * lane) & 63;
            const bool first = (lane & 16) == 0;
            const float sc = (seg == 1) ? 0.08838834764831845f : 1.f;
            const float2* c = cs + (size_t)gr * 64 + jj;
#pragma unroll
            for (int e = 0; e < 4; ++e) { const float2 t = c[e]; const float o = first ? (v[e] * t.x - p[e] * t.y) : (v[e] * t.x + p[e] * t.y); v[e] = o * sc; }
        } else if (seg == 4 || seg == 5) {
            float ss = v[0] * v[0] + v[1] * v[1] + v[2] * v[2] + v[3] * v[3];
            ss += __shfl_xor(ss, 1); ss += __shfl_xor(ss, 2); ss += __shfl_xor(ss, 4); ss += __shfl_xor(ss, 8);
            const float inv = rsqrtf(ss * (1.f / 64.f) + EPS);
            const float* g = (seg == 4 ? sb_q_g : sb_k_g) + (col0 - seg * 512) + 4 * lane;
            v[0] *= inv * g[0]; v[1] *= inv * g[1]; v[2] *= inv * g[2]; v[3] *= inv * g[3];
        }
        u32x2 o; o[0] = pk2(v[0], v[1]); o[1] = pk2(v[2], v[3]);
        *(u32x2*)(proj + (size_t)gr * NIN + col0 + 4 * lane) = o;
    }
};
struct EpiMemKV {
    bf16* memk; bf16* memv; const float* rinvm; const float* xk_g;
    __device__ __forceinline__ void operator()(f32x4 v, int gr, int pn, int lane) const {
        v = v * rinvm[gr];
        if (pn < 4) {
            float ss = wave_sum(v[0] * v[0] + v[1] * v[1] + v[2] * v[2] + v[3] * v[3]);
            const float inv = rsqrtf(ss * (1.f / 256.f) + EPS);
            const float* g = xk_g + pn * 256 + 4 * lane;
            v[0] *= inv * g[0]; v[1] *= inv * g[1]; v[2] *= inv * g[2]; v[3] *= inv * g[3];
            u32x2 o; o[0] = pk2(v[0], v[1]); o[1] = pk2(v[2], v[3]);
            *(u32x2*)(memk + (size_t)gr * DM + pn * 256 + 4 * lane) = o;
        } else {
            u32x2 o; o[0] = pk2(v[0], v[1]); o[1] = pk2(v[2], v[3]);
            *(u32x2*)(memv + (size_t)gr * DM + (pn - 4) * 256 + 4 * lane) = o;
        }
    }
};
struct EpiResid {
    const float* resid; float* out; bf16* xb; float* ssq;
    __device__ __forceinline__ void operator()(f32x4 v, int gr, int pn, int lane) const {
        const size_t o = (size_t)gr * DM + pn * 256 + 4 * lane;
        const f32x4 r = *(const f32x4*)(resid + o);
        v = v + r;
        *(f32x4*)(out + o) = v;
        u32x2 w; w[0] = pk2(v[0], v[1]); w[1] = pk2(v[2], v[3]);
        *(u32x2*)(xb + o) = w;
        const float ss = wave_sum(v[0] * v[0] + v[1] * v[1] + v[2] * v[2] + v[3] * v[3]);
        if (lane == 0) ssq[gr * 4 + pn] = ss;
    }
};
struct EpiXQ {
    bf16* xq; const float* ssq2; const float* xq_g;
    __device__ __forceinline__ void operator()(f32x4 v, int gr, int pn, int lane) const {
        const f32x4 q = *(const f32x4*)(ssq2 + gr * 4);
        const float rinv = rsqrtf((q[0] + q[1] + q[2] + q[3]) * (1.f / DM) + EPS);
        v = v * rinv;
        const float ss = wave_sum(v[0] * v[0] + v[1] * v[1] + v[2] * v[2] + v[3] * v[3]);
        const float inv = rsqrtf(ss * (1.f / 256.f) + EPS) * 0.0625f;
        const float* g = xq_g + pn * 256 + 4 * lane;
        v[0] *= inv * g[0]; v[1] *= inv * g[1]; v[2] *= inv * g[2]; v[3] *= inv * g[3];
        u32x2 o; o[0] = pk2(v[0], v[1]); o[1] = pk2(v[2], v[3]);
        *(u32x2*)(xq + (size_t)gr * DM + pn * 256 + 4 * lane) = o;
    }
};
struct EpiUp {
    bf16* hid; const float* ssq3;
    __device__ __forceinline__ void operator()(f32x4 v, int gr, int pn, int lane) const {
        const f32x4 q = *(const f32x4*)(ssq3 + gr * 4);
        const float rinv = rsqrtf((q[0] + q[1] + q[2] + q[3]) * (1.f / DM) + EPS);
#pragma unroll
        for (int e = 0; e < 4; ++e) { const float t = fmaxf(v[e] * rinv, 0.f); v[e] = t * t; }
        u32x2 o; o[0] = pk2(v[0], v[1]); o[1] = pk2(v[2], v[3]);
        *(u32x2*)(hid + (size_t)gr * FF + pn * 256 + 4 * lane) = o;
    }
};
struct EpiDown {
    float* out;
    __device__ __forceinline__ void operator()(f32x4 v, int gr, int pn, int lane) const {
        const size_t o = (size_t)gr * DM + pn * 256 + 4 * lane;
        const f32x4 r = *(const f32x4*)(out + o);
        *(f32x4*)(out + o) = v + r;
    }
};

__device__ void ret_naive(const Frame& F, const bf16* proj, bf16* mix) {
    const int lane = F.lane;
    LAS float* qs = (LAS float*)(F.lds + F.wave * 2048);
    LAS float* wl = qs + 128;
    const int gw = F.bid * NWAVES + F.wave, GW = F.G * NWAVES;
    for (int u = gw; u < BATCH * 4 * SEQ; u += GW) {
        const int t = u % SEQ, h = (u / SEQ) & 3, b = u / (4 * SEQ);
        const size_t row = (size_t)b * SEQ + t;
        const float lg = log1pf(-exp2f(-5.f - (float)h));
        CBAR();
        { const unsigned qu = *(const unsigned*)(proj + row * NIN + C_RQ + h * 128 + 2 * lane); qs[2 * lane] = bflo(qu); qs[2 * lane + 1] = bfhi(qu); }
        CBAR();
        float a0 = 0.f, a1 = 0.f;
        for (int s0 = 0; s0 <= t; s0 += 64) {
            const int s = s0 + lane;
            const bf16* kp = proj + ((size_t)b * SEQ + s) * NIN + C_RK + h * 128;
            float z = 0.f;
#pragma unroll 4
            for (int c = 0; c < 16; ++c) {
                const u32x4 kk = *(const u32x4*)(kp + c * 8);
                const f32x4 q0 = *(LAS f32x4*)(qs + c * 8), q1 = *(LAS f32x4*)(qs + c * 8 + 4);
                z += bflo(kk[0]) * q0[0] + bfhi(kk[0]) * q0[1] + bflo(kk[1]) * q0[2] + bfhi(kk[1]) * q0[3]
                   + bflo(kk[2]) * q1[0] + bfhi(kk[2]) * q1[1] + bflo(kk[3]) * q1[2] + bfhi(kk[3]) * q1[3];
            }
            const float w = (s <= t) ? z * expf(lg * (float)(t - s)) : 0.f;
            CBAR(); wl[lane] = w; CBAR();
            const int jn = min(64, t - s0 + 1);
            for (int j = 0; j < jn; ++j) {
                const float wj = wl[j];
                const unsigned vu = *(const unsigned*)(proj + ((size_t)b * SEQ + s0 + j) * NIN + C_RV + h * 128 + 2 * lane);
                a0 += wj * bflo(vu); a1 += wj * bfhi(vu);
            }
            CBAR();
        }
        const float ss = wave_sum(a0 * a0 + a1 * a1);
        const float inv = rsqrtf(ss * (1.f / 128.f) + EPS);
        const unsigned gu = *(const unsigned*)(proj + row * NIN + C_RG + h * 128 + 2 * lane);
        const float g0 = bflo(gu), g1 = bfhi(gu);
        const float o0 = a0 * inv * F.ret_gn_g[h * 128 + 2 * lane] * (g0 / (1.f + expf(-g0)));
        const float o1 = a1 * inv * F.ret_gn_g[h * 128 + 2 * lane + 1] * (g1 / (1.f + expf(-g1)));
        *(unsigned*)(mix + row * DM + h * 128 + 2 * lane) = pk2(o0, o1);
    }
}
__device__ void sb_naive(const Frame& F, const bf16* proj, bf16* mix) {
    const int lane = F.lane;
    LAS float* qs = (LAS float*)(F.lds + F.wave * 2048);
    LAS float* wl = qs + 64;
    const int gw = F.bid * NWAVES + F.wave, GW = F.G * NWAVES;
    for (int u = gw; u < BATCH * 8 * SEQ; u += GW) {
        const int t = u % SEQ, h = (u / SEQ) & 7, b = u / (8 * SEQ);
        const size_t row = (size_t)b * SEQ + t;
        CBAR();
        qs[lane] = bf2f(proj[row * NIN + C_SQ + h * 64 + lane]);
        CBAR();
        float acc = 0.f, carry = 0.f;
        for (int s0 = ((t - 1) >> 6) << 6; s0 >= 0 && t > 0; s0 -= 64) {
            const int s = s0 + lane;
            const bool valid = s < t;
            const bf16* kp = proj + ((size_t)b * SEQ + s) * NIN + C_SK + h * 64;
            float z = 0.f;
#pragma unroll
            for (int c = 0; c < 8; ++c) {
                const u32x4 kk = *(const u32x4*)(kp + c * 8);
                const f32x4 q0 = *(LAS f32x4*)(qs + c * 8), q1 = *(LAS f32x4*)(qs + c * 8 + 4);
                z += bflo(kk[0]) * q0[0] + bfhi(kk[0]) * q0[1] + bflo(kk[1]) * q0[2] + bfhi(kk[1]) * q0[3]
                   + bflo(kk[2]) * q1[0] + bfhi(kk[2]) * q1[1] + bflo(kk[3]) * q1[2] + bfhi(kk[3]) * q1[3];
            }
            z *= 0.125f;
            const float sp = fmaxf(z, 0.f) + log1pf(expf(-fabsf(z)));
            float x = valid ? -sp : 0.f;
#pragma unroll
            for (int o = 1; o < 64; o <<= 1) { const float y = __shfl_down(x, o); if (lane + o < 64) x += y; }
            const float total = __shfl(x, 0);
            const float w = valid ? expf(z + x + carry) : 0.f;
            carry += total;
            CBAR(); wl[lane] = w; CBAR();
            const int jn = min(64, t - s0);
            for (int j = 0; j < jn; ++j) acc += wl[j] * bf2f(proj[((size_t)b * SEQ + s0 + j) * NIN + C_SV + h * 64 + lane]);
            CBAR();
        }
        mix[row * DM + 512 + h * 64 + lane] = (bf16)f2bf(acc);
    }
}
__device__ void xattn_naive(const Frame& F, const bf16* xq, const bf16* memk, const bf16* memv, bf16* xo) {
    const int lane = F.lane;
    LAS float* qs = (LAS float*)(F.lds + F.wave * 2048);
    LAS float* pl = qs + 256;
    const int gw = F.bid * NWAVES + F.wave, GW = F.G * NWAVES;
    for (int u = gw; u < BATCH * 4 * SEQ; u += GW) {
        const int t = u % SEQ, h = (u / SEQ) & 3, b = u / (4 * SEQ);
        const size_t row = (size_t)b * SEQ + t;
        CBAR();
        { const u32x2 qu = *(const u32x2*)(xq + row * DM + h * 256 + 4 * lane); qs[4 * lane] = bflo(qu[0]); qs[4 * lane + 1] = bfhi(qu[0]); qs[4 * lane + 2] = bflo(qu[1]); qs[4 * lane + 3] = bfhi(qu[1]); }
        CBAR();
        float z[4];
#pragma unroll
        for (int c4 = 0; c4 < 4; ++c4) {
            const bf16* kp = memk + ((size_t)b * MEML + c4 * 64 + lane) * DM + h * 256;
            float zz = 0.f;
#pragma unroll 4
            for (int c = 0; c < 32; ++c) {
                const u32x4 kk = *(const u32x4*)(kp + c * 8);
                const f32x4 q0 = *(LAS f32x4*)(qs + c * 8), q1 = *(LAS f32x4*)(qs + c * 8 + 4);
                zz += bflo(kk[0]) * q0[0] + bfhi(kk[0]) * q0[1] + bflo(kk[1]) * q0[2] + bfhi(kk[1]) * q0[3]
                    + bflo(kk[2]) * q1[0] + bfhi(kk[2]) * q1[1] + bflo(kk[3]) * q1[2] + bfhi(kk[3]) * q1[3];
            }
            z[c4] = zz;
        }
        const float mx = wave_max(fmaxf(fmaxf(z[0], z[1]), fmaxf(z[2], z[3])));
        float p0 = expf(z[0] - mx), p1 = expf(z[1] - mx), p2 = expf(z[2] - mx), p3 = expf(z[3] - mx);
        const float inv = 1.f / wave_sum(p0 + p1 + p2 + p3);
        CBAR();
        pl[lane] = p0 * inv; pl[64 + lane] = p1 * inv; pl[128 + lane] = p2 * inv; pl[192 + lane] = p3 * inv;
        CBAR();
        float o0 = 0.f, o1 = 0.f, o2 = 0.f, o3 = 0.f;
        for (int j = 0; j < 256; ++j) {
            const float pj = pl[j];
            const u32x2 vu = *(const u32x2*)(memv + ((size_t)b * MEML + j) * DM + h * 256 + 4 * lane);
            o0 += pj * bflo(vu[0]); o1 += pj * bfhi(vu[0]); o2 += pj * bflo(vu[1]); o3 += pj * bfhi(vu[1]);
        }
        u32x2 o; o[0] = pk2(o0, o1); o[1] = pk2(o2, o3);
        *(u32x2*)(xo + row * DM + h * 256 + 4 * lane) = o;
        CBAR();
    }
}

__global__ void __launch_bounds__(NTHR, 2) fwd_kernel(Args args) {
    extern __shared__ __attribute__((aligned(16))) unsigned char lds_raw[];
    Frame F;
    F.lds = (LAS unsigned char*)lds_raw;
    F.tid = threadIdx.x; F.lane = F.tid & 63; F.wave = __builtin_amdgcn_readfirstlane(F.tid >> 6);
    F.G = gridDim.x; F.bid = blockIdx.x;
    F.x = (const float*)args.in[0]; F.mem = (const float*)args.in[1]; F.pos = (const int*)args.in[2];
    F.g_mix = (const float*)args.in[3]; F.w_in = (const float*)args.in[4]; F.ret_gn_g = (const float*)args.in[5];
    F.sb_q_g = (const float*)args.in[6]; F.sb_k_g = (const float*)args.in[7]; F.w_out = (const float*)args.in[8];
    F.g_xattn = (const float*)args.in[9]; F.g_mem = (const float*)args.in[10]; F.w_xq = (const float*)args.in[11];
    F.w_xkv = (const float*)args.in[12]; F.xq_g = (const float*)args.in[13]; F.xk_g = (const float*)args.in[14];
    F.w_xo = (const float*)args.in[15]; F.g_mlp = (const float*)args.in[16]; F.w_up = (const float*)args.in[17]; F.w_down = (const float*)args.in[18];
    F.out = args.out; F.ws = args.ws;
    unsigned char* ws = args.ws;
    volatile LAS unsigned* MISC = (volatile LAS unsigned*)(F.lds + MISC_OFF);
    if (F.tid < 64) MISC[F.tid] = 0u;
    __syncthreads();
    XcdBarrier bar; bar.bar = (unsigned*)(ws + WS_CTL) + 1024 + args.li * 4096; bar.x = 0; bar.st = nullptr;
    if (MK_N_LAUNCHES != NPHASE) bar = xcd_barrier_post(bar.bar, MISC + 8);
#define GRID_BAR() do { if (MK_N_LAUNCHES != NPHASE) xcd_barrier(bar); } while (0)
    const int lo = args.ph_lo, hi = args.ph_hi;
#define IN(k) (lo <= (k) && (k) < hi)
#define BOTH(k) (IN(k) && IN((k) + 1))

    bf16* Wt_in = (bf16*)(ws + WS_WIN); bf16* Wt_out = (bf16*)(ws + WS_WOUT); bf16* Wt_xq = (bf16*)(ws + WS_WXQ); bf16* Wt_xkv = (bf16*)(ws + WS_WXKV);
    bf16* Wt_xo = (bf16*)(ws + WS_WXO); bf16* Wt_up = (bf16*)(ws + WS_WUP); bf16* Wt_dn = (bf16*)(ws + WS_WDN);
    float* rinv1 = (float*)(ws + WS_RINV1); float* rinvm = (float*)(ws + WS_RINVM); float* ssq2 = (float*)(ws + WS_SSQ2); float* ssq3 = (float*)(ws + WS_SSQ3);
    bf16* memb = (bf16*)(ws + WS_MEMB); bf16* memk = (bf16*)(ws + WS_MEMK); bf16* memv = (bf16*)(ws + WS_MEMV);
    float2* cs = (float2*)(ws + WS_ROPE);
    bf16* xb = (bf16*)(ws + WS_XB); bf16* mix = (bf16*)(ws + WS_MIX); bf16* proj = (bf16*)(ws + WS_PROJ);
    bf16* x1b = (bf16*)(ws + WS_X1B); bf16* xq = (bf16*)(ws + WS_XQ); bf16* xo = (bf16*)(ws + WS_XO); bf16* x2b = (bf16*)(ws + WS_X2B); bf16* hid = (bf16*)(ws + WS_HID);

    if (IN(0)) {
        conv_weight(F, F.w_in, F.g_mix, Wt_in, DM, NIN);
        conv_weight(F, F.w_out, nullptr, Wt_out, DM, DM);
        conv_weight(F, F.w_xq, F.g_xattn, Wt_xq, DM, DM);
        conv_weight(F, F.w_xkv, F.g_mem, Wt_xkv, DM, 2 * DM);
        conv_weight(F, F.w_xo, nullptr, Wt_xo, DM, DM);
        conv_weight(F, F.w_up, F.g_mlp, Wt_up, DM, FF);
        conv_weight(F, F.w_down, nullptr, Wt_dn, FF, DM);
        rows_prep(F, F.x, xb, rinv1, M);
        rows_prep(F, F.mem, memb, rinvm, MROWS);
        rope_table(F, cs);
        if (BOTH(0)) GRID_BAR();
    }
    if (IN(1)) {
        { EpiInProj E{proj, rinv1, cs, F.sb_q_g, F.sb_k_g}; gemm_phase(F, xb, Wt_in, M, NIN, DM, E); }
        { EpiMemKV E{memk, memv, rinvm, F.xk_g}; gemm_phase(F, memb, Wt_xkv, MROWS, 2 * DM, DM, E); }
        if (BOTH(1)) GRID_BAR();
    }
    if (IN(2)) {
        ret_naive(F, proj, mix);
        sb_naive(F, proj, mix);
        if (BOTH(2)) GRID_BAR();
    }
    if (IN(3)) {
        EpiResid E{F.x, F.out, x1b, ssq2}; gemm_phase(F, mix, Wt_out, M, DM, DM, E);
        if (BOTH(3)) GRID_BAR();
    }
    if (IN(4)) {
        EpiXQ E{xq, ssq2, F.xq_g}; gemm_phase(F, x1b, Wt_xq, M, DM, DM, E);
        if (BOTH(4)) GRID_BAR();
    }
    if (IN(5)) {
        xattn_naive(F, xq, memk, memv, xo);
        if (BOTH(5)) GRID_BAR();
    }
    if (IN(6)) {
        EpiResid E{F.out, F.out, x2b, ssq3}; gemm_phase(F, xo, Wt_xo, M, DM, DM, E);
        if (BOTH(6)) GRID_BAR();
    }
    if (IN(7)) {
        EpiUp E{hid, ssq3}; gemm_phase(F, x2b, Wt_up, M, FF, DM, E);
        if (BOTH(7)) GRID_BAR();
    }
    if (IN(8)) {
        EpiDown E{F.out}; gemm_phase(F, hid, Wt_dn, M, DM, FF, E);
    }
#undef IN
#undef BOTH
}

extern "C" void kernel_launch(void* const* d_in, const int* in_sizes, int n_in, void* d_out, int out_size, void* d_ws, size_t ws_size, hipStream_t stream) {
    static int grid = 0;
    if (grid == 0) {
        if (n_in != 19 || in_sizes[0] != M * DM || out_size != M * DM || ws_size < WS_END) { fprintf(stderr, "kernel_launch: unexpected shapes (n_in %d, in0 %d, out %d, ws %zu); nothing launched\n", n_in, n_in > 0 ? in_sizes[0] : -1, out_size, ws_size); grid = -1; return; }
        int dev = 0, cus = 0, per_cu = 0;
        if (hipGetDevice(&dev) != hipSuccess || hipDeviceGetAttribute(&cus, hipDeviceAttributeMultiprocessorCount, dev) != hipSuccess) { grid = -1; return; }
        if (hipFuncSetAttribute((const void*)fwd_kernel, hipFuncAttributeMaxDynamicSharedMemorySize, LDS_BYTES) != hipSuccess) { fprintf(stderr, "kernel_launch: hipFuncSetAttribute failed\n"); grid = -1; return; }
        if (hipOccupancyMaxActiveBlocksPerMultiprocessor(&per_cu, (const void*)fwd_kernel, NTHR, LDS_BYTES) != hipSuccess || per_cu < 1) fprintf(stderr, "kernel_launch: occupancy query reports %d per CU\n", per_cu);
        (void)hipGetLastError();
        grid = cus;
    }
    if (grid < 0) return;
    (void)hipMemsetAsync((char*)d_ws + WS_CTL, 0, CTL_ZERO_BYTES, stream);
    Args a{};
    for (int i = 0; i < 19; ++i) a.in[i] = d_in[i];
    a.out = (float*)d_out; a.ws = (unsigned char*)d_ws;
    for (int li = 0; li < MK_N_LAUNCHES; ++li) {
        a.ph_lo = (MK_N_LAUNCHES == NPHASE) ? li : 0; a.ph_hi = (MK_N_LAUNCHES == NPHASE) ? li + 1 : NPHASE; a.li = li; a.pad = 0;
        hipLaunchKernelGGL(fwd_kernel, dim3(grid), dim3(NTHR), LDS_BYTES, stream, a);
    }
}
```

```cpp
#include <hip/hip_runtime.h>
#include <stdint.h>
#include <cstdio>

#define LAS __attribute__((address_space(3)))
#define GAS __attribute__((address_space(1)))
typedef unsigned short bf16;
typedef short bf16x8 __attribute__((ext_vector_type(8)));
typedef float f32x4 __attribute__((ext_vector_type(4)));
typedef unsigned u32x4 __attribute__((ext_vector_type(4)));
typedef unsigned u32x2 __attribute__((ext_vector_type(2)));
typedef GAS unsigned gu32;

#ifndef MK_N_LAUNCHES
#define MK_N_LAUNCHES 1
#endif
constexpr int NPHASE = 11;
constexpr int NWAVES = 8, NTHR = 512;

constexpr int BATCH = 4, SEQ = 4096, DM = 1024, M = BATCH * SEQ;
constexpr int NIN = 3584, FF = 4096, MEML = 256, MROWS = BATCH * MEML;
constexpr int NPROJ = 2560, P_RQ = 0, P_RK = 512, P_RG = 1024, P_SQ = 1536, P_SK = 2048;
constexpr int NT = 1536, TC_RK = 0, TC_RV = 512, TC_SV = 1024;
constexpr float EPS = 1e-6f;

constexpr size_t MiB = 1u << 20;
constexpr size_t WS_CTL = 0, CTL_ZERO_BYTES = 64 * 1024;
constexpr size_t WS_WIN = 1 * MiB, WS_WOUT = 8 * MiB, WS_WXQ = 10 * MiB, WS_WXKV = 12 * MiB, WS_WXO = 16 * MiB, WS_WUP = 18 * MiB, WS_WDN = 26 * MiB;
constexpr size_t WS_RINV1 = 34 * MiB, WS_RINVM = 34 * MiB + 64 * 1024, WS_SSQ2 = 34 * MiB + 128 * 1024, WS_SSQ3 = 34 * MiB + 384 * 1024;
constexpr size_t WS_MEMB = 35 * MiB, WS_MEMK = 37 * MiB, WS_MEMV = 39 * MiB;
constexpr size_t WS_ROPE = 41 * MiB;
constexpr size_t WS_XB = 49 * MiB, WS_MIX = 49 * MiB;
constexpr size_t WS_PROJ = 81 * MiB;
constexpr size_t WS_T = 161 * MiB;
constexpr size_t WS_KVS = 209 * MiB;
constexpr size_t WS_X1B = 81 * MiB, WS_XQ = 113 * MiB, WS_XO = 145 * MiB;
constexpr size_t WS_X2B = 193 * MiB;
constexpr size_t WS_HID = 49 * MiB;
constexpr size_t WS_END = 241 * MiB;

constexpr int LDS_BYTES = 147456;
constexpr int MISC_OFF = 144 * 1024 - 256;

__device__ const double INVF[64] = {1.0, 0.8659643233600653, 0.7498942093324559, 0.6493816315762113, 0.5623413251903491, 0.4869675251658631, 0.4216965034285822, 0.3651741272548377, 0.31622776601683794, 0.27384196342643613, 0.23713737056616552, 0.2053525026457146, 0.1778279410038923, 0.1539926526059492, 0.1333521432163324, 0.11547819846894582, 0.1, 0.08659643233600653, 0.07498942093324558, 0.06493816315762113, 0.05623413251903491, 0.04869675251658631, 0.042169650342858224, 0.03651741272548377, 0.03162277660168379, 0.027384196342643614, 0.023713737056616554, 0.02053525026457146, 0.01778279410038923, 0.01539926526059492, 0.01333521432163324, 0.011547819846894581, 0.01, 0.008659643233600654, 0.007498942093324558, 0.006493816315762113, 0.005623413251903491, 0.004869675251658631, 0.004216965034285823, 0.003651741272548377, 0.0031622776601683794, 0.0027384196342643613, 0.0023713737056616554, 0.002053525026457146, 0.0017782794100389228, 0.001539926526059492, 0.001333521432163324, 0.0011547819846894581, 0.001, 0.0008659643233600654, 0.0007498942093324559, 0.0006493816315762113, 0.0005623413251903491, 0.0004869675251658631, 0.00042169650342858224, 0.0003651741272548377, 0.00031622776601683794, 0.0002738419634264361, 0.00023713737056616554, 0.0002053525026457146, 0.00017782794100389227, 0.0001539926526059492, 0.0001333521432163324, 0.00011547819846894582};

__device__ __forceinline__ float bflo(unsigned u) { return __uint_as_float(u << 16); }
__device__ __forceinline__ float bfhi(unsigned u) { return __uint_as_float(u & 0xffff0000u); }
__device__ __forceinline__ float bf2f(bf16 v) { return __uint_as_float(((unsigned)v) << 16); }
__device__ __forceinline__ unsigned f2bf(float f) { unsigned u = __float_as_uint(f); return (u + 0x7fffu + ((u >> 16) & 1u)) >> 16; }
__device__ __forceinline__ unsigned pk2(float lo, float hi) { return f2bf(lo) | (f2bf(hi) << 16); }
__device__ __forceinline__ float wave_sum(float v) {
#pragma unroll
    for (int o = 1; o < 64; o <<= 1) v += __shfl_xor(v, o);
    return v;
}
__device__ __forceinline__ float wave_max(float v) {
#pragma unroll
    for (int o = 1; o < 64; o <<= 1) v = fmaxf(v, __shfl_xor(v, o));
    return v;
}
#define CBAR() asm volatile("" ::: "memory")

#define XB_TMO      128
#define XB_XCNT(j)  (256  + 64 * (j))
#define XB_XSUB(j)  (1280 + 64 * (j))
#define XB_XGEN(j)  (2304 + 64 * (j))
#define XB_TOP      3328
#define XB_TOPGEN   3392
#define XCD_BAR_WORDS 3456
#define XB_SPIN_CAP (1u << 22)
__device__ __forceinline__ unsigned xb_ld(unsigned* p)              { return __hip_atomic_load(p, __ATOMIC_RELAXED, __HIP_MEMORY_SCOPE_AGENT); }
__device__ __forceinline__ unsigned xb_add(unsigned* p, unsigned v) { return __hip_atomic_fetch_add(p, v, __ATOMIC_RELAXED, __HIP_MEMORY_SCOPE_AGENT); }
__device__ __forceinline__ unsigned xb_xcc_id() { return (unsigned)__builtin_amdgcn_s_getreg((3 << 11) | 20) & 0xFu; }
#define XB_SPIN(cond, bar) do { unsigned _sp = 0; while (cond) { __builtin_amdgcn_s_sleep(1); \
    if ((++_sp & 255u) == 0u) { if (xb_ld(&(bar)[XB_TMO])) break; if (_sp > XB_SPIN_CAP) { atomicAdd(&(bar)[XB_TMO], 1u); break; } } } } while (0)
struct XcdBarrier { unsigned* bar; unsigned x; volatile LAS unsigned* st; };
__device__ __forceinline__ XcdBarrier xcd_barrier_post(unsigned* bar, volatile LAS unsigned* st) {
    XcdBarrier b; b.bar = bar; b.x = xb_xcc_id(); b.st = st;
    if (threadIdx.x == 0) (void)xb_add(&bar[XB_XCNT(b.x)], 1u);
    return b;
}
__device__ __forceinline__ void xcd_barrier_complete(unsigned* bar, unsigned x, unsigned& nloc, unsigned& nx) {
    const unsigned G = gridDim.x * gridDim.y * gridDim.z;
    unsigned sum, cnt, mine, sp = 0u;
    for (;;) {
        sum = 0u; cnt = 0u; mine = 0u;
#pragma unroll
        for (unsigned j = 0; j < 16; ++j) { const unsigned c = xb_ld(&bar[XB_XCNT(j)]); sum += c; cnt += (c > 0u) ? 1u : 0u; mine = (j == x) ? c : mine; }
        if (sum == G) break;
        __builtin_amdgcn_s_sleep(1);
        if ((++sp & 255u) == 0u) { if (xb_ld(&bar[XB_TMO])) break; if (sp > XB_SPIN_CAP) { atomicAdd(&bar[XB_TMO], 1u); break; } }
    }
    nloc = mine > 0u ? mine : 1u; nx = cnt > 0u ? cnt : 1u;
}
__device__ __forceinline__ void xcd_barrier(const XcdBarrier& b) {
    asm volatile("s_waitcnt vmcnt(0)" ::: "memory");
    __syncthreads();
    if (threadIdx.x == 0) {
        unsigned* bar = b.bar;
        __builtin_amdgcn_s_waitcnt(0);
        unsigned nloc = b.st[0], nx = b.st[1];
        if (nloc == 0u) { xcd_barrier_complete(bar, b.x, nloc, nx); b.st[0] = nloc; b.st[1] = nx; }
        const unsigned old = xb_add(&bar[XB_XSUB(b.x)], 1u);
        const unsigned gen = old / nloc;
        if (old + 1u == (gen + 1u) * nloc) {
            __builtin_amdgcn_fence(__ATOMIC_RELEASE, "agent");
            asm volatile("s_waitcnt vmcnt(0)" ::: "memory");
            const unsigned og = xb_add(&bar[XB_TOP], 1u);
            const unsigned tg = og / nx;
            if (og + 1u == (tg + 1u) * nx) xb_add(&bar[XB_TOPGEN], 1u);
            else XB_SPIN(xb_ld(&bar[XB_TOPGEN]) == tg, bar);
            __builtin_amdgcn_fence(__ATOMIC_ACQUIRE, "agent");
            xb_add(&bar[XB_XGEN(b.x)], 1u);
            asm volatile("s_waitcnt vmcnt(0)" ::: "memory");
        } else {
            XB_SPIN(xb_ld(&bar[XB_XGEN(b.x)]) == gen, bar);
            __builtin_amdgcn_fence(__ATOMIC_ACQUIRE, "agent");
            asm volatile("s_waitcnt vmcnt(0)" ::: "memory");
        }
    }
    __syncthreads();
}

struct Args { const void* in[19]; float* out; unsigned char* ws; int ph_lo, ph_hi, li, pad; };
struct Frame {
    LAS unsigned char* lds;
    int tid, lane, wave, G, bid;
    const float *x, *mem; const int* pos;
    const float *g_mix, *w_in, *ret_gn_g, *sb_q_g, *sb_k_g, *w_out, *g_xattn, *g_mem, *w_xq, *w_xkv, *xq_g, *xk_g, *w_xo, *g_mlp, *w_up, *w_down;
    float* out; unsigned char* ws;
};

__device__ void conv_weight(const Frame& F, const float* W, const float* g, bf16* Wt, int K, int N) {
    LAS float* T = (LAS float*)F.lds;
    const int tk = K / 64, tn = N / 64, nt = tk * tn;
    for (int t = F.bid; t < nt; t += F.G) {
        const int k0 = (t / tn) * 64, n0 = (t % tn) * 64;
        __syncthreads();
#pragma unroll
        for (int i = 0; i < 2; ++i) {
            const int r = (F.tid >> 4) + 32 * i, c = (F.tid & 15) * 4;
            f32x4 v = *(const f32x4*)(W + (size_t)(k0 + r) * N + n0 + c);
            const float gg = g ? g[k0 + r] : 1.f;
            T[r * 65 + c + 0] = v[0] * gg; T[r * 65 + c + 1] = v[1] * gg; T[r * 65 + c + 2] = v[2] * gg; T[r * 65 + c + 3] = v[3] * gg;
        }
        __syncthreads();
#pragma unroll
        for (int i = 0; i < 2; ++i) {
            const int n = (F.tid >> 4) + 32 * i, k = (F.tid & 15) * 4;
            u32x2 o; o[0] = pk2(T[(k + 0) * 65 + n], T[(k + 1) * 65 + n]); o[1] = pk2(T[(k + 2) * 65 + n], T[(k + 3) * 65 + n]);
            *(u32x2*)(Wt + (size_t)(n0 + n) * K + k0 + k) = o;
        }
    }
    __syncthreads();
}
__device__ void rows_prep(const Frame& F, const float* X, bf16* Xb, float* rinv, int rows) {
    const int gw = F.bid * NWAVES + F.wave, GW = F.G * NWAVES;
    for (int r = gw; r < rows; r += GW) {
        float ss = 0.f;
#pragma unroll
        for (int i = 0; i < 4; ++i) {
            const int c = i * 256 + F.lane * 4;
            f32x4 v = *(const f32x4*)(X + (size_t)r * DM + c);
            ss += v[0] * v[0] + v[1] * v[1] + v[2] * v[2] + v[3] * v[3];
            u32x2 o; o[0] = pk2(v[0], v[1]); o[1] = pk2(v[2], v[3]);
            *(u32x2*)(Xb + (size_t)r * DM + c) = o;
        }
        ss = wave_sum(ss);
        if (F.lane == 0) rinv[r] = rsqrtf(ss * (1.f / DM) + EPS);
    }
}
__device__ void rope_table(const Frame& F, float2* cs) {
    const int total = M * 64;
    for (int e = F.bid * NTHR + F.tid; e < total; e += F.G * NTHR) {
        const int row = e >> 6, j = e & 63;
        const double ang = (double)F.pos[row] * INVF[j];
        const double rev = ang * 0.15915494309189535;
        const float fr = (float)(rev - floor(rev));
        float2 o; o.x = __builtin_amdgcn_cosf(fr); o.y = __builtin_amdgcn_sinf(fr);
        cs[e] = o;
    }
}

constexpr int LDA_S = 72, LDC_S = 260;
template <class Epi>
__device__ void gemm_phase(const Frame& F, const bf16* A, const bf16* Bt, int Mr, int N, int K, const Epi& E) {
    const int tid = F.tid, lane = F.lane, wave = F.wave;
    const int wr = wave >> 2, wc = wave & 3;
    const int nN = N / 256, nU = (Mr / 128) * nN, nk = K / 64;
    LAS bf16* As = (LAS bf16*)F.lds;
    LAS bf16* Bs = (LAS bf16*)(F.lds + 128 * LDA_S * 2);
    LAS float* Cs = (LAS float*)F.lds;
    const int lr = tid >> 3, lc = (tid & 7) * 8;
    for (int u = F.bid; u < nU; u += F.G) {
        const int pm = u / nN, pn = u % nN;
        const bf16* Ag = A + (size_t)(pm * 128 + lr) * K + lc;
        const bf16* Bg = Bt + (size_t)(pn * 256 + lr) * K + lc;
        f32x4 acc[4][4];
#pragma unroll
        for (int i = 0; i < 4; ++i)
#pragma unroll
            for (int j = 0; j < 4; ++j) acc[i][j] = (f32x4){0.f, 0.f, 0.f, 0.f};
        u32x4 ra[2], rb[4];
#pragma unroll
        for (int i = 0; i < 2; ++i) ra[i] = *(const u32x4*)(Ag + (size_t)(64 * i) * K);
#pragma unroll
        for (int i = 0; i < 4; ++i) rb[i] = *(const u32x4*)(Bg + (size_t)(64 * i) * K);
        for (int kt = 0; kt < nk; ++kt) {
            __syncthreads();
#pragma unroll
            for (int i = 0; i < 2; ++i) *(LAS u32x4*)(As + (lr + 64 * i) * LDA_S + lc) = ra[i];
#pragma unroll
            for (int i = 0; i < 4; ++i) *(LAS u32x4*)(Bs + (lr + 64 * i) * LDA_S + lc) = rb[i];
            __syncthreads();
            if (kt + 1 < nk) {
#pragma unroll
                for (int i = 0; i < 2; ++i) ra[i] = *(const u32x4*)(Ag + (size_t)(64 * i) * K + (kt + 1) * 64);
#pragma unroll
                for (int i = 0; i < 4; ++i) rb[i] = *(const u32x4*)(Bg + (size_t)(64 * i) * K + (kt + 1) * 64);
            }
#pragma unroll
            for (int kk = 0; kk < 2; ++kk) {
                bf16x8 a[4], b[4];
#pragma unroll
                for (int i = 0; i < 4; ++i) a[i] = *(LAS bf16x8*)(As + (wr * 64 + i * 16 + (lane & 15)) * LDA_S + kk * 32 + (lane >> 4) * 8);
#pragma unroll
                for (int j = 0; j < 4; ++j) b[j] = *(LAS bf16x8*)(Bs + (wc * 64 + j * 16 + (lane & 15)) * LDA_S + kk * 32 + (lane >> 4) * 8);
#pragma unroll
                for (int i = 0; i < 4; ++i)
#pragma unroll
                    for (int j = 0; j < 4; ++j) acc[i][j] = __builtin_amdgcn_mfma_f32_16x16x32_bf16(a[i], b[j], acc[i][j], 0, 0, 0);
            }
        }
        __syncthreads();
#pragma unroll
        for (int i = 0; i < 4; ++i)
#pragma unroll
            for (int j = 0; j < 4; ++j)
#pragma unroll
                for (int r = 0; r < 4; ++r) Cs[(wr * 64 + i * 16 + (lane >> 4) * 4 + r) * LDC_S + wc * 64 + j * 16 + (lane & 15)] = acc[i][j][r];
        __syncthreads();
        const bool tr = E.transposed(pn);
        for (int rr = 0; rr < 16; ++rr) {
            const int row = wave * 16 + rr;
            f32x4 v = *(LAS f32x4*)(Cs + row * LDC_S + lane * 4);
            v = E(v, pm * 128 + row, pn, lane);
            if (tr) *(LAS f32x4*)(Cs + row * LDC_S + lane * 4) = v;
        }
        if (tr) { __syncthreads(); E.store_T(Cs, pm, pn, tid); }
    }
    __syncthreads();
}

__device__ __forceinline__ float lg2gamma(int h) { return h == 0 ? -0.04580368961312479f : h == 1 ? -0.02272007650008353f : h == 2 ? -0.011315313227834146f : -0.005646563141142063f; }
struct EpiInProj {
    bf16* proj; const float* rinv1; const float2* cs; const float* sb_q_g; const float* sb_k_g; bf16* T;
    __device__ __forceinline__ bool transposed(int pn) const { const int seg = pn >> 1; return seg == 1 || seg == 2 || seg == 6; }
    __device__ __forceinline__ void store_T(LAS float* Cs, int pm, int pn, int tid) const {
        const int seg = pn >> 1, chb = (seg == 1 ? TC_RK : seg == 2 ? TC_RV : TC_SV) + (pn & 1) * 256;
#pragma unroll
        for (int it = 0; it < 8; ++it) {
            const int item = it * NTHR + tid, rg = item & 15, col = item >> 4;
            float f[8];
#pragma unroll
            for (int i = 0; i < 8; ++i) f[i] = Cs[(rg * 8 + i) * LDC_S + col];
            u32x4 o; o[0] = pk2(f[0], f[1]); o[1] = pk2(f[2], f[3]); o[2] = pk2(f[4], f[5]); o[3] = pk2(f[6], f[7]);
            const int row0 = pm * 128 + rg * 8, b = row0 / SEQ, sq = row0 % SEQ;
            *(u32x4*)(T + ((size_t)b * NT + chb + col) * SEQ + sq) = o;
        }
    }
    __device__ __forceinline__ f32x4 operator()(f32x4 v, int gr, int pn, int lane) const {
        const int seg = pn >> 1, half = (pn & 1) * 256;
        const float s = rinv1[gr];
        v = v * s;
        if (seg <= 1) {
            f32x4 p; p[0] = __shfl_xor(v[0], 16); p[1] = __shfl_xor(v[1], 16); p[2] = __shfl_xor(v[2], 16); p[3] = __shfl_xor(v[3], 16);
            const int jj = (4 * lane) & 63;
            const bool first = (lane & 16) == 0;
            const int h = 2 * (pn & 1) + (lane >> 5);
            const float e = (float)((gr & 127) + 1) * lg2gamma(h);
            const float sc = (seg == 0) ? __builtin_amdgcn_exp2f(e) : 0.08838834764831845f * __builtin_amdgcn_exp2f(-e);
            const float2* c = cs + (size_t)gr * 64 + jj;
#pragma unroll
            for (int e4 = 0; e4 < 4; ++e4) { const float2 t = c[e4]; const float o = first ? (v[e4] * t.x - p[e4] * t.y) : (v[e4] * t.x + p[e4] * t.y); v[e4] = o * sc; }
        } else if (seg == 4 || seg == 5) {
            float ss = v[0] * v[0] + v[1] * v[1] + v[2] * v[2] + v[3] * v[3];
            ss += __shfl_xor(ss, 1); ss += __shfl_xor(ss, 2); ss += __shfl_xor(ss, 4); ss += __shfl_xor(ss, 8);
            const float inv = rsqrtf(ss * (1.f / 64.f) + EPS);
            const float* g = (seg == 4 ? sb_q_g : sb_k_g) + half + 4 * lane;
            v[0] *= inv * g[0]; v[1] *= inv * g[1]; v[2] *= inv * g[2]; v[3] *= inv * g[3];
        }
        if (seg != 2 && seg != 6) {
            const int pc = (seg == 0 ? P_RQ : seg == 1 ? P_RK : seg == 3 ? P_RG : seg == 4 ? P_SQ : P_SK) + half + 4 * lane;
            u32x2 o; o[0] = pk2(v[0], v[1]); o[1] = pk2(v[2], v[3]);
            *(u32x2*)(proj + (size_t)gr * NPROJ + pc) = o;
        }
        return v;
    }
};
struct EpiMemKV {
    bf16* memk; bf16* memvT; const float* rinvm; const float* xk_g;
    __device__ __forceinline__ bool transposed(int pn) const { return pn >= 4; }
    __device__ __forceinline__ void store_T(LAS float* Cs, int pm, int pn, int tid) const {
#pragma unroll
        for (int it = 0; it < 8; ++it) {
            const int item = it * NTHR + tid, rg = item & 15, col = item >> 4;
            float f[8];
#pragma unroll
            for (int i = 0; i < 8; ++i) f[i] = Cs[(rg * 8 + i) * LDC_S + col];
            u32x4 o; o[0] = pk2(f[0], f[1]); o[1] = pk2(f[2], f[3]); o[2] = pk2(f[4], f[5]); o[3] = pk2(f[6], f[7]);
            const int row0 = pm * 128 + rg * 8, b = row0 / MEML, key = row0 % MEML;
            *(u32x4*)(memvT + ((size_t)(b * 4 + pn - 4) * 256 + col) * MEML + key) = o;
        }
    }
    __device__ __forceinline__ f32x4 operator()(f32x4 v, int gr, int pn, int lane) const {
        v = v * rinvm[gr];
        if (pn < 4) {
            float ss = wave_sum(v[0] * v[0] + v[1] * v[1] + v[2] * v[2] + v[3] * v[3]);
            const float inv = rsqrtf(ss * (1.f / 256.f) + EPS);
            const float* g = xk_g + pn * 256 + 4 * lane;
            v[0] *= inv * g[0]; v[1] *= inv * g[1]; v[2] *= inv * g[2]; v[3] *= inv * g[3];
            u32x2 o; o[0] = pk2(v[0], v[1]); o[1] = pk2(v[2], v[3]);
            *(u32x2*)(memk + (size_t)gr * DM + pn * 256 + 4 * lane) = o;
        }
        return v;
    }
};
struct EpiResid {
    const float* resid; float* out; bf16* xb; float* ssq;
    __device__ __forceinline__ bool transposed(int) const { return false; }
    __device__ __forceinline__ void store_T(LAS float*, int, int, int) const {}
    __device__ __forceinline__ f32x4 operator()(f32x4 v, int gr, int pn, int lane) const {
        const size_t o = (size_t)gr * DM + pn * 256 + 4 * lane;
        const f32x4 r = *(const f32x4*)(resid + o);
        v = v + r;
        *(f32x4*)(out + o) = v;
        u32x2 w; w[0] = pk2(v[0], v[1]); w[1] = pk2(v[2], v[3]);
        *(u32x2*)(xb + o) = w;
        const float ss = wave_sum(v[0] * v[0] + v[1] * v[1] + v[2] * v[2] + v[3] * v[3]);
        if (lane == 0) ssq[gr * 4 + pn] = ss;
        return v;
    }
};
struct EpiXQ {
    bf16* xq; const float* ssq2; const float* xq_g;
    __device__ __forceinline__ bool transposed(int) const { return false; }
    __device__ __forceinline__ void store_T(LAS float*, int, int, int) const {}
    __device__ __forceinline__ f32x4 operator()(f32x4 v, int gr, int pn, int lane) const {
        const f32x4 q = *(const f32x4*)(ssq2 + gr * 4);
        const float rinv = rsqrtf((q[0] + q[1] + q[2] + q[3]) * (1.f / DM) + EPS);
        v = v * rinv;
        const float ss = wave_sum(v[0] * v[0] + v[1] * v[1] + v[2] * v[2] + v[3] * v[3]);
        const float inv = rsqrtf(ss * (1.f / 256.f) + EPS) * 0.09016844005556021f;
        const float* g = xq_g + pn * 256 + 4 * lane;
        v[0] *= inv * g[0]; v[1] *= inv * g[1]; v[2] *= inv * g[2]; v[3] *= inv * g[3];
        u32x2 o; o[0] = pk2(v[0], v[1]); o[1] = pk2(v[2], v[3]);
        *(u32x2*)(xq + (size_t)gr * DM + pn * 256 + 4 * lane) = o;
        return v;
    }
};
struct EpiUp {
    bf16* hid; const float* ssq3;
    __device__ __forceinline__ bool transposed(int) const { return false; }
    __device__ __forceinline__ void store_T(LAS float*, int, int, int) const {}
    __device__ __forceinline__ f32x4 operator()(f32x4 v, int gr, int pn, int lane) const {
        const f32x4 q = *(const f32x4*)(ssq3 + gr * 4);
        const float rinv = rsqrtf((q[0] + q[1] + q[2] + q[3]) * (1.f / DM) + EPS);
#pragma unroll
        for (int e = 0; e < 4; ++e) { const float t = fmaxf(v[e] * rinv, 0.f); v[e] = t * t; }
        u32x2 o; o[0] = pk2(v[0], v[1]); o[1] = pk2(v[2], v[3]);
        *(u32x2*)(hid + (size_t)gr * FF + pn * 256 + 4 * lane) = o;
        return v;
    }
};
struct EpiDown {
    float* out;
    __device__ __forceinline__ bool transposed(int) const { return false; }
    __device__ __forceinline__ void store_T(LAS float*, int, int, int) const {}
    __device__ __forceinline__ f32x4 operator()(f32x4 v, int gr, int pn, int lane) const {
        const size_t o = (size_t)gr * DM + pn * 256 + 4 * lane;
        const f32x4 r = *(const f32x4*)(out + o);
        *(f32x4*)(out + o) = v + r;
        return v;
    }
};

typedef float f32x16 __attribute__((ext_vector_type(16)));
#define MFMA32(a, b, c) __builtin_amdgcn_mfma_f32_32x32x16_bf16((a), (b), (c), 0, 0, 0)
__device__ __forceinline__ bf16x8 pack8(float a0, float a1, float a2, float a3, float a4, float a5, float a6, float a7) {
    u32x4 p; p[0] = pk2(a0, a1); p[1] = pk2(a2, a3); p[2] = pk2(a4, a5); p[3] = pk2(a6, a7);
    return __builtin_bit_cast(bf16x8, p);
}
__device__ void sb_mfma(const Frame& F, const bf16* proj, const bf16* T, bf16* mix) {
    const int lane = F.lane, r = lane & 31, hh = lane >> 5;
    const int gw = F.bid * NWAVES + F.wave, GW = F.G * NWAVES;
    const float c1 = 0.18033688011112042f;
    for (int u = gw; u < BATCH * 8 * 128; u += GW) {
        const int qb = 127 - (u & 127), hd = (u >> 7) & 7, b = u >> 10;
        const int q0 = qb * 32;
        const float gq = wave_max(fabsf(F.sb_q_g[hd * 64 + lane])), gk = wave_max(fabsf(F.sb_k_g[hd * 64 + lane]));
        const float thresh = 152.f + c1 * 64.f * gq * gk * 1.02f;
        bf16x8 qf[4];
        {
            const bf16* qp = proj + ((size_t)b * SEQ + q0 + r) * NPROJ + P_SQ + hd * 64 + 8 * hh;
#pragma unroll
            for (int s = 0; s < 4; ++s) qf[s] = *(const bf16x8*)(qp + 16 * s);
        }
        f32x16 o0, o1;
#pragma unroll
        for (int i = 0; i < 16; ++i) { o0[i] = 0.f; o1[i] = 0.f; }
        float carry = 0.f;
        const bf16* vbase = T + ((size_t)b * NT + TC_SV + hd * 64 + r) * SEQ + 4 * hh;
        for (int k0 = q0; k0 >= 0; k0 -= 32) {
            bf16x8 kf[4];
            {
                const bf16* kp = proj + ((size_t)b * SEQ + k0 + r) * NPROJ + P_SK + hd * 64 + 8 * hh;
#pragma unroll
                for (int s = 0; s < 4; ++s) kf[s] = *(const bf16x8*)(kp + 16 * s);
            }
            u32x2 vl[2][2][2];
#pragma unroll
            for (int n = 0; n < 2; ++n)
#pragma unroll
                for (int ks = 0; ks < 2; ++ks) {
                    const bf16* vp = vbase + (size_t)(32 * n) * SEQ + k0 + 16 * ks;
                    vl[n][ks][0] = *(const u32x2*)(vp); vl[n][ks][1] = *(const u32x2*)(vp + 8);
                }
            f32x16 x;
#pragma unroll
            for (int i = 0; i < 16; ++i) x[i] = 0.f;
#pragma unroll
            for (int s = 0; s < 4; ++s) x = MFMA32(kf[s], qf[s], x);
            const bool diag = (k0 == q0);
            f32x16 tt, ll;
#pragma unroll
            for (int i = 0; i < 16; ++i) {
                const int key = (i & 3) + 8 * (i >> 2) + 4 * hh;
                const bool valid = !diag || (key < r);
                const float t = x[i] * c1;
                const float l = __builtin_amdgcn_logf(1.f + __builtin_amdgcn_exp2f(t));
                tt[i] = valid ? t : -1e30f; ll[i] = valid ? l : 0.f;
            }
            float gt[4], pt[4];
#pragma unroll
            for (int g = 0; g < 4; ++g) {
                ll[4 * g + 2] += ll[4 * g + 3]; ll[4 * g + 1] += ll[4 * g + 2]; ll[4 * g] += ll[4 * g + 1];
                gt[g] = ll[4 * g]; pt[g] = __shfl_xor(gt[g], 32);
            }
            const float T0 = gt[0] + pt[0], T1 = gt[1] + pt[1], T2 = gt[2] + pt[2], T3 = gt[3] + pt[3];
            const float R2 = T3, R1 = R2 + T2, R0 = R1 + T1;
            float bs[4];
            bs[0] = carry + R0 + (hh == 0 ? pt[0] : 0.f); bs[1] = carry + R1 + (hh == 0 ? pt[1] : 0.f);
            bs[2] = carry + R2 + (hh == 0 ? pt[2] : 0.f); bs[3] = carry + (hh == 0 ? pt[3] : 0.f);
            carry += R0 + T0;
#pragma unroll
            for (int i = 0; i < 16; ++i) x[i] = __builtin_amdgcn_exp2f(tt[i] - (bs[i >> 2] + ll[i]));
#pragma unroll
            for (int ks = 0; ks < 2; ++ks) {
                const bf16x8 pf = pack8(x[8 * ks], x[8 * ks + 1], x[8 * ks + 2], x[8 * ks + 3], x[8 * ks + 4], x[8 * ks + 5], x[8 * ks + 6], x[8 * ks + 7]);
                u32x4 v0; v0[0] = vl[0][ks][0][0]; v0[1] = vl[0][ks][0][1]; v0[2] = vl[0][ks][1][0]; v0[3] = vl[0][ks][1][1];
                u32x4 v1; v1[0] = vl[1][ks][0][0]; v1[1] = vl[1][ks][0][1]; v1[2] = vl[1][ks][1][0]; v1[3] = vl[1][ks][1][1];
                o0 = MFMA32(pf, __builtin_bit_cast(bf16x8, v0), o0);
                o1 = MFMA32(pf, __builtin_bit_cast(bf16x8, v1), o1);
            }
            if (__all(carry > thresh)) break;
        }
        bf16* op = mix + ((size_t)b * SEQ + q0 + 4 * hh) * DM + 512 + hd * 64 + r;
#pragma unroll
        for (int i = 0; i < 16; ++i) {
            const int qr = (i & 3) + 8 * (i >> 2);
            op[(size_t)qr * DM] = (bf16)f2bf(o0[i]);
            op[(size_t)qr * DM + 32] = (bf16)f2bf(o1[i]);
        }
    }
}
__device__ void ret_kv(const Frame& F, const bf16* T, float* KVs) {
    const int lane = F.lane, r = lane & 31, hh = lane >> 5, mt = F.wave >> 1, nt0 = (F.wave & 1) * 2;
    for (int u = F.bid; u < BATCH * 4 * 32; u += F.G) {
        const int c = u & 31, h = (u >> 5) & 3, b = u >> 7, s0 = c * 128;
        const bf16* vp = T + ((size_t)b * NT + TC_RV + h * 128 + 32 * mt + r) * SEQ + s0 + 8 * hh;
        const bf16* kp0 = T + ((size_t)b * NT + TC_RK + h * 128 + 32 * nt0 + r) * SEQ + s0 + 8 * hh;
        const bf16* kp1 = kp0 + (size_t)32 * SEQ;
        f32x16 a0, a1;
#pragma unroll
        for (int i = 0; i < 16; ++i) { a0[i] = 0.f; a1[i] = 0.f; }
#pragma unroll
        for (int ks = 0; ks < 8; ++ks) {
            const bf16x8 vf = *(const bf16x8*)(vp + 16 * ks), k0f = *(const bf16x8*)(kp0 + 16 * ks), k1f = *(const bf16x8*)(kp1 + 16 * ks);
            a0 = MFMA32(vf, k0f, a0); a1 = MFMA32(vf, k1f, a1);
        }
        const float g128 = __builtin_amdgcn_exp2f(128.f * lg2gamma(h));
        float* op = KVs + (size_t)u * 16384 + (size_t)(32 * mt + 4 * hh) * 128 + 32 * nt0 + r;
#pragma unroll
        for (int i = 0; i < 16; ++i) { const int row = (i & 3) + 8 * (i >> 2); op[row * 128] = a0[i] * g128; op[row * 128 + 32] = a1[i] * g128; }
    }
}
__device__ void ret_scan(const Frame& F, float* KVs) {
    for (int it = F.bid * NTHR + F.tid; it < 16 * 4096; it += F.G * NTHR) {
        const int bh = it >> 12, e4 = (it & 4095) * 4;
        const float g128 = __builtin_amdgcn_exp2f(128.f * lg2gamma(bh & 3));
        float* p = KVs + (size_t)bh * 32 * 16384 + e4;
        f32x4 st = (f32x4){0.f, 0.f, 0.f, 0.f};
#pragma unroll 1
        for (int cb = 0; cb < 4; ++cb) {
            f32x4 t[8];
#pragma unroll
            for (int c = 0; c < 8; ++c) t[c] = *(const f32x4*)(p + (size_t)(cb * 8 + c) * 16384);
#pragma unroll
            for (int c = 0; c < 8; ++c) { *(f32x4*)(p + (size_t)(cb * 8 + c) * 16384) = st; st = st * g128 + t[c]; }
        }
    }
}
__device__ void ret_out(const Frame& F, const bf16* proj, const bf16* T, const float* KVs, bf16* mix) {
    const int lane = F.lane, r = lane & 31, hh = lane >> 5;
    const int gw = F.bid * NWAVES + F.wave, GW = F.G * NWAVES;
    for (int wu = gw; wu < BATCH * 4 * 32 * 4; wu += GW) {
        const int u = wu >> 2, wq = wu & 3, c = u & 31, h = (u >> 5) & 3, b = u >> 7;
        const int q0 = c * 128 + 32 * wq;
        bf16x8 qf[8];
        {
            const bf16* qp = proj + ((size_t)b * SEQ + q0 + r) * NPROJ + P_RQ + h * 128 + 8 * hh;
#pragma unroll
            for (int s = 0; s < 8; ++s) qf[s] = *(const bf16x8*)(qp + 16 * s);
        }
        f32x16 o[4];
#pragma unroll
        for (int n = 0; n < 4; ++n)
#pragma unroll
            for (int i = 0; i < 16; ++i) o[n][i] = 0.f;
        {
            const float* sp = KVs + (size_t)u * 16384 + (size_t)r * 128 + 8 * hh;
#pragma unroll
            for (int n = 0; n < 4; ++n)
#pragma unroll
                for (int ks = 0; ks < 8; ++ks) {
                    const f32x4 lo = *(const f32x4*)(sp + n * 32 * 128 + 16 * ks), hi = *(const f32x4*)(sp + n * 32 * 128 + 16 * ks + 4);
                    o[n] = MFMA32(qf[ks], pack8(lo[0], lo[1], lo[2], lo[3], hi[0], hi[1], hi[2], hi[3]), o[n]);
                }
        }
        for (int kt = 0; kt <= wq; ++kt) {
            const int k0 = c * 128 + 32 * kt;
            f32x16 x;
#pragma unroll
            for (int i = 0; i < 16; ++i) x[i] = 0.f;
            {
                const bf16* kp = proj + ((size_t)b * SEQ + k0 + r) * NPROJ + P_RK + h * 128 + 8 * hh;
#pragma unroll
                for (int s = 0; s < 8; ++s) x = MFMA32(*(const bf16x8*)(kp + 16 * s), qf[s], x);
            }
            if (kt == wq) {
#pragma unroll
                for (int i = 0; i < 16; ++i) { const int key = (i & 3) + 8 * (i >> 2) + 4 * hh; x[i] = (key <= r) ? x[i] : 0.f; }
            }
#pragma unroll
            for (int ks = 0; ks < 2; ++ks) {
                const bf16x8 pf = pack8(x[8 * ks], x[8 * ks + 1], x[8 * ks + 2], x[8 * ks + 3], x[8 * ks + 4], x[8 * ks + 5], x[8 * ks + 6], x[8 * ks + 7]);
#pragma unroll
                for (int n = 0; n < 4; ++n) {
                    const bf16* vp = T + ((size_t)b * NT + TC_RV + h * 128 + 32 * n + r) * SEQ + k0 + 16 * ks + 4 * hh;
                    const u32x2 lo = *(const u32x2*)(vp), hi = *(const u32x2*)(vp + 8);
                    u32x4 vv; vv[0] = lo[0]; vv[1] = lo[1]; vv[2] = hi[0]; vv[3] = hi[1];
                    o[n] = MFMA32(pf, __builtin_bit_cast(bf16x8, vv), o[n]);
                }
            }
        }
#pragma unroll
        for (int i = 0; i < 16; ++i) {
            float ss = o[0][i] * o[0][i] + o[1][i] * o[1][i] + o[2][i] * o[2][i] + o[3][i] * o[3][i];
            ss += __shfl_xor(ss, 1); ss += __shfl_xor(ss, 2); ss += __shfl_xor(ss, 4); ss += __shfl_xor(ss, 8); ss += __shfl_xor(ss, 16);
            const float inv = rsqrtf(ss * (1.f / 128.f) + EPS);
            const size_t row = (size_t)b * SEQ + q0 + (i & 3) + 8 * (i >> 2) + 4 * hh;
#pragma unroll
            for (int n = 0; n < 4; ++n) {
                const int dv = h * 128 + 32 * n + r;
                const float g = bf2f(proj[row * NPROJ + P_RG + dv]);
                const float val = o[n][i] * inv * F.ret_gn_g[dv] * (g / (1.f + __expf(-g)));
                mix[row * DM + dv] = (bf16)f2bf(val);
            }
        }
    }
}
__device__ void xattn_mfma(const Frame& F, const bf16* xq, const bf16* memk, const bf16* memvT, bf16* xo) {
    const int lane = F.lane, r = lane & 31, hh = lane >> 5;
    LAS bf16* qs = (LAS bf16*)(F.lds + F.wave * 16896);
    const int gw = F.bid * NWAVES + F.wave, GW = F.G * NWAVES;
    for (int wu = gw; wu < BATCH * 4 * 128; wu += GW) {
        const int qb = wu & 127, h = (wu >> 7) & 3, b = wu >> 9, q0 = qb * 32;
        CBAR();
#pragma unroll
        for (int i = 0; i < 16; ++i) {
            const int id = i * 64 + lane, row = id >> 5, ch = id & 31;
            const u32x4 v = *(const u32x4*)(xq + ((size_t)b * SEQ + q0 + row) * DM + h * 256 + ch * 8);
            *(LAS u32x4*)(qs + row * 264 + ch * 8) = v;
        }
        CBAR();
        f32x16 o[8];
#pragma unroll
        for (int n = 0; n < 8; ++n)
#pragma unroll
            for (int i = 0; i < 16; ++i) o[n][i] = 0.f;
        float m = 0.f, l = 0.f;
        const bf16* vbase = memvT + ((size_t)(b * 4 + h) * 256 + r) * MEML + 4 * hh;
        for (int kt = 0; kt < 8; ++kt) {
            const int k0 = kt * 32;
            f32x16 x;
#pragma unroll
            for (int i = 0; i < 16; ++i) x[i] = 0.f;
            {
                const bf16* kp = memk + ((size_t)b * MEML + k0 + r) * DM + h * 256 + 8 * hh;
#pragma unroll
                for (int sg = 0; sg < 4; ++sg) {
#pragma unroll
                    for (int s = 4 * sg; s < 4 * sg + 4; ++s) x = MFMA32(*(const bf16x8*)(kp + 16 * s), *(LAS bf16x8*)(qs + r * 264 + 16 * s + 8 * hh), x);
                    __builtin_amdgcn_sched_barrier(0);
                }
            }
            float tmax = x[0];
#pragma unroll
            for (int i = 1; i < 16; ++i) tmax = fmaxf(tmax, x[i]);
            tmax = fmaxf(tmax, __shfl_xor(tmax, 32));
            if (kt == 0) m = tmax;
            else if (__any(tmax > m + 8.f)) {
                const float mn = fmaxf(m, tmax), alpha = __builtin_amdgcn_exp2f(m - mn);
                m = mn; l *= alpha;
#pragma unroll
                for (int i = 0; i < 16; ++i) {
                    const float ai = __shfl(alpha, (i & 3) + 8 * (i >> 2) + 4 * hh);
#pragma unroll
                    for (int n = 0; n < 8; ++n) o[n][i] *= ai;
                }
            }
            float ps = 0.f;
#pragma unroll
            for (int i = 0; i < 16; ++i) { x[i] = __builtin_amdgcn_exp2f(x[i] - m); ps += x[i]; }
            ps += __shfl_xor(ps, 32);
            l += ps;
#pragma unroll
            for (int ks = 0; ks < 2; ++ks) {
                const bf16x8 pf = pack8(x[8 * ks], x[8 * ks + 1], x[8 * ks + 2], x[8 * ks + 3], x[8 * ks + 4], x[8 * ks + 5], x[8 * ks + 6], x[8 * ks + 7]);
#pragma unroll
                for (int ng = 0; ng < 2; ++ng) {
#pragma unroll
                    for (int n = 4 * ng; n < 4 * ng + 4; ++n) {
                        const bf16* vp = vbase + (size_t)(32 * n) * MEML + k0 + 16 * ks;
                        const u32x2 lo = *(const u32x2*)(vp), hi = *(const u32x2*)(vp + 8);
                        u32x4 vv; vv[0] = lo[0]; vv[1] = lo[1]; vv[2] = hi[0]; vv[3] = hi[1];
                        o[n] = MFMA32(pf, __builtin_bit_cast(bf16x8, vv), o[n]);
                    }
                    __builtin_amdgcn_sched_barrier(0);
                }
            }
        }
        const float linv = 1.f / l;
#pragma unroll
        for (int i = 0; i < 16; ++i) {
            const int qr = (i & 3) + 8 * (i >> 2) + 4 * hh;
            const float li = __shfl(linv, qr);
            bf16* op = xo + ((size_t)b * SEQ + q0 + qr) * DM + h * 256 + r;
#pragma unroll
            for (int n = 0; n < 8; ++n) op[32 * n] = (bf16)f2bf(o[n][i] * li);
        }
    }
}

__global__ void __launch_bounds__(NTHR, 2) fwd_kernel(Args args) {
    extern __shared__ __attribute__((aligned(16))) unsigned char lds_raw[];
    Frame F;
    F.lds = (LAS unsigned char*)lds_raw;
    F.tid = threadIdx.x; F.lane = F.tid & 63; F.wave = __builtin_amdgcn_readfirstlane(F.tid >> 6);
    F.G = gridDim.x; F.bid = blockIdx.x;
    F.x = (const float*)args.in[0]; F.mem = (const float*)args.in[1]; F.pos = (const int*)args.in[2];
    F.g_mix = (const float*)args.in[3]; F.w_in = (const float*)args.in[4]; F.ret_gn_g = (const float*)args.in[5];
    F.sb_q_g = (const float*)args.in[6]; F.sb_k_g = (const float*)args.in[7]; F.w_out = (const float*)args.in[8];
    F.g_xattn = (const float*)args.in[9]; F.g_mem = (const float*)args.in[10]; F.w_xq = (const float*)args.in[11];
    F.w_xkv = (const float*)args.in[12]; F.xq_g = (const float*)args.in[13]; F.xk_g = (const float*)args.in[14];
    F.w_xo = (const float*)args.in[15]; F.g_mlp = (const float*)args.in[16]; F.w_up = (const float*)args.in[17]; F.w_down = (const float*)args.in[18];
    F.out = args.out; F.ws = args.ws;
    unsigned char* ws = args.ws;
    volatile LAS unsigned* MISC = (volatile LAS unsigned*)(F.lds + MISC_OFF);
    if (F.tid < 64) MISC[F.tid] = 0u;
    __syncthreads();
    XcdBarrier bar; bar.bar = (unsigned*)(ws + WS_CTL) + 1024 + args.li * 4096; bar.x = 0; bar.st = nullptr;
    if (MK_N_LAUNCHES != NPHASE) bar = xcd_barrier_post(bar.bar, MISC + 8);
#define GRID_BAR() do { if (MK_N_LAUNCHES != NPHASE) xcd_barrier(bar); } while (0)
    const int lo = args.ph_lo, hi = args.ph_hi;
#define IN(k) (lo <= (k) && (k) < hi)
#define BOTH(k) (IN(k) && IN((k) + 1))

    bf16* Wt_in = (bf16*)(ws + WS_WIN); bf16* Wt_out = (bf16*)(ws + WS_WOUT); bf16* Wt_xq = (bf16*)(ws + WS_WXQ); bf16* Wt_xkv = (bf16*)(ws + WS_WXKV);
    bf16* Wt_xo = (bf16*)(ws + WS_WXO); bf16* Wt_up = (bf16*)(ws + WS_WUP); bf16* Wt_dn = (bf16*)(ws + WS_WDN);
    float* rinv1 = (float*)(ws + WS_RINV1); float* rinvm = (float*)(ws + WS_RINVM); float* ssq2 = (float*)(ws + WS_SSQ2); float* ssq3 = (float*)(ws + WS_SSQ3);
    bf16* memb = (bf16*)(ws + WS_MEMB); bf16* memk = (bf16*)(ws + WS_MEMK); bf16* memvT = (bf16*)(ws + WS_MEMV);
    float2* cs = (float2*)(ws + WS_ROPE);
    bf16* xb = (bf16*)(ws + WS_XB); bf16* mix = (bf16*)(ws + WS_MIX); bf16* proj = (bf16*)(ws + WS_PROJ);
    bf16* x1b = (bf16*)(ws + WS_X1B); bf16* xq = (bf16*)(ws + WS_XQ); bf16* xo = (bf16*)(ws + WS_XO); bf16* x2b = (bf16*)(ws + WS_X2B); bf16* hid = (bf16*)(ws + WS_HID); bf16* T = (bf16*)(ws + WS_T); float* KVs = (float*)(ws + WS_KVS);

    if (IN(0)) {
        conv_weight(F, F.w_in, F.g_mix, Wt_in, DM, NIN);
        conv_weight(F, F.w_out, nullptr, Wt_out, DM, DM);
        conv_weight(F, F.w_xq, F.g_xattn, Wt_xq, DM, DM);
        conv_weight(F, F.w_xkv, F.g_mem, Wt_xkv, DM, 2 * DM);
        conv_weight(F, F.w_xo, nullptr, Wt_xo, DM, DM);
        conv_weight(F, F.w_up, F.g_mlp, Wt_up, DM, FF);
        conv_weight(F, F.w_down, nullptr, Wt_dn, FF, DM);
        rows_prep(F, F.x, xb, rinv1, M);
        rows_prep(F, F.mem, memb, rinvm, MROWS);
        rope_table(F, cs);
        if (BOTH(0)) GRID_BAR();
    }
    if (IN(1)) {
        { EpiInProj E{proj, rinv1, cs, F.sb_q_g, F.sb_k_g, T}; gemm_phase(F, xb, Wt_in, M, NIN, DM, E); }
        { EpiMemKV E{memk, memvT, rinvm, F.xk_g}; gemm_phase(F, memb, Wt_xkv, MROWS, 2 * DM, DM, E); }
        if (BOTH(1)) GRID_BAR();
    }
    if (IN(2)) {
        ret_kv(F, T, KVs);
        sb_mfma(F, proj, T, mix);
        if (BOTH(2)) GRID_BAR();
    }
    if (IN(3)) {
        ret_scan(F, KVs);
        if (BOTH(3)) GRID_BAR();
    }
    if (IN(4)) {
        ret_out(F, proj, T, KVs, mix);
        if (BOTH(4)) GRID_BAR();
    }
    if (IN(5)) {
        EpiResid E{F.x, F.out, x1b, ssq2}; gemm_phase(F, mix, Wt_out, M, DM, DM, E);
        if (BOTH(5)) GRID_BAR();
    }
    if (IN(6)) {
        EpiXQ E{xq, ssq2, F.xq_g}; gemm_phase(F, x1b, Wt_xq, M, DM, DM, E);
        if (BOTH(6)) GRID_BAR();
    }
    if (IN(7)) {
        xattn_mfma(F, xq, memk, memvT, xo);
        if (BOTH(7)) GRID_BAR();
    }
    if (IN(8)) {
        EpiResid E{F.out, F.out, x2b, ssq3}; gemm_phase(F, xo, Wt_xo, M, DM, DM, E);
        if (BOTH(8)) GRID_BAR();
    }
    if (IN(9)) {
        EpiUp E{hid, ssq3}; gemm_phase(F, x2b, Wt_up, M, FF, DM, E);
        if (BOTH(9)) GRID_BAR();
    }
    if (IN(10)) {
        EpiDown E{F.out}; gemm_phase(F, hid, Wt_dn, M, DM, FF, E);
    }
#undef IN
#undef BOTH
}

extern "C" void kernel_launch(void* const* d_in, const int* in_sizes, int n_in, void* d_out, int out_size, void* d_ws, size_t ws_size, hipStream_t stream) {
    static int grid = 0;
    if (grid == 0) {
        if (n_in != 19 || in_sizes[0] != M * DM || out_size != M * DM || ws_size < WS_END) { fprintf(stderr, "kernel_launch: unexpected shapes (n_in %d, in0 %d, out %d, ws %zu); nothing launched\n", n_in, n_in > 0 ? in_sizes[0] : -1, out_size, ws_size); grid = -1; return; }
        int dev = 0, cus = 0, per_cu = 0;
        if (hipGetDevice(&dev) != hipSuccess || hipDeviceGetAttribute(&cus, hipDeviceAttributeMultiprocessorCount, dev) != hipSuccess) { grid = -1; return; }
        if (hipFuncSetAttribute((const void*)fwd_kernel, hipFuncAttributeMaxDynamicSharedMemorySize, LDS_BYTES) != hipSuccess) { fprintf(stderr, "kernel_launch: hipFuncSetAttribute failed\n"); grid = -1; return; }
        if (hipOccupancyMaxActiveBlocksPerMultiprocessor(&per_cu, (const void*)fwd_kernel, NTHR, LDS_BYTES) != hipSuccess || per_cu < 1) fprintf(stderr, "kernel_launch: occupancy query reports %d per CU\n", per_cu);
        (void)hipGetLastError();
        grid = cus;
    }
    if (grid < 0) return;
    (void)hipMemsetAsync((char*)d_ws + WS_CTL, 0, CTL_ZERO_BYTES, stream);
    Args a{};
    for (int i = 0; i < 19; ++i) a.in[i] = d_in[i];
    a.out = (float*)d_out; a.ws = (unsigned char*)d_ws;
    for (int li = 0; li < MK_N_LAUNCHES; ++li) {
        a.ph_lo = (MK_N_LAUNCHES == NPHASE) ? li : 0; a.ph_hi = (MK_N_LAUNCHES == NPHASE) ? li + 1 : NPHASE; a.li = li; a.pad = 0;
        hipLaunchKernelGGL(fwd_kernel, dim3(grid), dim3(NTHR), LDS_BYTES, stream, a);
    }
}
```

```cpp
#include <hip/hip_runtime.h>
#include <stdint.h>
#include <cstdio>

#define LAS __attribute__((address_space(3)))
#define GAS __attribute__((address_space(1)))
typedef unsigned short bf16;
typedef short bf16x8 __attribute__((ext_vector_type(8)));
typedef float f32x4 __attribute__((ext_vector_type(4)));
typedef unsigned u32x4 __attribute__((ext_vector_type(4)));
typedef unsigned u32x2 __attribute__((ext_vector_type(2)));
typedef GAS unsigned gu32;

#ifndef MK_N_LAUNCHES
#define MK_N_LAUNCHES 1
#endif
constexpr int NPHASE = 11;
constexpr int NWAVES = 8, NTHR = 512;

constexpr int BATCH = 4, SEQ = 4096, DM = 1024, M = BATCH * SEQ;
constexpr int NIN = 3584, FF = 4096, MEML = 256, MROWS = BATCH * MEML;
constexpr int NPROJ = 2560, P_RQ = 0, P_RK = 512, P_RG = 1024, P_SQ = 1536, P_SK = 2048;
constexpr int NT = 1536, TC_RK = 0, TC_RV = 512, TC_SV = 1024;
constexpr float EPS = 1e-6f;

constexpr size_t MiB = 1u << 20;
constexpr size_t WS_CTL = 0, CTL_ZERO_BYTES = 64 * 1024;
constexpr size_t WS_WIN = 1 * MiB, WS_WOUT = 8 * MiB, WS_WXQ = 10 * MiB, WS_WXKV = 12 * MiB, WS_WXO = 16 * MiB, WS_WUP = 18 * MiB, WS_WDN = 26 * MiB;
constexpr size_t WS_RINV1 = 34 * MiB, WS_RINVM = 34 * MiB + 64 * 1024;
constexpr size_t WS_SSQ2 = 241 * MiB, WS_SSQ3 = 242 * MiB, WS_SSQQ = 243 * MiB;
constexpr size_t WS_MEMB = 35 * MiB, WS_MEMK = 37 * MiB, WS_MEMV = 39 * MiB;
constexpr size_t WS_ROPE = 41 * MiB;
constexpr size_t WS_XB = 49 * MiB, WS_MIX = 49 * MiB;
constexpr size_t WS_PROJ = 81 * MiB;
constexpr size_t WS_T = 161 * MiB;
constexpr size_t WS_KVS = 209 * MiB;
constexpr size_t WS_X1B = 81 * MiB, WS_XQ = 113 * MiB, WS_XO = 145 * MiB;
constexpr size_t WS_X2B = 193 * MiB;
constexpr size_t WS_HID = 49 * MiB;
constexpr size_t WS_END = 244 * MiB;

constexpr int LDS_BYTES = 147456;
constexpr int MISC_OFF = 144 * 1024 - 256;

__device__ const double INVF[64] = {1.0, 0.8659643233600653, 0.7498942093324559, 0.6493816315762113, 0.5623413251903491, 0.4869675251658631, 0.4216965034285822, 0.3651741272548377, 0.31622776601683794, 0.27384196342643613, 0.23713737056616552, 0.2053525026457146, 0.1778279410038923, 0.1539926526059492, 0.1333521432163324, 0.11547819846894582, 0.1, 0.08659643233600653, 0.07498942093324558, 0.06493816315762113, 0.05623413251903491, 0.04869675251658631, 0.042169650342858224, 0.03651741272548377, 0.03162277660168379, 0.027384196342643614, 0.023713737056616554, 0.02053525026457146, 0.01778279410038923, 0.01539926526059492, 0.01333521432163324, 0.011547819846894581, 0.01, 0.008659643233600654, 0.007498942093324558, 0.006493816315762113, 0.005623413251903491, 0.004869675251658631, 0.004216965034285823, 0.003651741272548377, 0.0031622776601683794, 0.0027384196342643613, 0.0023713737056616554, 0.002053525026457146, 0.0017782794100389228, 0.001539926526059492, 0.001333521432163324, 0.0011547819846894581, 0.001, 0.0008659643233600654, 0.0007498942093324559, 0.0006493816315762113, 0.0005623413251903491, 0.0004869675251658631, 0.00042169650342858224, 0.0003651741272548377, 0.00031622776601683794, 0.0002738419634264361, 0.00023713737056616554, 0.0002053525026457146, 0.00017782794100389227, 0.0001539926526059492, 0.0001333521432163324, 0.00011547819846894582};

__device__ __forceinline__ float bflo(unsigned u) { return __uint_as_float(u << 16); }
__device__ __forceinline__ float bfhi(unsigned u) { return __uint_as_float(u & 0xffff0000u); }
__device__ __forceinline__ float bf2f(bf16 v) { return __uint_as_float(((unsigned)v) << 16); }
__device__ __forceinline__ unsigned f2bf(float f) { unsigned u = __float_as_uint(f); return (u + 0x7fffu + ((u >> 16) & 1u)) >> 16; }
__device__ __forceinline__ unsigned pk2(float lo, float hi) { return f2bf(lo) | (f2bf(hi) << 16); }
__device__ __forceinline__ float wave_sum(float v) {
#pragma unroll
    for (int o = 1; o < 64; o <<= 1) v += __shfl_xor(v, o);
    return v;
}
__device__ __forceinline__ float wave_max(float v) {
#pragma unroll
    for (int o = 1; o < 64; o <<= 1) v = fmaxf(v, __shfl_xor(v, o));
    return v;
}
#define CBAR() asm volatile("" ::: "memory")
__device__ __forceinline__ float lg2gamma(int h) { return h == 0 ? -0.04580368961312479f : h == 1 ? -0.02272007650008353f : h == 2 ? -0.011315313227834146f : -0.005646563141142063f; }

#define XB_TMO      128
#define XB_XCNT(j)  (256  + 64 * (j))
#define XB_XSUB(j)  (1280 + 64 * (j))
#define XB_XGEN(j)  (2304 + 64 * (j))
#define XB_TOP      3328
#define XB_TOPGEN   3392
#define XCD_BAR_WORDS 3456
#define XB_SPIN_CAP (1u << 22)
__device__ __forceinline__ unsigned xb_ld(unsigned* p)              { return __hip_atomic_load(p, __ATOMIC_RELAXED, __HIP_MEMORY_SCOPE_AGENT); }
__device__ __forceinline__ unsigned xb_add(unsigned* p, unsigned v) { return __hip_atomic_fetch_add(p, v, __ATOMIC_RELAXED, __HIP_MEMORY_SCOPE_AGENT); }
__device__ __forceinline__ unsigned xb_xcc_id() { return (unsigned)__builtin_amdgcn_s_getreg((3 << 11) | 20) & 0xFu; }
#define XB_SPIN(cond, bar) do { unsigned _sp = 0; while (cond) { __builtin_amdgcn_s_sleep(1); \
    if ((++_sp & 255u) == 0u) { if (xb_ld(&(bar)[XB_TMO])) break; if (_sp > XB_SPIN_CAP) { atomicAdd(&(bar)[XB_TMO], 1u); break; } } } } while (0)
struct XcdBarrier { unsigned* bar; unsigned x; volatile LAS unsigned* st; };
__device__ __forceinline__ XcdBarrier xcd_barrier_post(unsigned* bar, volatile LAS unsigned* st) {
    XcdBarrier b; b.bar = bar; b.x = xb_xcc_id(); b.st = st;
    if (threadIdx.x == 0) (void)xb_add(&bar[XB_XCNT(b.x)], 1u);
    return b;
}
__device__ __forceinline__ void xcd_barrier_complete(unsigned* bar, unsigned x, unsigned& nloc, unsigned& nx) {
    const unsigned G = gridDim.x * gridDim.y * gridDim.z;
    unsigned sum, cnt, mine, sp = 0u;
    for (;;) {
        sum = 0u; cnt = 0u; mine = 0u;
#pragma unroll
        for (unsigned j = 0; j < 16; ++j) { const unsigned c = xb_ld(&bar[XB_XCNT(j)]); sum += c; cnt += (c > 0u) ? 1u : 0u; mine = (j == x) ? c : mine; }
        if (sum == G) break;
        __builtin_amdgcn_s_sleep(1);
        if ((++sp & 255u) == 0u) { if (xb_ld(&bar[XB_TMO])) break; if (sp > XB_SPIN_CAP) { atomicAdd(&bar[XB_TMO], 1u); break; } }
    }
    nloc = mine > 0u ? mine : 1u; nx = cnt > 0u ? cnt : 1u;
}
__device__ __forceinline__ void xcd_barrier(const XcdBarrier& b) {
    asm volatile("s_waitcnt vmcnt(0)" ::: "memory");
    __syncthreads();
    if (threadIdx.x == 0) {
        unsigned* bar = b.bar;
        __builtin_amdgcn_s_waitcnt(0);
        unsigned nloc = b.st[0], nx = b.st[1];
        if (nloc == 0u) { xcd_barrier_complete(bar, b.x, nloc, nx); b.st[0] = nloc; b.st[1] = nx; }
        const unsigned old = xb_add(&bar[XB_XSUB(b.x)], 1u);
        const unsigned gen = old / nloc;
        if (old + 1u == (gen + 1u) * nloc) {
            __builtin_amdgcn_fence(__ATOMIC_RELEASE, "agent");
            asm volatile("s_waitcnt vmcnt(0)" ::: "memory");
            const unsigned og = xb_add(&bar[XB_TOP], 1u);
            const unsigned tg = og / nx;
            if (og + 1u == (tg + 1u) * nx) xb_add(&bar[XB_TOPGEN], 1u);
            else XB_SPIN(xb_ld(&bar[XB_TOPGEN]) == tg, bar);
            __builtin_amdgcn_fence(__ATOMIC_ACQUIRE, "agent");
            xb_add(&bar[XB_XGEN(b.x)], 1u);
            asm volatile("s_waitcnt vmcnt(0)" ::: "memory");
        } else {
            XB_SPIN(xb_ld(&bar[XB_XGEN(b.x)]) == gen, bar);
            __builtin_amdgcn_fence(__ATOMIC_ACQUIRE, "agent");
            asm volatile("s_waitcnt vmcnt(0)" ::: "memory");
        }
    }
    __syncthreads();
}

struct Args { const void* in[19]; float* out; unsigned char* ws; int ph_lo, ph_hi, li, pad; };
struct Frame {
    LAS unsigned char* lds;
    int tid, lane, wave, G, bid;
    const float *x, *mem; const int* pos;
    const float *g_mix, *w_in, *ret_gn_g, *sb_q_g, *sb_k_g, *w_out, *g_xattn, *g_mem, *w_xq, *w_xkv, *xq_g, *xk_g, *w_xo, *g_mlp, *w_up, *w_down;
    float* out; unsigned char* ws;
};

__device__ __forceinline__ int inproj_src_col(int np) {
    const int pn = np >> 8, p = np & 255, seg = pn >> 1, half = pn & 1, bj = p >> 7, wc = (p >> 5) & 3, i = p & 31;
    if (seg <= 1) { const int h = 2 * half + bj, g = 4 * wc + (i >> 3), e = i & 7; return seg * 512 + h * 128 + (e < 4 ? 4 * g + e : 64 + 4 * g + e - 4); }
    if (seg == 4 || seg == 5) { const int head = 4 * half + wc; return seg * 512 + head * 64 + 32 * bj + i; }
    return np;
}
template <bool PERM_IN>
__device__ void conv_weight(const Frame& F, const float* W, const float* g, bf16* Wt, int K, int N) {
    LAS float* T = (LAS float*)F.lds;
    const int tk = K / 64, tn = N / 64, nt = tk * tn;
    for (int t = F.bid; t < nt; t += F.G) {
        const int k0 = (t / tn) * 64, n0 = (t % tn) * 64;
        __syncthreads();
#pragma unroll
        for (int i = 0; i < 2; ++i) {
            const int r = (F.tid >> 4) + 32 * i, c = (F.tid & 15) * 4;
            const int sc = PERM_IN ? inproj_src_col(n0 + c) : n0 + c;
            f32x4 v = *(const f32x4*)(W + (size_t)(k0 + r) * N + sc);
            const float gg = g ? g[k0 + r] : 1.f;
            T[r * 65 + c + 0] = v[0] * gg; T[r * 65 + c + 1] = v[1] * gg; T[r * 65 + c + 2] = v[2] * gg; T[r * 65 + c + 3] = v[3] * gg;
        }
        __syncthreads();
#pragma unroll
        for (int i = 0; i < 2; ++i) {
            const int n = (F.tid >> 4) + 32 * i, k = (F.tid & 15) * 4;
            u32x2 o; o[0] = pk2(T[(k + 0) * 65 + n], T[(k + 1) * 65 + n]); o[1] = pk2(T[(k + 2) * 65 + n], T[(k + 3) * 65 + n]);
            *(u32x2*)(Wt + (size_t)(n0 + n) * K + k0 + k) = o;
        }
    }
    __syncthreads();
}
__device__ void rows_prep(const Frame& F, const float* X, bf16* Xb, float* rinv, int rows) {
    const int gw = F.bid * NWAVES + F.wave, GW = F.G * NWAVES;
    for (int r = gw; r < rows; r += GW) {
        float ss = 0.f;
#pragma unroll
        for (int i = 0; i < 4; ++i) {
            const int c = i * 256 + F.lane * 4;
            f32x4 v = *(const f32x4*)(X + (size_t)r * DM + c);
            ss += v[0] * v[0] + v[1] * v[1] + v[2] * v[2] + v[3] * v[3];
            u32x2 o; o[0] = pk2(v[0], v[1]); o[1] = pk2(v[2], v[3]);
            *(u32x2*)(Xb + (size_t)r * DM + c) = o;
        }
        ss = wave_sum(ss);
        if (F.lane == 0) rinv[r] = rsqrtf(ss * (1.f / DM) + EPS);
    }
}
__device__ void rope_table(const Frame& F, float2* cs) {
    const int total = M * 64;
    for (int e = F.bid * NTHR + F.tid; e < total; e += F.G * NTHR) {
        const int row = e >> 6, j = e & 63;
        const double ang = (double)F.pos[row] * INVF[j];
        const double rev = ang * 0.15915494309189535;
        const float fr = (float)(rev - floor(rev));
        float2 o; o.x = __builtin_amdgcn_cosf(fr); o.y = __builtin_amdgcn_sinf(fr);
        cs[e] = o;
    }
}

namespace pg8 {
#define PG8_LAS __attribute__((address_space(3)))
typedef unsigned short bf16_t;
typedef short bf16x8 __attribute__((ext_vector_type(8)));
typedef float f32x4 __attribute__((ext_vector_type(4)));
typedef unsigned u32x4 __attribute__((ext_vector_type(4)));
constexpr int BM = 256, BK = 64, HALF = 128, HTB = HALF * BK * 2  , STAGE_BYTES = 8 * HTB, NXCD = 8, WGM = 8;

__host__ __device__ __forceinline__ int lds_byte(int r, int c) { const int st = (r >> 4) * 2 + (c >> 5), rr = r & 15, cc = c & 31, ob = rr * 64 + cc * 2; return st * 1024 + (ob ^ (((ob >> 9) & 1) << 5)); }
__host__ __device__ __forceinline__ void stage_rc(int b, int& R, int& C) { const int st = b / 1024, sb = b % 1024, swz = sb ^ (((sb >> 9) & 1) << 5); R = (st >> 1) * 16 + swz / 64; C = (st & 1) * 32 + (swz % 64) / 2; }
__host__ __device__ __forceinline__ int perm32(int rho) { const int n = rho >> 4, i = rho & 15; return 8 * (i >> 2) + 4 * n + (i & 3); }

struct Unit { int pm, pn; };
struct Gemm { const bf16_t* A; const bf16_t* Bt; int M, N, K; };

struct StaticOrder {
    int nM, nN, nwg, G, c;
    __host__ __device__ void init(int M, int N, int G_, int c_) { nM = M / BM; nN = N / BM; nwg = nM * nN; G = G_; c = c_; }
    __host__ __device__ bool next(int i, Unit& u) const {
        const long L = (long)i * G + c; if (L >= nwg) return false;
        int wgid = (int)L; { const int q = nwg / NXCD, r = nwg % NXCD, xcd = wgid % NXCD, off = wgid / NXCD; wgid = (xcd < r ? xcd * (q + 1) : r * (q + 1) + (xcd - r) * q) + off; }
        const int nig = WGM * nN, gid = wgid / nig, fm = gid * WGM, gsz = (nM - fm) < WGM ? (nM - fm) : WGM;
        u.pm = fm + ((wgid % nig) % gsz); u.pn = (wgid % nig) / gsz; return true;
    }
    __device__ __forceinline__ void a_ready(const Unit&) const {}
    __device__ __forceinline__ void done(const Unit&) const {}
};

__device__ __forceinline__ unsigned cvt_pk_bf16(float lo, float hi) { unsigned r; asm volatile("v_cvt_pk_bf16_f32 %0, %1, %2" : "=v"(r) : "v"(lo), "v"(hi)); return r; }
template <class Epi, class Sched, bool ALIGN_EPI = false, bool SP2 = false>
__device__ __forceinline__ void gemm_phase(PG8_LAS unsigned char* lds, const Gemm g, const Sched& S, const Epi& E) {
    const int tid = threadIdx.x, wid = __builtin_amdgcn_readfirstlane(tid >> 6), lane = tid & 63, wr = wid >> 2, wc = wid & 3, fr = lane & 15, fq = lane >> 4;
    const int K = g.K, nt = K / BK;
    unsigned voffA[2], voffB[2];
#pragma unroll
    for (int i = 0; i < 2; ++i) { int R, C; stage_rc(tid * 16 + i * 8192, R, C); const int Rb = Epi::PERM ? ((R & ~31) + perm32(R & 31)) : R;
        voffA[i] = (unsigned)(R * K + C) * 2u; voffB[i] = (unsigned)(Rb * K + C) * 2u; }
    const size_t kstep = (size_t)(BK * 2);
    const size_t hstep = (size_t)HALF * K * 2;
    const size_t tstep = 2 * hstep;
    const unsigned ldsw = (unsigned)wid * 1024u;
    const int aoff = lds_byte(wr * 64 + fr, fq * 8), boff = lds_byte(wc * 32 + fr, fq * 8);
#define PG8_SA(b, h) (((b) * 2 + (h)) * HTB)
#define PG8_SB(b, h) ((4 + (b) * 2 + (h)) * HTB)
#define PG8_STAGE(bufoff, gbase, voff) do { _Pragma("unroll") for (int _i = 0; _i < 2; ++_i) \
        __builtin_amdgcn_global_load_lds((const unsigned*)((const char*)(gbase) + (voff)[_i]), (PG8_LAS unsigned*)(lds + (bufoff) + ldsw + _i * 8192), 16, 0, 0); } while (0)
#define PG8_LDA(dst, b, h) do { _Pragma("unroll") for (int m = 0; m < 4; ++m) _Pragma("unroll") for (int k = 0; k < 2; ++k) dst[m][k] = *(const PG8_LAS bf16x8*)(lds + PG8_SA(b, h) + aoff + m * 2048 + k * 1024); } while (0)
#define PG8_LDB(dst, b, h) do { _Pragma("unroll") for (int n = 0; n < 2; ++n) _Pragma("unroll") for (int k = 0; k < 2; ++k) dst[n][k] = *(const PG8_LAS bf16x8*)(lds + PG8_SB(b, h) + boff + n * 2048 + k * 1024); } while (0)
#define PG8_MMA(ai, bj, At, Bt) do { __builtin_amdgcn_s_setprio(1); _Pragma("unroll") for (int m = 0; m < 4; ++m) _Pragma("unroll") for (int n = 0; n < 2; ++n) _Pragma("unroll") for (int k = 0; k < 2; ++k) \
        acc[ai][bj][m][n] = __builtin_amdgcn_mfma_f32_16x16x32_bf16(Bt[n][k], At[m][k], acc[ai][bj][m][n], 0, 0, 0); __builtin_amdgcn_s_setprio(0); } while (0)
#define PG8_WAIT_V(n) asm volatile("s_waitcnt vmcnt(" #n ")" ::: "memory")
#define PG8_WAIT_L(n) asm volatile("s_waitcnt lgkmcnt(" #n ")" ::: "memory")
#define PG8_BAR __builtin_amdgcn_s_barrier()
#define PG8_SCHED __builtin_amdgcn_sched_barrier(0)
    Unit cur, nxt; int ui = 0;
    if (!S.next(0, cur)) return;
    f32x4 acc[2][2][4][2];
#pragma unroll
    for (int a = 0; a < 2; ++a)
#pragma unroll
        for (int b = 0; b < 2; ++b)
#pragma unroll
            for (int m = 0; m < 4; ++m)
#pragma unroll
                for (int n = 0; n < 2; ++n) acc[a][b][m][n] = (f32x4){0.f, 0.f, 0.f, 0.f};
    bf16x8 At[4][2], B0[2][2], B1[2][2];
    const char* cA = (const char*)g.A + (size_t)cur.pm * tstep; const char* cB = (const char*)g.Bt + (size_t)cur.pn * tstep;
    S.a_ready(cur);
    if constexpr (SP2) {
        PG8_STAGE(PG8_SB(0, 0), cB, voffB); PG8_STAGE(PG8_SB(0, 1), cB + hstep, voffB); PG8_STAGE(PG8_SA(0, 0), cA, voffA); PG8_STAGE(PG8_SA(0, 1), cA + hstep, voffA);
        if (wr == 1) PG8_BAR;
        PG8_WAIT_V(2); PG8_BAR;
        PG8_STAGE(PG8_SB(1, 0), cB + kstep, voffB); PG8_STAGE(PG8_SA(1, 0), cA + kstep, voffA); PG8_STAGE(PG8_SB(1, 1), cB + hstep + kstep, voffB);
        PG8_WAIT_V(6); PG8_BAR;
    } else {
        PG8_STAGE(PG8_SB(0, 0), cB, voffB); PG8_STAGE(PG8_SA(0, 0), cA, voffA); PG8_STAGE(PG8_SB(0, 1), cB + hstep, voffB); PG8_STAGE(PG8_SA(0, 1), cA + hstep, voffA);
        if (wr == 1) PG8_BAR;
        PG8_WAIT_V(4); PG8_BAR;
        PG8_STAGE(PG8_SB(1, 0), cB + kstep, voffB); PG8_STAGE(PG8_SA(1, 0), cA + kstep, voffA); PG8_STAGE(PG8_SB(1, 1), cB + hstep + kstep, voffB);
        PG8_WAIT_V(6); PG8_BAR;
    }
    for (;;) {
        const bool has_next = S.next(ui + 1, nxt);
        const char* nA = has_next ? (const char*)g.A + (size_t)nxt.pm * tstep : cA; const char* nB = has_next ? (const char*)g.Bt + (size_t)nxt.pn * tstep : cB;
        for (int t = 0; t < nt; t += 2) {
            const bool last = (t == nt - 2);
            const char* a1 = cA + (size_t)(t + 1) * kstep;
            const char* a2 = last ? nA : cA + (size_t)(t + 2) * kstep; const char* b2 = last ? nB : cB + (size_t)(t + 2) * kstep;
            const char* a3 = a2 + kstep; const char* b3 = b2 + kstep;
            if (last && has_next) S.a_ready(nxt);
            if constexpr (SP2) {
            PG8_LDB(B0, 0, 0); PG8_LDB(B1, 0, 1); PG8_SCHED; PG8_LDA(At, 0, 0); PG8_STAGE(PG8_SA(1, 1), a1 + hstep, voffA);
            PG8_WAIT_V(8); PG8_WAIT_L(0); PG8_BAR; PG8_MMA(0, 0, At, B0); PG8_MMA(0, 1, At, B1); PG8_BAR; PG8_SCHED;
            PG8_LDA(At, 0, 1); PG8_STAGE(PG8_SB(0, 0), b2, voffB); PG8_STAGE(PG8_SB(0, 1), b2 + hstep, voffB); PG8_STAGE(PG8_SA(0, 0), a2, voffA);
            PG8_WAIT_V(8); PG8_WAIT_L(0); PG8_BAR; PG8_MMA(1, 0, At, B0); PG8_MMA(1, 1, At, B1); PG8_BAR; PG8_SCHED;
            PG8_LDB(B0, 1, 0); PG8_LDB(B1, 1, 1); PG8_SCHED; PG8_LDA(At, 1, 0); PG8_STAGE(PG8_SA(0, 1), a2 + hstep, voffA);
            PG8_WAIT_V(8); PG8_WAIT_L(0); PG8_BAR; PG8_MMA(0, 0, At, B0); PG8_MMA(0, 1, At, B1); PG8_BAR; PG8_SCHED;
            PG8_LDA(At, 1, 1); PG8_STAGE(PG8_SB(1, 0), b3, voffB); PG8_STAGE(PG8_SB(1, 1), b3 + hstep, voffB); PG8_STAGE(PG8_SA(1, 0), a3, voffA);
            PG8_WAIT_V(8); PG8_WAIT_L(0); PG8_BAR; PG8_MMA(1, 0, At, B0); PG8_MMA(1, 1, At, B1); PG8_BAR; PG8_SCHED;
            } else {
            PG8_LDB(B0, 0, 0); PG8_SCHED; PG8_LDA(At, 0, 0); PG8_STAGE(PG8_SA(1, 1), a1 + hstep, voffA);
            PG8_WAIT_L(8); PG8_BAR; PG8_WAIT_L(0); PG8_MMA(0, 0, At, B0); PG8_BAR; PG8_SCHED;
            PG8_LDB(B1, 0, 1); PG8_STAGE(PG8_SB(0, 0), b2, voffB);
            PG8_BAR; PG8_WAIT_L(0); PG8_MMA(0, 1, At, B1); PG8_BAR;
            PG8_LDA(At, 0, 1); PG8_STAGE(PG8_SA(0, 0), a2, voffA);
            PG8_BAR; PG8_WAIT_L(0); PG8_MMA(1, 0, At, B0); PG8_BAR; PG8_SCHED;
            PG8_STAGE(PG8_SB(0, 1), b2 + hstep, voffB);
            PG8_WAIT_V(6); PG8_BAR; PG8_MMA(1, 1, At, B1); PG8_BAR;
            PG8_LDB(B0, 1, 0); PG8_SCHED; PG8_LDA(At, 1, 0); PG8_STAGE(PG8_SA(0, 1), a2 + hstep, voffA);
            PG8_WAIT_L(8); PG8_BAR; PG8_WAIT_L(0); PG8_MMA(0, 0, At, B0); PG8_BAR; PG8_SCHED;
            PG8_LDB(B1, 1, 1); PG8_STAGE(PG8_SB(1, 0), b3, voffB);
            PG8_BAR; PG8_WAIT_L(0); PG8_MMA(0, 1, At, B1); PG8_BAR;
            PG8_LDA(At, 1, 1); PG8_STAGE(PG8_SA(1, 0), a3, voffA);
            PG8_BAR; PG8_WAIT_L(0); PG8_MMA(1, 0, At, B0); PG8_BAR; PG8_SCHED;
            PG8_STAGE(PG8_SB(1, 1), b3 + hstep, voffB);
            PG8_WAIT_V(6); PG8_BAR; PG8_MMA(1, 1, At, B1); PG8_BAR;
            }
        }
        if constexpr (ALIGN_EPI) { if (wr == 0) PG8_BAR; }
        if constexpr (!Epi::AFTER_DRAIN) { E(acc, cur, wr, wc, fr, fq); S.done(cur); }
        if (!has_next) break;
#pragma unroll
        for (int a = 0; a < 2; ++a)
#pragma unroll
            for (int b = 0; b < 2; ++b)
#pragma unroll
                for (int m = 0; m < 4; ++m)
#pragma unroll
                    for (int n = 0; n < 2; ++n) acc[a][b][m][n] = (f32x4){0.f, 0.f, 0.f, 0.f};
        cur = nxt; cA = nA; cB = nB; ++ui;
        if constexpr (ALIGN_EPI) { if (wr == 1) PG8_BAR; }
    }
    PG8_WAIT_V(0);
    if constexpr (!ALIGN_EPI) { if (wr == 0) PG8_BAR; }
    PG8_BAR;
    if constexpr (Epi::AFTER_DRAIN) { E.fused(acc, cur, wr, wc, fr, fq, lds, wid, lane); S.done(cur); }
#undef PG8_SA
#undef PG8_SB
#undef PG8_STAGE
#undef PG8_LDA
#undef PG8_LDB
#undef PG8_MMA
#undef PG8_WAIT_V
#undef PG8_WAIT_L
#undef PG8_BAR
#undef PG8_SCHED
}
}

__device__ __forceinline__ float sum16(const float* p) { const f32x4 a = *(const f32x4*)p, b = *(const f32x4*)(p + 4), c = *(const f32x4*)(p + 8), d = *(const f32x4*)(p + 12); const f32x4 t = (a + b) + (c + d); return (t[0] + t[1]) + (t[2] + t[3]); }
__device__ __forceinline__ u32x4 pack8u(const f32x4& a, const f32x4& b) { u32x4 w; w[0] = pg8::cvt_pk_bf16(a[0], a[1]); w[1] = pg8::cvt_pk_bf16(a[2], a[3]); w[2] = pg8::cvt_pk_bf16(b[0], b[1]); w[3] = pg8::cvt_pk_bf16(b[2], b[3]); return w; }
__device__ __forceinline__ void store_T8(bf16* T, size_t chan0, int sq, const u32x4& w) {
    bf16* t = T + chan0 * SEQ + sq;
#pragma unroll
    for (int e = 0; e < 4; ++e) { t[(size_t)(2 * e) * SEQ] = (bf16)(w[e] & 0xffffu); t[(size_t)(2 * e + 1) * SEQ] = (bf16)(w[e] >> 16); }
}
struct EpiInProj {
    static constexpr bool PERM = true, AFTER_DRAIN = false;
    bf16* proj; const float* rinv1; const float2* cs; const float* sb_q_g; const float* sb_k_g; bf16* T;
    __device__ __forceinline__ void operator()(const f32x4 (&acc)[2][2][4][2], const pg8::Unit& u, int wr, int wc, int fr, int fq) const {
        const int pn = u.pn, seg = pn >> 1, half = pn & 1;
#pragma unroll
        for (int ai = 0; ai < 2; ++ai)
#pragma unroll
            for (int m = 0; m < 4; ++m) {
                const int gr = u.pm * 256 + ai * 128 + wr * 64 + m * 16 + fr, b = gr >> 12, sq = gr & (SEQ - 1);
                const float s = rinv1[gr];
                f32x4 a[2][2];
#pragma unroll
                for (int bj = 0; bj < 2; ++bj) { a[bj][0] = acc[ai][bj][m][0] * s; a[bj][1] = acc[ai][bj][m][1] * s; }
                if (seg <= 1) {
                    const int g = 4 * wc + fq;
                    const f32x4* c4 = (const f32x4*)(cs + (size_t)gr * 64 + 4 * g);
                    const f32x4 c01 = c4[0], c23 = c4[1];
                    const f32x4 cosv = (f32x4){c01[0], c01[2], c23[0], c23[2]}, sinv = (f32x4){c01[1], c01[3], c23[1], c23[3]};
                    const float eidx = (float)((gr & 127) + 1);
#pragma unroll
                    for (int bj = 0; bj < 2; ++bj) {
                        const int h = 2 * half + bj;
                        const float e = eidx * lg2gamma(h);
                        const float sc = (seg == 0) ? __builtin_amdgcn_exp2f(e) : 0.08838834764831845f * __builtin_amdgcn_exp2f(-e);
                        const f32x4 x = a[bj][0], y = a[bj][1];
                        const f32x4 o1 = (x * cosv - y * sinv) * sc, o2 = (y * cosv + x * sinv) * sc;
                        const u32x4 w = pack8u(o1, o2);
                        *(u32x4*)(proj + (size_t)gr * NPROJ + (seg == 0 ? P_RQ : P_RK) + h * 128 + 8 * g) = w;
                        if (seg == 1) store_T8(T, (size_t)b * NT + TC_RK + h * 128 + 8 * g, sq, w);
                    }
                } else if (seg == 4 || seg == 5) {
                    float ss = 0.f;
#pragma unroll
                    for (int bj = 0; bj < 2; ++bj)
#pragma unroll
                        for (int n = 0; n < 2; ++n) { const f32x4 t = a[bj][n] * a[bj][n]; ss += (t[0] + t[1]) + (t[2] + t[3]); }
                    ss += __shfl_xor(ss, 16); ss += __shfl_xor(ss, 32);
                    const float inv = rsqrtf(ss * (1.f / 64.f) + EPS);
                    const int head = 4 * half + wc;
                    const float* gp = (seg == 4 ? sb_q_g : sb_k_g) + head * 64 + 8 * fq;
#pragma unroll
                    for (int bj = 0; bj < 2; ++bj) {
                        const f32x4 g0 = *(const f32x4*)(gp + 32 * bj), g1 = *(const f32x4*)(gp + 32 * bj + 4);
                        const u32x4 w = pack8u(a[bj][0] * g0 * inv, a[bj][1] * g1 * inv);
                        *(u32x4*)(proj + (size_t)gr * NPROJ + (seg == 4 ? P_SQ : P_SK) + head * 64 + 32 * bj + 8 * fq) = w;
                    }
                } else if (seg == 3) {
#pragma unroll
                    for (int bj = 0; bj < 2; ++bj) *(u32x4*)(proj + (size_t)gr * NPROJ + P_RG + half * 256 + 128 * bj + 32 * wc + 8 * fq) = pack8u(a[bj][0], a[bj][1]);
                } else {
                    const int chb = (seg == 2 ? TC_RV : TC_SV) + half * 256 + 32 * wc + 8 * fq;
#pragma unroll
                    for (int bj = 0; bj < 2; ++bj) store_T8(T, (size_t)b * NT + chb + 128 * bj, sq, pack8u(a[bj][0], a[bj][1]));
                }
            }
    }
};
struct EpiResid {
    static constexpr bool PERM = true, AFTER_DRAIN = false;
    const float* resid; float* out; bf16* xb; float* ssq;
    __device__ __forceinline__ void operator()(const f32x4 (&acc)[2][2][4][2], const pg8::Unit& u, int wr, int wc, int fr, int fq) const {
#pragma unroll
        for (int ai = 0; ai < 2; ++ai)
#pragma unroll
            for (int m = 0; m < 4; ++m) {
                const int gr = u.pm * 256 + ai * 128 + wr * 64 + m * 16 + fr;
                float ss = 0.f;
#pragma unroll
                for (int bj = 0; bj < 2; ++bj) {
                    const size_t o = (size_t)gr * DM + u.pn * 256 + 128 * bj + 32 * wc + 8 * fq;
                    const f32x4 v0 = acc[ai][bj][m][0] + *(const f32x4*)(resid + o), v1 = acc[ai][bj][m][1] + *(const f32x4*)(resid + o + 4);
                    *(f32x4*)(out + o) = v0; *(f32x4*)(out + o + 4) = v1;
                    *(u32x4*)(xb + o) = pack8u(v0, v1);
                    const f32x4 t = v0 * v0 + v1 * v1; ss += (t[0] + t[1]) + (t[2] + t[3]);
                }
                ss += __shfl_xor(ss, 16); ss += __shfl_xor(ss, 32);
                if (fq == 0) ssq[(size_t)gr * 16 + u.pn * 4 + wc] = ss;
            }
    }
};
struct EpiXQ {
    static constexpr bool PERM = true, AFTER_DRAIN = false;
    bf16* xq; const float* ssq2; float* ssqq;
    __device__ __forceinline__ void operator()(const f32x4 (&acc)[2][2][4][2], const pg8::Unit& u, int wr, int wc, int fr, int fq) const {
#pragma unroll
        for (int ai = 0; ai < 2; ++ai)
#pragma unroll
            for (int m = 0; m < 4; ++m) {
                const int gr = u.pm * 256 + ai * 128 + wr * 64 + m * 16 + fr;
                const float rinv = rsqrtf(sum16(ssq2 + (size_t)gr * 16) * (1.f / DM) + EPS);
                float ss = 0.f;
#pragma unroll
                for (int bj = 0; bj < 2; ++bj) {
                    const f32x4 v0 = acc[ai][bj][m][0] * rinv, v1 = acc[ai][bj][m][1] * rinv;
                    *(u32x4*)(xq + (size_t)gr * DM + u.pn * 256 + 128 * bj + 32 * wc + 8 * fq) = pack8u(v0, v1);
                    const f32x4 t = v0 * v0 + v1 * v1; ss += (t[0] + t[1]) + (t[2] + t[3]);
                }
                ss += __shfl_xor(ss, 16); ss += __shfl_xor(ss, 32);
                if (fq == 0) ssqq[(size_t)gr * 16 + u.pn * 4 + wc] = ss;
            }
    }
};
struct EpiUp {
    static constexpr bool PERM = true, AFTER_DRAIN = false;
    bf16* hid; const float* ssq3;
    __device__ __forceinline__ void operator()(const f32x4 (&acc)[2][2][4][2], const pg8::Unit& u, int wr, int wc, int fr, int fq) const {
#pragma unroll
        for (int ai = 0; ai < 2; ++ai)
#pragma unroll
            for (int m = 0; m < 4; ++m) {
                const int gr = u.pm * 256 + ai * 128 + wr * 64 + m * 16 + fr;
                const float rinv = rsqrtf(sum16(ssq3 + (size_t)gr * 16) * (1.f / DM) + EPS);
#pragma unroll
                for (int bj = 0; bj < 2; ++bj) {
                    f32x4 v0 = acc[ai][bj][m][0] * rinv, v1 = acc[ai][bj][m][1] * rinv;
#pragma unroll
                    for (int e = 0; e < 4; ++e) { const float t0 = fmaxf(v0[e], 0.f), t1 = fmaxf(v1[e], 0.f); v0[e] = t0 * t0; v1[e] = t1 * t1; }
                    *(u32x4*)(hid + (size_t)gr * FF + u.pn * 256 + 128 * bj + 32 * wc + 8 * fq) = pack8u(v0, v1);
                }
            }
    }
};
struct EpiDown {
    static constexpr bool PERM = true, AFTER_DRAIN = false;
    float* out;
    __device__ __forceinline__ void operator()(const f32x4 (&acc)[2][2][4][2], const pg8::Unit& u, int wr, int wc, int fr, int fq) const {
#pragma unroll
        for (int ai = 0; ai < 2; ++ai)
#pragma unroll
            for (int m = 0; m < 4; ++m) {
                const int gr = u.pm * 256 + ai * 128 + wr * 64 + m * 16 + fr;
#pragma unroll
                for (int bj = 0; bj < 2; ++bj) {
                    const size_t o = (size_t)gr * DM + u.pn * 256 + 128 * bj + 32 * wc + 8 * fq;
                    const f32x4 r0 = *(const f32x4*)(out + o), r1 = *(const f32x4*)(out + o + 4);
                    *(f32x4*)(out + o) = acc[ai][bj][m][0] + r0; *(f32x4*)(out + o + 4) = acc[ai][bj][m][1] + r1;
                }
            }
    }
};
template <class Epi>
__device__ __forceinline__ void gemm_big(const Frame& F, const bf16* A, const bf16* Bt, int N, int K, const Epi& E) {
    pg8::Gemm g{A, Bt, M, N, K}; pg8::StaticOrder S; S.init(M, N, F.G, F.bid);
    pg8::gemm_phase<Epi, pg8::StaticOrder, true, true>(F.lds, g, S, E);
}

constexpr int LDA_S = 72, LDC_S = 260;
template <class Epi>
__device__ void gemm_phase_v1(const Frame& F, const bf16* A, const bf16* Bt, int Mr, int N, int K, const Epi& E) {
    const int tid = F.tid, lane = F.lane, wave = F.wave;
    const int wr = wave >> 2, wc = wave & 3;
    const int nN = N / 256, nU = (Mr / 128) * nN, nk = K / 64;
    LAS bf16* As = (LAS bf16*)F.lds;
    LAS bf16* Bs = (LAS bf16*)(F.lds + 128 * LDA_S * 2);
    LAS float* Cs = (LAS float*)F.lds;
    const int lr = tid >> 3, lc = (tid & 7) * 8;
    for (int u = F.bid; u < nU; u += F.G) {
        const int pm = u / nN, pn = u % nN;
        const bf16* Ag = A + (size_t)(pm * 128 + lr) * K + lc;
        const bf16* Bg = Bt + (size_t)(pn * 256 + lr) * K + lc;
        f32x4 acc[4][4];
#pragma unroll
        for (int i = 0; i < 4; ++i)
#pragma unroll
            for (int j = 0; j < 4; ++j) acc[i][j] = (f32x4){0.f, 0.f, 0.f, 0.f};
        u32x4 ra[2], rb[4];
#pragma unroll
        for (int i = 0; i < 2; ++i) ra[i] = *(const u32x4*)(Ag + (size_t)(64 * i) * K);
#pragma unroll
        for (int i = 0; i < 4; ++i) rb[i] = *(const u32x4*)(Bg + (size_t)(64 * i) * K);
        for (int kt = 0; kt < nk; ++kt) {
            __syncthreads();
#pragma unroll
            for (int i = 0; i < 2; ++i) *(LAS u32x4*)(As + (lr + 64 * i) * LDA_S + lc) = ra[i];
#pragma unroll
            for (int i = 0; i < 4; ++i) *(LAS u32x4*)(Bs + (lr + 64 * i) * LDA_S + lc) = rb[i];
            __syncthreads();
            if (kt + 1 < nk) {
#pragma unroll
                for (int i = 0; i < 2; ++i) ra[i] = *(const u32x4*)(Ag + (size_t)(64 * i) * K + (kt + 1) * 64);
#pragma unroll
                for (int i = 0; i < 4; ++i) rb[i] = *(const u32x4*)(Bg + (size_t)(64 * i) * K + (kt + 1) * 64);
            }
#pragma unroll
            for (int kk = 0; kk < 2; ++kk) {
                bf16x8 a[4], b[4];
#pragma unroll
                for (int i = 0; i < 4; ++i) a[i] = *(LAS bf16x8*)(As + (wr * 64 + i * 16 + (lane & 15)) * LDA_S + kk * 32 + (lane >> 4) * 8);
#pragma unroll
                for (int j = 0; j < 4; ++j) b[j] = *(LAS bf16x8*)(Bs + (wc * 64 + j * 16 + (lane & 15)) * LDA_S + kk * 32 + (lane >> 4) * 8);
#pragma unroll
                for (int i = 0; i < 4; ++i)
#pragma unroll
                    for (int j = 0; j < 4; ++j) acc[i][j] = __builtin_amdgcn_mfma_f32_16x16x32_bf16(a[i], b[j], acc[i][j], 0, 0, 0);
            }
        }
        __syncthreads();
#pragma unroll
        for (int i = 0; i < 4; ++i)
#pragma unroll
            for (int j = 0; j < 4; ++j)
#pragma unroll
                for (int r = 0; r < 4; ++r) Cs[(wr * 64 + i * 16 + (lane >> 4) * 4 + r) * LDC_S + wc * 64 + j * 16 + (lane & 15)] = acc[i][j][r];
        __syncthreads();
        const bool tr = E.transposed(pn);
        for (int rr = 0; rr < 16; ++rr) {
            const int row = wave * 16 + rr;
            f32x4 v = *(LAS f32x4*)(Cs + row * LDC_S + lane * 4);
            v = E(v, pm * 128 + row, pn, lane);
            if (tr) *(LAS f32x4*)(Cs + row * LDC_S + lane * 4) = v;
        }
        if (tr) { __syncthreads(); E.store_T(Cs, pm, pn, tid); }
    }
    __syncthreads();
}

struct EpiMemKV {
    bf16* memk; bf16* memvT; const float* rinvm; const float* xk_g;
    __device__ __forceinline__ bool transposed(int pn) const { return pn >= 4; }
    __device__ __forceinline__ void store_T(LAS float* Cs, int pm, int pn, int tid) const {
#pragma unroll
        for (int it = 0; it < 8; ++it) {
            const int item = it * NTHR + tid, rg = item & 15, col = item >> 4;
            float f[8];
#pragma unroll
            for (int i = 0; i < 8; ++i) f[i] = Cs[(rg * 8 + i) * LDC_S + col];
            u32x4 o; o[0] = pk2(f[0], f[1]); o[1] = pk2(f[2], f[3]); o[2] = pk2(f[4], f[5]); o[3] = pk2(f[6], f[7]);
            const int row0 = pm * 128 + rg * 8, b = row0 / MEML, key = row0 % MEML;
            *(u32x4*)(memvT + ((size_t)(b * 4 + pn - 4) * 256 + col) * MEML + key) = o;
        }
    }
    __device__ __forceinline__ f32x4 operator()(f32x4 v, int gr, int pn, int lane) const {
        v = v * rinvm[gr];
        if (pn < 4) {
            float ss = wave_sum(v[0] * v[0] + v[1] * v[1] + v[2] * v[2] + v[3] * v[3]);
            const float inv = rsqrtf(ss * (1.f / 256.f) + EPS);
            const float* g = xk_g + pn * 256 + 4 * lane;
            v[0] *= inv * g[0]; v[1] *= inv * g[1]; v[2] *= inv * g[2]; v[3] *= inv * g[3];
            u32x2 o; o[0] = pk2(v[0], v[1]); o[1] = pk2(v[2], v[3]);
            *(u32x2*)(memk + (size_t)gr * DM + pn * 256 + 4 * lane) = o;
        }
        return v;
    }
};

typedef float f32x16 __attribute__((ext_vector_type(16)));
#define MFMA32(a, b, c) __builtin_amdgcn_mfma_f32_32x32x16_bf16((a), (b), (c), 0, 0, 0)
__device__ __forceinline__ bf16x8 pack8(float a0, float a1, float a2, float a3, float a4, float a5, float a6, float a7) {
    u32x4 p; p[0] = pk2(a0, a1); p[1] = pk2(a2, a3); p[2] = pk2(a4, a5); p[3] = pk2(a6, a7);
    return __builtin_bit_cast(bf16x8, p);
}
__device__ void sb_mfma(const Frame& F, const bf16* proj, const bf16* T, bf16* mix) {
    const int lane = F.lane, r = lane & 31, hh = lane >> 5;
    const int gw = F.bid * NWAVES + F.wave, GW = F.G * NWAVES;
    const float c1 = 0.18033688011112042f;
    for (int u = gw; u < BATCH * 8 * 128; u += GW) {
        const int qb = 127 - (u & 127), hd = (u >> 7) & 7, b = u >> 10;
        const int q0 = qb * 32;
        const float gq = wave_max(fabsf(F.sb_q_g[hd * 64 + lane])), gk = wave_max(fabsf(F.sb_k_g[hd * 64 + lane]));
        const float thresh = 152.f + c1 * 64.f * gq * gk * 1.02f;
        bf16x8 qf[4];
        {
            const bf16* qp = proj + ((size_t)b * SEQ + q0 + r) * NPROJ + P_SQ + hd * 64 + 8 * hh;
#pragma unroll
            for (int s = 0; s < 4; ++s) qf[s] = *(const bf16x8*)(qp + 16 * s);
        }
        f32x16 o0, o1;
#pragma unroll
        for (int i = 0; i < 16; ++i) { o0[i] = 0.f; o1[i] = 0.f; }
        float carry = 0.f;
        const bf16* vbase = T + ((size_t)b * NT + TC_SV + hd * 64 + r) * SEQ + 4 * hh;
        for (int k0 = q0; k0 >= 0; k0 -= 32) {
            bf16x8 kf[4];
            {
                const bf16* kp = proj + ((size_t)b * SEQ + k0 + r) * NPROJ + P_SK + hd * 64 + 8 * hh;
#pragma unroll
                for (int s = 0; s < 4; ++s) kf[s] = *(const bf16x8*)(kp + 16 * s);
            }
            u32x2 vl[2][2][2];
#pragma unroll
            for (int n = 0; n < 2; ++n)
#pragma unroll
                for (int ks = 0; ks < 2; ++ks) {
                    const bf16* vp = vbase + (size_t)(32 * n) * SEQ + k0 + 16 * ks;
                    vl[n][ks][0] = *(const u32x2*)(vp); vl[n][ks][1] = *(const u32x2*)(vp + 8);
                }
            f32x16 x;
#pragma unroll
            for (int i = 0; i < 16; ++i) x[i] = 0.f;
#pragma unroll
            for (int s = 0; s < 4; ++s) x = MFMA32(kf[s], qf[s], x);
            const bool diag = (k0 == q0);
            f32x16 tt, ll;
#pragma unroll
            for (int i = 0; i < 16; ++i) {
                const int key = (i & 3) + 8 * (i >> 2) + 4 * hh;
                const bool valid = !diag || (key < r);
                const float t = x[i] * c1;
                const float l = __builtin_amdgcn_logf(1.f + __builtin_amdgcn_exp2f(t));
                tt[i] = valid ? t : -1e30f; ll[i] = valid ? l : 0.f;
            }
            float gt[4], pt[4];
#pragma unroll
            for (int g = 0; g < 4; ++g) {
                ll[4 * g + 2] += ll[4 * g + 3]; ll[4 * g + 1] += ll[4 * g + 2]; ll[4 * g] += ll[4 * g + 1];
                gt[g] = ll[4 * g]; pt[g] = __shfl_xor(gt[g], 32);
            }
            const float T0 = gt[0] + pt[0], T1 = gt[1] + pt[1], T2 = gt[2] + pt[2], T3 = gt[3] + pt[3];
            const float R2 = T3, R1 = R2 + T2, R0 = R1 + T1;
            float bs[4];
            bs[0] = carry + R0 + (hh == 0 ? pt[0] : 0.f); bs[1] = carry + R1 + (hh == 0 ? pt[1] : 0.f);
            bs[2] = carry + R2 + (hh == 0 ? pt[2] : 0.f); bs[3] = carry + (hh == 0 ? pt[3] : 0.f);
            carry += R0 + T0;
#pragma unroll
            for (int i = 0; i < 16; ++i) x[i] = __builtin_amdgcn_exp2f(tt[i] - (bs[i >> 2] + ll[i]));
#pragma unroll
            for (int ks = 0; ks < 2; ++ks) {
                const bf16x8 pf = pack8(x[8 * ks], x[8 * ks + 1], x[8 * ks + 2], x[8 * ks + 3], x[8 * ks + 4], x[8 * ks + 5], x[8 * ks + 6], x[8 * ks + 7]);
                u32x4 v0; v0[0] = vl[0][ks][0][0]; v0[1] = vl[0][ks][0][1]; v0[2] = vl[0][ks][1][0]; v0[3] = vl[0][ks][1][1];
                u32x4 v1; v1[0] = vl[1][ks][0][0]; v1[1] = vl[1][ks][0][1]; v1[2] = vl[1][ks][1][0]; v1[3] = vl[1][ks][1][1];
                o0 = MFMA32(pf, __builtin_bit_cast(bf16x8, v0), o0);
                o1 = MFMA32(pf, __builtin_bit_cast(bf16x8, v1), o1);
            }
            if (__all(carry > thresh)) break;
        }
        bf16* op = mix + ((size_t)b * SEQ + q0 + 4 * hh) * DM + 512 + hd * 64 + r;
#pragma unroll
        for (int i = 0; i < 16; ++i) {
            const int qr = (i & 3) + 8 * (i >> 2);
            op[(size_t)qr * DM] = (bf16)f2bf(o0[i]);
            op[(size_t)qr * DM + 32] = (bf16)f2bf(o1[i]);
        }
    }
}
__device__ void ret_kv(const Frame& F, const bf16* T, float* KVs) {
    const int lane = F.lane, r = lane & 31, hh = lane >> 5, mt = F.wave >> 1, nt0 = (F.wave & 1) * 2;
    for (int u = F.bid; u < BATCH * 4 * 32; u += F.G) {
        const int c = u & 31, h = (u >> 5) & 3, b = u >> 7, s0 = c * 128;
        const bf16* vp = T + ((size_t)b * NT + TC_RV + h * 128 + 32 * mt + r) * SEQ + s0 + 8 * hh;
        const bf16* kp0 = T + ((size_t)b * NT + TC_RK + h * 128 + 32 * nt0 + r) * SEQ + s0 + 8 * hh;
        const bf16* kp1 = kp0 + (size_t)32 * SEQ;
        f32x16 a0, a1;
#pragma unroll
        for (int i = 0; i < 16; ++i) { a0[i] = 0.f; a1[i] = 0.f; }
#pragma unroll
        for (int ks = 0; ks < 8; ++ks) {
            const bf16x8 vf = *(const bf16x8*)(vp + 16 * ks), k0f = *(const bf16x8*)(kp0 + 16 * ks), k1f = *(const bf16x8*)(kp1 + 16 * ks);
            a0 = MFMA32(vf, k0f, a0); a1 = MFMA32(vf, k1f, a1);
        }
        const float g128 = __builtin_amdgcn_exp2f(128.f * lg2gamma(h));
        float* op = KVs + (size_t)u * 16384 + (size_t)(32 * mt + 4 * hh) * 128 + 32 * nt0 + r;
#pragma unroll
        for (int i = 0; i < 16; ++i) { const int row = (i & 3) + 8 * (i >> 2); op[row * 128] = a0[i] * g128; op[row * 128 + 32] = a1[i] * g128; }
    }
}
__device__ void ret_scan(const Frame& F, float* KVs, int wb, int nwb) {
    for (int it = (F.bid - wb) * NTHR + F.tid; it < 16 * 4096; it += nwb * NTHR) {
        const int bh = it >> 12, e4 = (it & 4095) * 4;
        const float g128 = __builtin_amdgcn_exp2f(128.f * lg2gamma(bh & 3));
        float* p = KVs + (size_t)bh * 32 * 16384 + e4;
        f32x4 st = (f32x4){0.f, 0.f, 0.f, 0.f};
#pragma unroll 1
        for (int cb = 0; cb < 4; ++cb) {
            f32x4 t[8];
#pragma unroll
            for (int c = 0; c < 8; ++c) t[c] = *(const f32x4*)(p + (size_t)(cb * 8 + c) * 16384);
#pragma unroll
            for (int c = 0; c < 8; ++c) { *(f32x4*)(p + (size_t)(cb * 8 + c) * 16384) = st; st = st * g128 + t[c]; }
        }
    }
}
__device__ void ret_out(const Frame& F, const bf16* proj, const bf16* T, const float* KVs, bf16* mix) {
    const int lane = F.lane, r = lane & 31, hh = lane >> 5;
    const int gw = F.bid * NWAVES + F.wave, GW = F.G * NWAVES;
    for (int wu = gw; wu < BATCH * 4 * 32 * 4; wu += GW) {
        const int u = wu >> 2, wq = wu & 3, c = u & 31, h = (u >> 5) & 3, b = u >> 7;
        const int q0 = c * 128 + 32 * wq;
        bf16x8 qf[8];
        {
            const bf16* qp = proj + ((size_t)b * SEQ + q0 + r) * NPROJ + P_RQ + h * 128 + 8 * hh;
#pragma unroll
            for (int s = 0; s < 8; ++s) qf[s] = *(const bf16x8*)(qp + 16 * s);
        }
        f32x16 o[4];
#pragma unroll
        for (int n = 0; n < 4; ++n)
#pragma unroll
            for (int i = 0; i < 16; ++i) o[n][i] = 0.f;
        {
            const float* sp = KVs + (size_t)u * 16384 + (size_t)r * 128 + 8 * hh;
#pragma unroll
            for (int n = 0; n < 4; ++n)
#pragma unroll
                for (int ks = 0; ks < 8; ++ks) {
                    const f32x4 lo = *(const f32x4*)(sp + n * 32 * 128 + 16 * ks), hi = *(const f32x4*)(sp + n * 32 * 128 + 16 * ks + 4);
                    o[n] = MFMA32(qf[ks], pack8(lo[0], lo[1], lo[2], lo[3], hi[0], hi[1], hi[2], hi[3]), o[n]);
                }
        }
        for (int kt = 0; kt <= wq; ++kt) {
            const int k0 = c * 128 + 32 * kt;
            f32x16 x;
#pragma unroll
            for (int i = 0; i < 16; ++i) x[i] = 0.f;
            {
                const bf16* kp = proj + ((size_t)b * SEQ + k0 + r) * NPROJ + P_RK + h * 128 + 8 * hh;
#pragma unroll
                for (int s = 0; s < 8; ++s) x = MFMA32(*(const bf16x8*)(kp + 16 * s), qf[s], x);
            }
            if (kt == wq) {
#pragma unroll
                for (int i = 0; i < 16; ++i) { const int key = (i & 3) + 8 * (i >> 2) + 4 * hh; x[i] = (key <= r) ? x[i] : 0.f; }
            }
#pragma unroll
            for (int ks = 0; ks < 2; ++ks) {
                const bf16x8 pf = pack8(x[8 * ks], x[8 * ks + 1], x[8 * ks + 2], x[8 * ks + 3], x[8 * ks + 4], x[8 * ks + 5], x[8 * ks + 6], x[8 * ks + 7]);
#pragma unroll
                for (int n = 0; n < 4; ++n) {
                    const bf16* vp = T + ((size_t)b * NT + TC_RV + h * 128 + 32 * n + r) * SEQ + k0 + 16 * ks + 4 * hh;
                    const u32x2 lo = *(const u32x2*)(vp), hi = *(const u32x2*)(vp + 8);
                    u32x4 vv; vv[0] = lo[0]; vv[1] = lo[1]; vv[2] = hi[0]; vv[3] = hi[1];
                    o[n] = MFMA32(pf, __builtin_bit_cast(bf16x8, vv), o[n]);
                }
            }
        }
#pragma unroll
        for (int i = 0; i < 16; ++i) {
            float ss = o[0][i] * o[0][i] + o[1][i] * o[1][i] + o[2][i] * o[2][i] + o[3][i] * o[3][i];
            ss += __shfl_xor(ss, 1); ss += __shfl_xor(ss, 2); ss += __shfl_xor(ss, 4); ss += __shfl_xor(ss, 8); ss += __shfl_xor(ss, 16);
            const float inv = rsqrtf(ss * (1.f / 128.f) + EPS);
            const size_t row = (size_t)b * SEQ + q0 + (i & 3) + 8 * (i >> 2) + 4 * hh;
#pragma unroll
            for (int n = 0; n < 4; ++n) {
                const int dv = h * 128 + 32 * n + r;
                const float g = bf2f(proj[row * NPROJ + P_RG + dv]);
                const float val = o[n][i] * inv * F.ret_gn_g[dv] * (g / (1.f + __expf(-g)));
                mix[row * DM + dv] = (bf16)f2bf(val);
            }
        }
    }
}
__device__ void xattn_mfma(const Frame& F, const bf16* xq, const float* ssqq, const bf16* memk, const bf16* memvT, bf16* xo) {
    const int lane = F.lane, r = lane & 31, hh = lane >> 5;
    LAS bf16* qs = (LAS bf16*)(F.lds + F.wave * 16896);
    const int gw = F.bid * NWAVES + F.wave, GW = F.G * NWAVES;
    for (int wu = gw; wu < BATCH * 4 * 128; wu += GW) {
        const int qb = wu & 127, h = (wu >> 7) & 3, b = wu >> 9, q0 = qb * 32;
        CBAR();
#pragma unroll
        for (int i = 0; i < 16; ++i) {
            const int id = i * 64 + lane, row = id >> 5, ch = id & 31;
            const size_t grow = (size_t)b * SEQ + q0 + row;
            const u32x4 v = *(const u32x4*)(xq + grow * DM + h * 256 + ch * 8);
            const f32x4 pq = *(const f32x4*)(ssqq + grow * 16 + h * 4);
            const float sc = rsqrtf(((pq[0] + pq[1]) + (pq[2] + pq[3])) * (1.f / 256.f) + EPS) * 0.09016844005556021f;
            const f32x4 g0 = *(const f32x4*)(F.xq_g + h * 256 + ch * 8), g1 = *(const f32x4*)(F.xq_g + h * 256 + ch * 8 + 4);
            u32x4 w;
            w[0] = pk2(bflo(v[0]) * sc * g0[0], bfhi(v[0]) * sc * g0[1]); w[1] = pk2(bflo(v[1]) * sc * g0[2], bfhi(v[1]) * sc * g0[3]);
            w[2] = pk2(bflo(v[2]) * sc * g1[0], bfhi(v[2]) * sc * g1[1]); w[3] = pk2(bflo(v[3]) * sc * g1[2], bfhi(v[3]) * sc * g1[3]);
            *(LAS u32x4*)(qs + row * 264 + ch * 8) = w;
        }
        CBAR();
        f32x16 o[8];
#pragma unroll
        for (int n = 0; n < 8; ++n)
#pragma unroll
            for (int i = 0; i < 16; ++i) o[n][i] = 0.f;
        float m = 0.f, l = 0.f;
        const bf16* vbase = memvT + ((size_t)(b * 4 + h) * 256 + r) * MEML + 4 * hh;
        for (int kt = 0; kt < 8; ++kt) {
            const int k0 = kt * 32;
            f32x16 x;
#pragma unroll
            for (int i = 0; i < 16; ++i) x[i] = 0.f;
            {
                const bf16* kp = memk + ((size_t)b * MEML + k0 + r) * DM + h * 256 + 8 * hh;
#pragma unroll
                for (int sg = 0; sg < 4; ++sg) {
#pragma unroll
                    for (int s = 4 * sg; s < 4 * sg + 4; ++s) x = MFMA32(*(const bf16x8*)(kp + 16 * s), *(LAS bf16x8*)(qs + r * 264 + 16 * s + 8 * hh), x);
                    __builtin_amdgcn_sched_barrier(0);
                }
            }
            float tmax = x[0];
#pragma unroll
            for (int i = 1; i < 16; ++i) tmax = fmaxf(tmax, x[i]);
            tmax = fmaxf(tmax, __shfl_xor(tmax, 32));
            if (kt == 0) m = tmax;
            else if (__any(tmax > m + 8.f)) {
                const float mn = fmaxf(m, tmax), alpha = __builtin_amdgcn_exp2f(m - mn);
                m = mn; l *= alpha;
#pragma unroll
                for (int i = 0; i < 16; ++i) {
                    const float ai = __shfl(alpha, (i & 3) + 8 * (i >> 2) + 4 * hh);
#pragma unroll
                    for (int n = 0; n < 8; ++n) o[n][i] *= ai;
                }
            }
            float ps = 0.f;
#pragma unroll
            for (int i = 0; i < 16; ++i) { x[i] = __builtin_amdgcn_exp2f(x[i] - m); ps += x[i]; }
            ps += __shfl_xor(ps, 32);
            l += ps;
#pragma unroll
            for (int ks = 0; ks < 2; ++ks) {
                const bf16x8 pf = pack8(x[8 * ks], x[8 * ks + 1], x[8 * ks + 2], x[8 * ks + 3], x[8 * ks + 4], x[8 * ks + 5], x[8 * ks + 6], x[8 * ks + 7]);
#pragma unroll
                for (int ng = 0; ng < 2; ++ng) {
#pragma unroll
                    for (int n = 4 * ng; n < 4 * ng + 4; ++n) {
                        const bf16* vp = vbase + (size_t)(32 * n) * MEML + k0 + 16 * ks;
                        const u32x2 lo = *(const u32x2*)(vp), hi = *(const u32x2*)(vp + 8);
                        u32x4 vv; vv[0] = lo[0]; vv[1] = lo[1]; vv[2] = hi[0]; vv[3] = hi[1];
                        o[n] = MFMA32(pf, __builtin_bit_cast(bf16x8, vv), o[n]);
                    }
                    __builtin_amdgcn_sched_barrier(0);
                }
            }
        }
        const float linv = 1.f / l;
#pragma unroll
        for (int i = 0; i < 16; ++i) {
            const int qr = (i & 3) + 8 * (i >> 2) + 4 * hh;
            const float li = __shfl(linv, qr);
            bf16* op = xo + ((size_t)b * SEQ + q0 + qr) * DM + h * 256 + r;
#pragma unroll
            for (int n = 0; n < 8; ++n) op[32 * n] = (bf16)f2bf(o[n][i] * li);
        }
    }
}

__global__ void __launch_bounds__(NTHR, 2) fwd_kernel(Args args) {
    extern __shared__ __attribute__((aligned(16))) unsigned char lds_raw[];
    Frame F;
    F.lds = (LAS unsigned char*)lds_raw;
    F.tid = threadIdx.x; F.lane = F.tid & 63; F.wave = __builtin_amdgcn_readfirstlane(F.tid >> 6);
    F.G = gridDim.x; F.bid = blockIdx.x;
    F.x = (const float*)args.in[0]; F.mem = (const float*)args.in[1]; F.pos = (const int*)args.in[2];
    F.g_mix = (const float*)args.in[3]; F.w_in = (const float*)args.in[4]; F.ret_gn_g = (const float*)args.in[5];
    F.sb_q_g = (const float*)args.in[6]; F.sb_k_g = (const float*)args.in[7]; F.w_out = (const float*)args.in[8];
    F.g_xattn = (const float*)args.in[9]; F.g_mem = (const float*)args.in[10]; F.w_xq = (const float*)args.in[11];
    F.w_xkv = (const float*)args.in[12]; F.xq_g = (const float*)args.in[13]; F.xk_g = (const float*)args.in[14];
    F.w_xo = (const float*)args.in[15]; F.g_mlp = (const float*)args.in[16]; F.w_up = (const float*)args.in[17]; F.w_down = (const float*)args.in[18];
    F.out = args.out; F.ws = args.ws;
    unsigned char* ws = args.ws;
    volatile LAS unsigned* MISC = (volatile LAS unsigned*)(F.lds + MISC_OFF);
    if (F.tid < 64) MISC[F.tid] = 0u;
    __syncthreads();
    XcdBarrier bar; bar.bar = (unsigned*)(ws + WS_CTL) + 1024 + args.li * 4096; bar.x = 0; bar.st = nullptr;
    if (MK_N_LAUNCHES != NPHASE) bar = xcd_barrier_post(bar.bar, MISC + 8);
#define GRID_BAR() do { if (MK_N_LAUNCHES != NPHASE) xcd_barrier(bar); } while (0)
    const int lo = args.ph_lo, hi = args.ph_hi;
#define IN(k) (lo <= (k) && (k) < hi)
#define BOTH(k) (IN(k) && IN((k) + 1))

    bf16* Wt_in = (bf16*)(ws + WS_WIN); bf16* Wt_out = (bf16*)(ws + WS_WOUT); bf16* Wt_xq = (bf16*)(ws + WS_WXQ); bf16* Wt_xkv = (bf16*)(ws + WS_WXKV);
    bf16* Wt_xo = (bf16*)(ws + WS_WXO); bf16* Wt_up = (bf16*)(ws + WS_WUP); bf16* Wt_dn = (bf16*)(ws + WS_WDN);
    float* rinv1 = (float*)(ws + WS_RINV1); float* rinvm = (float*)(ws + WS_RINVM); float* ssq2 = (float*)(ws + WS_SSQ2); float* ssq3 = (float*)(ws + WS_SSQ3); float* ssqq = (float*)(ws + WS_SSQQ);
    bf16* memb = (bf16*)(ws + WS_MEMB); bf16* memk = (bf16*)(ws + WS_MEMK); bf16* memvT = (bf16*)(ws + WS_MEMV);
    float2* cs = (float2*)(ws + WS_ROPE);
    bf16* xb = (bf16*)(ws + WS_XB); bf16* mix = (bf16*)(ws + WS_MIX); bf16* proj = (bf16*)(ws + WS_PROJ);
    bf16* x1b = (bf16*)(ws + WS_X1B); bf16* xq = (bf16*)(ws + WS_XQ); bf16* xo = (bf16*)(ws + WS_XO); bf16* x2b = (bf16*)(ws + WS_X2B); bf16* hid = (bf16*)(ws + WS_HID); bf16* T = (bf16*)(ws + WS_T); float* KVs = (float*)(ws + WS_KVS);

    if (IN(0)) {
        conv_weight<true>(F, F.w_in, F.g_mix, Wt_in, DM, NIN);
        conv_weight<false>(F, F.w_out, nullptr, Wt_out, DM, DM);
        conv_weight<false>(F, F.w_xq, F.g_xattn, Wt_xq, DM, DM);
        conv_weight<false>(F, F.w_xkv, F.g_mem, Wt_xkv, DM, 2 * DM);
        conv_weight<false>(F, F.w_xo, nullptr, Wt_xo, DM, DM);
        conv_weight<false>(F, F.w_up, F.g_mlp, Wt_up, DM, FF);
        conv_weight<false>(F, F.w_down, nullptr, Wt_dn, FF, DM);
        rows_prep(F, F.x, xb, rinv1, M);
        rows_prep(F, F.mem, memb, rinvm, MROWS);
        rope_table(F, cs);
        if (BOTH(0)) GRID_BAR();
    }
    if (IN(1)) {
        { EpiInProj E{proj, rinv1, cs, F.sb_q_g, F.sb_k_g, T}; gemm_big(F, xb, Wt_in, NIN, DM, E); }
        if (BOTH(1)) GRID_BAR();
    }
    if (IN(2)) {
        ret_kv(F, T, KVs);
        sb_mfma(F, proj, T, mix);
        if (BOTH(2)) GRID_BAR();
    }
    if (IN(3)) {
        const int nmk = (F.G > 128) ? 64 : 0;
        if (nmk == 0 || F.bid < nmk) { Frame Fm = F; if (nmk) Fm.G = nmk; EpiMemKV E{memk, memvT, rinvm, F.xk_g}; gemm_phase_v1(Fm, memb, Wt_xkv, MROWS, 2 * DM, DM, E); }
        if (nmk == 0 || F.bid >= nmk) ret_scan(F, KVs, nmk, F.G - nmk);
        if (BOTH(3)) GRID_BAR();
    }
    if (IN(4)) {
        ret_out(F, proj, T, KVs, mix);
        if (BOTH(4)) GRID_BAR();
    }
    if (IN(5)) {
        EpiResid E{F.x, F.out, x1b, ssq2}; gemm_big(F, mix, Wt_out, DM, DM, E);
        if (BOTH(5)) GRID_BAR();
    }
    if (IN(6)) {
        EpiXQ E{xq, ssq2, ssqq}; gemm_big(F, x1b, Wt_xq, DM, DM, E);
        if (BOTH(6)) GRID_BAR();
    }
    if (IN(7)) {
        xattn_mfma(F, xq, ssqq, memk, memvT, xo);
        if (BOTH(7)) GRID_BAR();
    }
    if (IN(8)) {
        EpiResid E{F.out, F.out, x2b, ssq3}; gemm_big(F, xo, Wt_xo, DM, DM, E);
        if (BOTH(8)) GRID_BAR();
    }
    if (IN(9)) {
        EpiUp E{hid, ssq3}; gemm_big(F, x2b, Wt_up, FF, DM, E);
        if (BOTH(9)) GRID_BAR();
    }
    if (IN(10)) {
        EpiDown E{F.out}; gemm_big(F, hid, Wt_dn, DM, FF, E);
    }
#undef IN
#undef BOTH
}

extern "C" void kernel_launch(void* const* d_in, const int* in_sizes, int n_in, void* d_out, int out_size, void* d_ws, size_t ws_size, hipStream_t stream) {
    static int grid = 0;
    if (grid == 0) {
        if (n_in != 19 || in_sizes[0] != M * DM || out_size != M * DM || ws_size < WS_END) { fprintf(stderr, "kernel_launch: unexpected shapes (n_in %d, in0 %d, out %d, ws %zu); nothing launched\n", n_in, n_in > 0 ? in_sizes[0] : -1, out_size, ws_size); grid = -1; return; }
        int dev = 0, cus = 0, per_cu = 0;
        if (hipGetDevice(&dev) != hipSuccess || hipDeviceGetAttribute(&cus, hipDeviceAttributeMultiprocessorCount, dev) != hipSuccess) { grid = -1; return; }
        if (hipFuncSetAttribute((const void*)fwd_kernel, hipFuncAttributeMaxDynamicSharedMemorySize, LDS_BYTES) != hipSuccess) { fprintf(stderr, "kernel_launch: hipFuncSetAttribute failed\n"); grid = -1; return; }
        if (hipOccupancyMaxActiveBlocksPerMultiprocessor(&per_cu, (const void*)fwd_kernel, NTHR, LDS_BYTES) != hipSuccess || per_cu < 1) fprintf(stderr, "kernel_launch: occupancy query reports %d per CU\n", per_cu);
        (void)hipGetLastError();
        grid = cus;
    }
    if (grid < 0) return;
    (void)hipMemsetAsync((char*)d_ws + WS_CTL, 0, CTL_ZERO_BYTES, stream);
    Args a{};
    for (int i = 0; i < 19; ++i) a.in[i] = d_in[i];
    a.out = (float*)d_out; a.ws = (unsigned char*)d_ws;
    for (int li = 0; li < MK_N_LAUNCHES; ++li) {
        a.ph_lo = (MK_N_LAUNCHES == NPHASE) ? li : 0; a.ph_hi = (MK_N_LAUNCHES == NPHASE) ? li + 1 : NPHASE; a.li = li; a.pad = 0;
        hipLaunchKernelGGL(fwd_kernel, dim3(grid), dim3(NTHR), LDS_BYTES, stream, a);
    }
}
```

```cpp
#include <hip/hip_runtime.h>
#include <stdint.h>
#include <cstdio>

#define LAS __attribute__((address_space(3)))
#define GAS __attribute__((address_space(1)))
typedef unsigned short bf16;
typedef short bf16x8 __attribute__((ext_vector_type(8)));
typedef float f32x4 __attribute__((ext_vector_type(4)));
typedef unsigned u32x4 __attribute__((ext_vector_type(4)));
typedef unsigned u32x2 __attribute__((ext_vector_type(2)));
typedef GAS unsigned gu32;

#ifndef MK_N_LAUNCHES
#define MK_N_LAUNCHES 1
#endif
constexpr int NPHASE = 11;
#ifndef PROBE_MASK
#define PROBE_MASK 0
#endif
constexpr int NWAVES = 8, NTHR = 512;

constexpr int BATCH = 4, SEQ = 4096, DM = 1024, M = BATCH * SEQ;
constexpr int NIN = 3584, FF = 4096, MEML = 256, MROWS = BATCH * MEML;
constexpr int NPROJ = 2560, P_RQ = 0, P_RK = 512, P_RG = 1024, P_SQ = 1536, P_SK = 2048;
constexpr int NT = 1536, TC_RK = 0, TC_RV = 512, TC_SV = 1024;
constexpr float EPS = 1e-6f;

constexpr size_t MiB = 1u << 20;
constexpr size_t WS_CTL = 0, CTL_ZERO_BYTES = 64 * 1024;
constexpr size_t WS_WIN = 1 * MiB, WS_WOUT = 8 * MiB, WS_WXQ = 10 * MiB, WS_WXKV = 12 * MiB, WS_WXO = 16 * MiB, WS_WUP = 18 * MiB, WS_WDN = 26 * MiB;
constexpr size_t WS_RINV1 = 34 * MiB, WS_RINVM = 34 * MiB + 64 * 1024;
constexpr size_t WS_SSQ2 = 241 * MiB, WS_SSQ3 = 242 * MiB, WS_SSQQ = 243 * MiB;
constexpr size_t WS_MEMB = 35 * MiB, WS_MEMK = 37 * MiB, WS_MEMV = 39 * MiB;
constexpr size_t WS_ROPE = 41 * MiB;
constexpr size_t WS_XB = 49 * MiB, WS_MIX = 49 * MiB;
constexpr size_t WS_PROJ = 81 * MiB;
constexpr size_t WS_T = 161 * MiB;
constexpr size_t WS_KVS = 209 * MiB;
constexpr size_t WS_X1B = 81 * MiB, WS_XQ = 113 * MiB, WS_XO = 145 * MiB;
constexpr size_t WS_X2B = 193 * MiB;
constexpr size_t WS_HID = 49 * MiB;
constexpr size_t WS_END = 244 * MiB;

constexpr int LDS_BYTES = 147456;
constexpr int MISC_OFF = 144 * 1024 - 256;

__device__ const double INVF[64] = {1.0, 0.8659643233600653, 0.7498942093324559, 0.6493816315762113, 0.5623413251903491, 0.4869675251658631, 0.4216965034285822, 0.3651741272548377, 0.31622776601683794, 0.27384196342643613, 0.23713737056616552, 0.2053525026457146, 0.1778279410038923, 0.1539926526059492, 0.1333521432163324, 0.11547819846894582, 0.1, 0.08659643233600653, 0.07498942093324558, 0.06493816315762113, 0.05623413251903491, 0.04869675251658631, 0.042169650342858224, 0.03651741272548377, 0.03162277660168379, 0.027384196342643614, 0.023713737056616554, 0.02053525026457146, 0.01778279410038923, 0.01539926526059492, 0.01333521432163324, 0.011547819846894581, 0.01, 0.008659643233600654, 0.007498942093324558, 0.006493816315762113, 0.005623413251903491, 0.004869675251658631, 0.004216965034285823, 0.003651741272548377, 0.0031622776601683794, 0.0027384196342643613, 0.0023713737056616554, 0.002053525026457146, 0.0017782794100389228, 0.001539926526059492, 0.001333521432163324, 0.0011547819846894581, 0.001, 0.0008659643233600654, 0.0007498942093324559, 0.0006493816315762113, 0.0005623413251903491, 0.0004869675251658631, 0.00042169650342858224, 0.0003651741272548377, 0.00031622776601683794, 0.0002738419634264361, 0.00023713737056616554, 0.0002053525026457146, 0.00017782794100389227, 0.0001539926526059492, 0.0001333521432163324, 0.00011547819846894582};

__device__ __forceinline__ float bflo(unsigned u) { return __uint_as_float(u << 16); }
__device__ __forceinline__ float bfhi(unsigned u) { return __uint_as_float(u & 0xffff0000u); }
__device__ __forceinline__ float bf2f(bf16 v) { return __uint_as_float(((unsigned)v) << 16); }
__device__ __forceinline__ unsigned f2bf(float f) { unsigned u = __float_as_uint(f); return (u + 0x7fffu + ((u >> 16) & 1u)) >> 16; }
__device__ __forceinline__ unsigned pk2(float lo, float hi) { return f2bf(lo) | (f2bf(hi) << 16); }
__device__ __forceinline__ float wave_sum(float v) {
#pragma unroll
    for (int o = 1; o < 64; o <<= 1) v += __shfl_xor(v, o);
    return v;
}
__device__ __forceinline__ float wave_max(float v) {
#pragma unroll
    for (int o = 1; o < 64; o <<= 1) v = fmaxf(v, __shfl_xor(v, o));
    return v;
}
#define CBAR() asm volatile("" ::: "memory")
__device__ __forceinline__ float lg2gamma(int h) { return h == 0 ? -0.04580368961312479f : h == 1 ? -0.02272007650008353f : h == 2 ? -0.011315313227834146f : -0.005646563141142063f; }

#define XB_TMO      128
#define XB_XCNT(j)  (256  + 64 * (j))
#define XB_XSUB(j)  (1280 + 64 * (j))
#define XB_XGEN(j)  (2304 + 64 * (j))
#define XB_TOP      3328
#define XB_TOPGEN   3392
#define XCD_BAR_WORDS 3456
#define XB_SPIN_CAP (1u << 22)
__device__ __forceinline__ unsigned xb_ld(unsigned* p)              { return __hip_atomic_load(p, __ATOMIC_RELAXED, __HIP_MEMORY_SCOPE_AGENT); }
__device__ __forceinline__ unsigned xb_add(unsigned* p, unsigned v) { return __hip_atomic_fetch_add(p, v, __ATOMIC_RELAXED, __HIP_MEMORY_SCOPE_AGENT); }
__device__ __forceinline__ unsigned xb_xcc_id() { return (unsigned)__builtin_amdgcn_s_getreg((3 << 11) | 20) & 0xFu; }
#define XB_SPIN(cond, bar) do { unsigned _sp = 0; while (cond) { __builtin_amdgcn_s_sleep(1); \
    if ((++_sp & 255u) == 0u) { if (xb_ld(&(bar)[XB_TMO])) break; if (_sp > XB_SPIN_CAP) { atomicAdd(&(bar)[XB_TMO], 1u); break; } } } } while (0)
struct XcdBarrier { unsigned* bar; unsigned x; volatile LAS unsigned* st; };
__device__ __forceinline__ XcdBarrier xcd_barrier_post(unsigned* bar, volatile LAS unsigned* st) {
    XcdBarrier b; b.bar = bar; b.x = xb_xcc_id(); b.st = st;
    if (threadIdx.x == 0) (void)xb_add(&bar[XB_XCNT(b.x)], 1u);
    return b;
}
__device__ __forceinline__ void xcd_barrier_complete(unsigned* bar, unsigned x, unsigned& nloc, unsigned& nx) {
    const unsigned G = gridDim.x * gridDim.y * gridDim.z;
    unsigned sum, cnt, mine, sp = 0u;
    for (;;) {
        sum = 0u; cnt = 0u; mine = 0u;
#pragma unroll
        for (unsigned j = 0; j < 16; ++j) { const unsigned c = xb_ld(&bar[XB_XCNT(j)]); sum += c; cnt += (c > 0u) ? 1u : 0u; mine = (j == x) ? c : mine; }
        if (sum == G) break;
        __builtin_amdgcn_s_sleep(1);
        if ((++sp & 255u) == 0u) { if (xb_ld(&bar[XB_TMO])) break; if (sp > XB_SPIN_CAP) { atomicAdd(&bar[XB_TMO], 1u); break; } }
    }
    nloc = mine > 0u ? mine : 1u; nx = cnt > 0u ? cnt : 1u;
}
__device__ __forceinline__ void xcd_barrier(const XcdBarrier& b) {
    asm volatile("s_waitcnt vmcnt(0)" ::: "memory");
    __syncthreads();
    if (threadIdx.x == 0) {
        unsigned* bar = b.bar;
        __builtin_amdgcn_s_waitcnt(0);
        unsigned nloc = b.st[0], nx = b.st[1];
        if (nloc == 0u) { xcd_barrier_complete(bar, b.x, nloc, nx); b.st[0] = nloc; b.st[1] = nx; }
        const unsigned old = xb_add(&bar[XB_XSUB(b.x)], 1u);
        const unsigned gen = old / nloc;
        if (old + 1u == (gen + 1u) * nloc) {
            __builtin_amdgcn_fence(__ATOMIC_RELEASE, "agent");
            asm volatile("s_waitcnt vmcnt(0)" ::: "memory");
            const unsigned og = xb_add(&bar[XB_TOP], 1u);
            const unsigned tg = og / nx;
            if (og + 1u == (tg + 1u) * nx) xb_add(&bar[XB_TOPGEN], 1u);
            else XB_SPIN(xb_ld(&bar[XB_TOPGEN]) == tg, bar);
            __builtin_amdgcn_fence(__ATOMIC_ACQUIRE, "agent");
            xb_add(&bar[XB_XGEN(b.x)], 1u);
            asm volatile("s_waitcnt vmcnt(0)" ::: "memory");
        } else {
            XB_SPIN(xb_ld(&bar[XB_XGEN(b.x)]) == gen, bar);
            __builtin_amdgcn_fence(__ATOMIC_ACQUIRE, "agent");
            asm volatile("s_waitcnt vmcnt(0)" ::: "memory");
        }
    }
    __syncthreads();
}

struct Args { const void* in[19]; float* out; unsigned char* ws; int ph_lo, ph_hi, li, pad; };
struct Frame {
    LAS unsigned char* lds;
    int tid, lane, wave, G, bid;
    const float *x, *mem; const int* pos;
    const float *g_mix, *w_in, *ret_gn_g, *sb_q_g, *sb_k_g, *w_out, *g_xattn, *g_mem, *w_xq, *w_xkv, *xq_g, *xk_g, *w_xo, *g_mlp, *w_up, *w_down;
    float* out; unsigned char* ws;
};

__device__ __forceinline__ int inproj_src_col(int np) {
    const int pn = np >> 8, p = np & 255, seg = pn >> 1, half = pn & 1, bj = p >> 7, wc = (p >> 5) & 3, i = p & 31;
    if (seg <= 1) { const int h = 2 * half + bj, g = 4 * wc + (i >> 3), e = i & 7; return seg * 512 + h * 128 + (e < 4 ? 4 * g + e : 64 + 4 * g + e - 4); }
    if (seg == 4 || seg == 5) { const int head = 4 * half + wc; return seg * 512 + head * 64 + 32 * bj + i; }
    return np;
}
template <bool PERM_IN>
__device__ void conv_weight(const Frame& F, const float* W, const float* g, bf16* Wt, int K, int N) {
    LAS float* T = (LAS float*)F.lds;
    const int tk = K / 64, tn = N / 64, nt = tk * tn;
    for (int t = F.bid; t < nt; t += F.G) {
        const int k0 = (t / tn) * 64, n0 = (t % tn) * 64;
        __syncthreads();
#pragma unroll
        for (int i = 0; i < 2; ++i) {
            const int r = (F.tid >> 4) + 32 * i, c = (F.tid & 15) * 4;
            const int sc = PERM_IN ? inproj_src_col(n0 + c) : n0 + c;
            f32x4 v = *(const f32x4*)(W + (size_t)(k0 + r) * N + sc);
            const float gg = g ? g[k0 + r] : 1.f;
            T[r * 65 + c + 0] = v[0] * gg; T[r * 65 + c + 1] = v[1] * gg; T[r * 65 + c + 2] = v[2] * gg; T[r * 65 + c + 3] = v[3] * gg;
        }
        __syncthreads();
#pragma unroll
        for (int i = 0; i < 2; ++i) {
            const int n = (F.tid >> 4) + 32 * i, k = (F.tid & 15) * 4;
            u32x2 o; o[0] = pk2(T[(k + 0) * 65 + n], T[(k + 1) * 65 + n]); o[1] = pk2(T[(k + 2) * 65 + n], T[(k + 3) * 65 + n]);
            *(u32x2*)(Wt + (size_t)(n0 + n) * K + k0 + k) = o;
        }
    }
    __syncthreads();
}
__device__ void rows_prep(const Frame& F, const float* X, bf16* Xb, float* rinv, int rows) {
    const int gw = F.bid * NWAVES + F.wave, GW = F.G * NWAVES;
    for (int r = gw; r < rows; r += GW) {
        float ss = 0.f;
#pragma unroll
        for (int i = 0; i < 4; ++i) {
            const int c = i * 256 + F.lane * 4;
            f32x4 v = *(const f32x4*)(X + (size_t)r * DM + c);
            ss += v[0] * v[0] + v[1] * v[1] + v[2] * v[2] + v[3] * v[3];
            u32x2 o; o[0] = pk2(v[0], v[1]); o[1] = pk2(v[2], v[3]);
            *(u32x2*)(Xb + (size_t)r * DM + c) = o;
        }
        ss = wave_sum(ss);
        if (F.lane == 0) rinv[r] = rsqrtf(ss * (1.f / DM) + EPS);
    }
}
__device__ void rope_table(const Frame& F, float2* cs) {
    const int total = M * 64;
    for (int e = F.bid * NTHR + F.tid; e < total; e += F.G * NTHR) {
        const int row = e >> 6, j = e & 63;
        const double ang = (double)F.pos[row] * INVF[j];
        const double rev = ang * 0.15915494309189535;
        const float fr = (float)(rev - floor(rev));
        float2 o; o.x = __builtin_amdgcn_cosf(fr); o.y = __builtin_amdgcn_sinf(fr);
        cs[e] = o;
    }
}

namespace pg8 {
#define PG8_LAS __attribute__((address_space(3)))
typedef unsigned short bf16_t;
typedef short bf16x8 __attribute__((ext_vector_type(8)));
typedef float f32x4 __attribute__((ext_vector_type(4)));
typedef unsigned u32x4 __attribute__((ext_vector_type(4)));
constexpr int BM = 256, BK = 64, HALF = 128, HTB = HALF * BK * 2  , STAGE_BYTES = 8 * HTB, NXCD = 8, WGM = 8;

__host__ __device__ __forceinline__ int lds_byte(int r, int c) { const int st = (r >> 4) * 2 + (c >> 5), rr = r & 15, cc = c & 31, ob = rr * 64 + cc * 2; return st * 1024 + (ob ^ (((ob >> 9) & 1) << 5)); }
__host__ __device__ __forceinline__ void stage_rc(int b, int& R, int& C) { const int st = b / 1024, sb = b % 1024, swz = sb ^ (((sb >> 9) & 1) << 5); R = (st >> 1) * 16 + swz / 64; C = (st & 1) * 32 + (swz % 64) / 2; }
__host__ __device__ __forceinline__ int perm32(int rho) { const int n = rho >> 4, i = rho & 15; return 8 * (i >> 2) + 4 * n + (i & 3); }

struct Unit { int pm, pn; };
struct Gemm { const bf16_t* A; const bf16_t* Bt; int M, N, K; };

struct StaticOrder {
    int nM, nN, nwg, G, c;
    __host__ __device__ void init(int M, int N, int G_, int c_) { nM = M / BM; nN = N / BM; nwg = nM * nN; G = G_; c = c_; }
    __host__ __device__ bool next(int i, Unit& u) const {
        const long L = (long)i * G + c; if (L >= nwg) return false;
        int wgid = (int)L; { const int q = nwg / NXCD, r = nwg % NXCD, xcd = wgid % NXCD, off = wgid / NXCD; wgid = (xcd < r ? xcd * (q + 1) : r * (q + 1) + (xcd - r) * q) + off; }
        const int nig = WGM * nN, gid = wgid / nig, fm = gid * WGM, gsz = (nM - fm) < WGM ? (nM - fm) : WGM;
        u.pm = fm + ((wgid % nig) % gsz); u.pn = (wgid % nig) / gsz; return true;
    }
    __device__ __forceinline__ void a_ready(const Unit&) const {}
    __device__ __forceinline__ void done(const Unit&) const {}
};

__device__ __forceinline__ unsigned cvt_pk_bf16(float lo, float hi) { unsigned r; asm volatile("v_cvt_pk_bf16_f32 %0, %1, %2" : "=v"(r) : "v"(lo), "v"(hi)); return r; }
template <class Epi, class Sched, bool ALIGN_EPI = false, bool SP2 = false>
__device__ __forceinline__ void gemm_phase(PG8_LAS unsigned char* lds, const Gemm g, const Sched& S, const Epi& E) {
    const int tid = threadIdx.x, wid = __builtin_amdgcn_readfirstlane(tid >> 6), lane = tid & 63, wr = wid >> 2, wc = wid & 3, fr = lane & 15, fq = lane >> 4;
    const int K = g.K, nt = K / BK;
    unsigned voffA[2], voffB[2];
#pragma unroll
    for (int i = 0; i < 2; ++i) { int R, C; stage_rc(tid * 16 + i * 8192, R, C); const int Rb = Epi::PERM ? ((R & ~31) + perm32(R & 31)) : R;
        voffA[i] = (unsigned)(R * K + C) * 2u; voffB[i] = (unsigned)(Rb * K + C) * 2u; }
    const size_t kstep = (size_t)(BK * 2);
    const size_t hstep = (size_t)HALF * K * 2;
    const size_t tstep = 2 * hstep;
    const unsigned ldsw = (unsigned)wid * 1024u;
    const int aoff = lds_byte(wr * 64 + fr, fq * 8), boff = lds_byte(wc * 32 + fr, fq * 8);
#define PG8_SA(b, h) (((b) * 2 + (h)) * HTB)
#define PG8_SB(b, h) ((4 + (b) * 2 + (h)) * HTB)
#define PG8_STAGE(bufoff, gbase, voff) do { _Pragma("unroll") for (int _i = 0; _i < 2; ++_i) \
        __builtin_amdgcn_global_load_lds((const unsigned*)((const char*)(gbase) + (voff)[_i]), (PG8_LAS unsigned*)(lds + (bufoff) + ldsw + _i * 8192), 16, 0, 0); } while (0)
#define PG8_LDA(dst, b, h) do { _Pragma("unroll") for (int m = 0; m < 4; ++m) _Pragma("unroll") for (int k = 0; k < 2; ++k) dst[m][k] = *(const PG8_LAS bf16x8*)(lds + PG8_SA(b, h) + aoff + m * 2048 + k * 1024); } while (0)
#define PG8_LDB(dst, b, h) do { _Pragma("unroll") for (int n = 0; n < 2; ++n) _Pragma("unroll") for (int k = 0; k < 2; ++k) dst[n][k] = *(const PG8_LAS bf16x8*)(lds + PG8_SB(b, h) + boff + n * 2048 + k * 1024); } while (0)
#define PG8_MMA(ai, bj, At, Bt) do { __builtin_amdgcn_s_setprio(1); _Pragma("unroll") for (int m = 0; m < 4; ++m) _Pragma("unroll") for (int n = 0; n < 2; ++n) _Pragma("unroll") for (int k = 0; k < 2; ++k) \
        acc[ai][bj][m][n] = __builtin_amdgcn_mfma_f32_16x16x32_bf16(Bt[n][k], At[m][k], acc[ai][bj][m][n], 0, 0, 0); __builtin_amdgcn_s_setprio(0); } while (0)
#define PG8_WAIT_V(n) asm volatile("s_waitcnt vmcnt(" #n ")" ::: "memory")
#define PG8_WAIT_L(n) asm volatile("s_waitcnt lgkmcnt(" #n ")" ::: "memory")
#define PG8_BAR __builtin_amdgcn_s_barrier()
#define PG8_SCHED __builtin_amdgcn_sched_barrier(0)
    Unit cur, nxt; int ui = 0;
    if (!S.next(0, cur)) return;
    f32x4 acc[2][2][4][2];
#pragma unroll
    for (int a = 0; a < 2; ++a)
#pragma unroll
        for (int b = 0; b < 2; ++b)
#pragma unroll
            for (int m = 0; m < 4; ++m)
#pragma unroll
                for (int n = 0; n < 2; ++n) acc[a][b][m][n] = (f32x4){0.f, 0.f, 0.f, 0.f};
    bf16x8 At[4][2], B0[2][2], B1[2][2];
    const char* cA = (const char*)g.A + (size_t)cur.pm * tstep; const char* cB = (const char*)g.Bt + (size_t)cur.pn * tstep;
    S.a_ready(cur);
    if constexpr (SP2) {
        PG8_STAGE(PG8_SB(0, 0), cB, voffB); PG8_STAGE(PG8_SB(0, 1), cB + hstep, voffB); PG8_STAGE(PG8_SA(0, 0), cA, voffA); PG8_STAGE(PG8_SA(0, 1), cA + hstep, voffA);
        if (wr == 1) PG8_BAR;
        PG8_WAIT_V(2); PG8_BAR;
        PG8_STAGE(PG8_SB(1, 0), cB + kstep, voffB); PG8_STAGE(PG8_SA(1, 0), cA + kstep, voffA); PG8_STAGE(PG8_SB(1, 1), cB + hstep + kstep, voffB);
        PG8_WAIT_V(6); PG8_BAR;
    } else {
        PG8_STAGE(PG8_SB(0, 0), cB, voffB); PG8_STAGE(PG8_SA(0, 0), cA, voffA); PG8_STAGE(PG8_SB(0, 1), cB + hstep, voffB); PG8_STAGE(PG8_SA(0, 1), cA + hstep, voffA);
        if (wr == 1) PG8_BAR;
        PG8_WAIT_V(4); PG8_BAR;
        PG8_STAGE(PG8_SB(1, 0), cB + kstep, voffB); PG8_STAGE(PG8_SA(1, 0), cA + kstep, voffA); PG8_STAGE(PG8_SB(1, 1), cB + hstep + kstep, voffB);
        PG8_WAIT_V(6); PG8_BAR;
    }
    for (;;) {
        const bool has_next = S.next(ui + 1, nxt);
        const char* nA = has_next ? (const char*)g.A + (size_t)nxt.pm * tstep : cA; const char* nB = has_next ? (const char*)g.Bt + (size_t)nxt.pn * tstep : cB;
        for (int t = 0; t < nt; t += 2) {
            const bool last = (t == nt - 2);
            const char* a1 = cA + (size_t)(t + 1) * kstep;
            const char* a2 = last ? nA : cA + (size_t)(t + 2) * kstep; const char* b2 = last ? nB : cB + (size_t)(t + 2) * kstep;
            const char* a3 = a2 + kstep; const char* b3 = b2 + kstep;
            if (last && has_next) S.a_ready(nxt);
            if constexpr (SP2) {
            PG8_LDB(B0, 0, 0); PG8_LDB(B1, 0, 1); PG8_SCHED; PG8_LDA(At, 0, 0); PG8_STAGE(PG8_SA(1, 1), a1 + hstep, voffA);
            PG8_WAIT_V(8); PG8_WAIT_L(0); PG8_BAR; PG8_MMA(0, 0, At, B0); PG8_MMA(0, 1, At, B1); PG8_BAR; PG8_SCHED;
            PG8_LDA(At, 0, 1); PG8_STAGE(PG8_SB(0, 0), b2, voffB); PG8_STAGE(PG8_SB(0, 1), b2 + hstep, voffB); PG8_STAGE(PG8_SA(0, 0), a2, voffA);
            PG8_WAIT_V(8); PG8_WAIT_L(0); PG8_BAR; PG8_MMA(1, 0, At, B0); PG8_MMA(1, 1, At, B1); PG8_BAR; PG8_SCHED;
            PG8_LDB(B0, 1, 0); PG8_LDB(B1, 1, 1); PG8_SCHED; PG8_LDA(At, 1, 0); PG8_STAGE(PG8_SA(0, 1), a2 + hstep, voffA);
            PG8_WAIT_V(8); PG8_WAIT_L(0); PG8_BAR; PG8_MMA(0, 0, At, B0); PG8_MMA(0, 1, At, B1); PG8_BAR; PG8_SCHED;
            PG8_LDA(At, 1, 1); PG8_STAGE(PG8_SB(1, 0), b3, voffB); PG8_STAGE(PG8_SB(1, 1), b3 + hstep, voffB); PG8_STAGE(PG8_SA(1, 0), a3, voffA);
            PG8_WAIT_V(8); PG8_WAIT_L(0); PG8_BAR; PG8_MMA(1, 0, At, B0); PG8_MMA(1, 1, At, B1); PG8_BAR; PG8_SCHED;
            } else {
            PG8_LDB(B0, 0, 0); PG8_SCHED; PG8_LDA(At, 0, 0); PG8_STAGE(PG8_SA(1, 1), a1 + hstep, voffA);
            PG8_WAIT_L(8); PG8_BAR; PG8_WAIT_L(0); PG8_MMA(0, 0, At, B0); PG8_BAR; PG8_SCHED;
            PG8_LDB(B1, 0, 1); PG8_STAGE(PG8_SB(0, 0), b2, voffB);
            PG8_BAR; PG8_WAIT_L(0); PG8_MMA(0, 1, At, B1); PG8_BAR;
            PG8_LDA(At, 0, 1); PG8_STAGE(PG8_SA(0, 0), a2, voffA);
            PG8_BAR; PG8_WAIT_L(0); PG8_MMA(1, 0, At, B0); PG8_BAR; PG8_SCHED;
            PG8_STAGE(PG8_SB(0, 1), b2 + hstep, voffB);
            PG8_WAIT_V(6); PG8_BAR; PG8_MMA(1, 1, At, B1); PG8_BAR;
            PG8_LDB(B0, 1, 0); PG8_SCHED; PG8_LDA(At, 1, 0); PG8_STAGE(PG8_SA(0, 1), a2 + hstep, voffA);
            PG8_WAIT_L(8); PG8_BAR; PG8_WAIT_L(0); PG8_MMA(0, 0, At, B0); PG8_BAR; PG8_SCHED;
            PG8_LDB(B1, 1, 1); PG8_STAGE(PG8_SB(1, 0), b3, voffB);
            PG8_BAR; PG8_WAIT_L(0); PG8_MMA(0, 1, At, B1); PG8_BAR;
            PG8_LDA(At, 1, 1); PG8_STAGE(PG8_SA(1, 0), a3, voffA);
            PG8_BAR; PG8_WAIT_L(0); PG8_MMA(1, 0, At, B0); PG8_BAR; PG8_SCHED;
            PG8_STAGE(PG8_SB(1, 1), b3 + hstep, voffB);
            PG8_WAIT_V(6); PG8_BAR; PG8_MMA(1, 1, At, B1); PG8_BAR;
            }
        }
        if constexpr (ALIGN_EPI) { if (wr == 0) PG8_BAR; }
        if constexpr (!Epi::AFTER_DRAIN) { E(acc, cur, wr, wc, fr, fq); S.done(cur); }
        if (!has_next) break;
#pragma unroll
        for (int a = 0; a < 2; ++a)
#pragma unroll
            for (int b = 0; b < 2; ++b)
#pragma unroll
                for (int m = 0; m < 4; ++m)
#pragma unroll
                    for (int n = 0; n < 2; ++n) acc[a][b][m][n] = (f32x4){0.f, 0.f, 0.f, 0.f};
        cur = nxt; cA = nA; cB = nB; ++ui;
        if constexpr (ALIGN_EPI) { if (wr == 1) PG8_BAR; }
    }
    PG8_WAIT_V(0);
    if constexpr (!ALIGN_EPI) { if (wr == 0) PG8_BAR; }
    PG8_BAR;
    if constexpr (Epi::AFTER_DRAIN) { E.fused(acc, cur, wr, wc, fr, fq, lds, wid, lane); S.done(cur); }
#undef PG8_SA
#undef PG8_SB
#undef PG8_STAGE
#undef PG8_LDA
#undef PG8_LDB
#undef PG8_MMA
#undef PG8_WAIT_V
#undef PG8_WAIT_L
#undef PG8_BAR
#undef PG8_SCHED
}
}

__device__ __forceinline__ float sum16(const float* p) { const f32x4 a = *(const f32x4*)p, b = *(const f32x4*)(p + 4), c = *(const f32x4*)(p + 8), d = *(const f32x4*)(p + 12); const f32x4 t = (a + b) + (c + d); return (t[0] + t[1]) + (t[2] + t[3]); }
__device__ __forceinline__ u32x4 pack8u(const f32x4& a, const f32x4& b) { u32x4 w; w[0] = pg8::cvt_pk_bf16(a[0], a[1]); w[1] = pg8::cvt_pk_bf16(a[2], a[3]); w[2] = pg8::cvt_pk_bf16(b[0], b[1]); w[3] = pg8::cvt_pk_bf16(b[2], b[3]); return w; }
__device__ __forceinline__ void store_T8(bf16* T, size_t chan0, int sq, const u32x4& w) {
    bf16* t = T + chan0 * SEQ + sq;
#pragma unroll
    for (int e = 0; e < 4; ++e) { t[(size_t)(2 * e) * SEQ] = (bf16)(w[e] & 0xffffu); t[(size_t)(2 * e + 1) * SEQ] = (bf16)(w[e] >> 16); }
}
struct EpiInProj {
    static constexpr bool PERM = true, AFTER_DRAIN = false;
    bf16* proj; const float* rinv1; const float2* cs; const float* sb_q_g; const float* sb_k_g; bf16* T;
    __device__ __forceinline__ void operator()(const f32x4 (&acc)[2][2][4][2], const pg8::Unit& u, int wr, int wc, int fr, int fq) const {
        const int pn = u.pn, seg = pn >> 1, half = pn & 1;
#pragma unroll
        for (int ai = 0; ai < 2; ++ai)
#pragma unroll
            for (int m = 0; m < 4; ++m) {
                const int gr = u.pm * 256 + ai * 128 + wr * 64 + m * 16 + fr, b = gr >> 12, sq = gr & (SEQ - 1);
                const float s = rinv1[gr];
                f32x4 a[2][2];
#pragma unroll
                for (int bj = 0; bj < 2; ++bj) { a[bj][0] = acc[ai][bj][m][0] * s; a[bj][1] = acc[ai][bj][m][1] * s; }
                if (seg <= 1) {
                    const int g = 4 * wc + fq;
                    const f32x4* c4 = (const f32x4*)(cs + (size_t)gr * 64 + 4 * g);
                    const f32x4 c01 = c4[0], c23 = c4[1];
                    const f32x4 cosv = (f32x4){c01[0], c01[2], c23[0], c23[2]}, sinv = (f32x4){c01[1], c01[3], c23[1], c23[3]};
                    const float eidx = (float)((gr & 127) + 1);
#pragma unroll
                    for (int bj = 0; bj < 2; ++bj) {
                        const int h = 2 * half + bj;
                        const float e = eidx * lg2gamma(h);
                        const float sc = (seg == 0) ? __builtin_amdgcn_exp2f(e) : 0.08838834764831845f * __builtin_amdgcn_exp2f(-e);
                        const f32x4 x = a[bj][0], y = a[bj][1];
                        const f32x4 o1 = (x * cosv - y * sinv) * sc, o2 = (y * cosv + x * sinv) * sc;
                        const u32x4 w = pack8u(o1, o2);
                        *(u32x4*)(proj + (size_t)gr * NPROJ + (seg == 0 ? P_RQ : P_RK) + h * 128 + 8 * g) = w;
                        if (seg == 1) store_T8(T, (size_t)b * NT + TC_RK + h * 128 + 8 * g, sq, w);
                    }
                } else if (seg == 4 || seg == 5) {
                    float ss = 0.f;
#pragma unroll
                    for (int bj = 0; bj < 2; ++bj)
#pragma unroll
                        for (int n = 0; n < 2; ++n) { const f32x4 t = a[bj][n] * a[bj][n]; ss += (t[0] + t[1]) + (t[2] + t[3]); }
                    ss += __shfl_xor(ss, 16); ss += __shfl_xor(ss, 32);
                    const float inv = rsqrtf(ss * (1.f / 64.f) + EPS);
                    const int head = 4 * half + wc;
                    const float* gp = (seg == 4 ? sb_q_g : sb_k_g) + head * 64 + 8 * fq;
#pragma unroll
                    for (int bj = 0; bj < 2; ++bj) {
                        const f32x4 g0 = *(const f32x4*)(gp + 32 * bj), g1 = *(const f32x4*)(gp + 32 * bj + 4);
                        const u32x4 w = pack8u(a[bj][0] * g0 * inv, a[bj][1] * g1 * inv);
                        *(u32x4*)(proj + (size_t)gr * NPROJ + (seg == 4 ? P_SQ : P_SK) + head * 64 + 32 * bj + 8 * fq) = w;
                    }
                } else if (seg == 3) {
#pragma unroll
                    for (int bj = 0; bj < 2; ++bj) *(u32x4*)(proj + (size_t)gr * NPROJ + P_RG + half * 256 + 128 * bj + 32 * wc + 8 * fq) = pack8u(a[bj][0], a[bj][1]);
                } else {
                    const int chb = (seg == 2 ? TC_RV : TC_SV) + half * 256 + 32 * wc + 8 * fq;
#pragma unroll
                    for (int bj = 0; bj < 2; ++bj) store_T8(T, (size_t)b * NT + chb + 128 * bj, sq, pack8u(a[bj][0], a[bj][1]));
                }
            }
    }
};
struct EpiResid {
    static constexpr bool PERM = true, AFTER_DRAIN = false;
    const float* resid; float* out; bf16* xb; float* ssq;
    __device__ __forceinline__ void operator()(const f32x4 (&acc)[2][2][4][2], const pg8::Unit& u, int wr, int wc, int fr, int fq) const {
#pragma unroll
        for (int ai = 0; ai < 2; ++ai)
#pragma unroll
            for (int m = 0; m < 4; ++m) {
                const int gr = u.pm * 256 + ai * 128 + wr * 64 + m * 16 + fr;
                float ss = 0.f;
#pragma unroll
                for (int bj = 0; bj < 2; ++bj) {
                    const size_t o = (size_t)gr * DM + u.pn * 256 + 128 * bj + 32 * wc + 8 * fq;
                    const f32x4 v0 = acc[ai][bj][m][0] + *(const f32x4*)(resid + o), v1 = acc[ai][bj][m][1] + *(const f32x4*)(resid + o + 4);
                    *(f32x4*)(out + o) = v0; *(f32x4*)(out + o + 4) = v1;
                    *(u32x4*)(xb + o) = pack8u(v0, v1);
                    const f32x4 t = v0 * v0 + v1 * v1; ss += (t[0] + t[1]) + (t[2] + t[3]);
                }
                ss += __shfl_xor(ss, 16); ss += __shfl_xor(ss, 32);
                if (fq == 0) ssq[(size_t)gr * 16 + u.pn * 4 + wc] = ss;
            }
    }
};
struct EpiXQ {
    static constexpr bool PERM = true, AFTER_DRAIN = false;
    bf16* xq; const float* ssq2; float* ssqq;
    __device__ __forceinline__ void operator()(const f32x4 (&acc)[2][2][4][2], const pg8::Unit& u, int wr, int wc, int fr, int fq) const {
#pragma unroll
        for (int ai = 0; ai < 2; ++ai)
#pragma unroll
            for (int m = 0; m < 4; ++m) {
                const int gr = u.pm * 256 + ai * 128 + wr * 64 + m * 16 + fr;
                const float rinv = rsqrtf(sum16(ssq2 + (size_t)gr * 16) * (1.f / DM) + EPS);
                float ss = 0.f;
#pragma unroll
                for (int bj = 0; bj < 2; ++bj) {
                    const f32x4 v0 = acc[ai][bj][m][0] * rinv, v1 = acc[ai][bj][m][1] * rinv;
                    *(u32x4*)(xq + (size_t)gr * DM + u.pn * 256 + 128 * bj + 32 * wc + 8 * fq) = pack8u(v0, v1);
                    const f32x4 t = v0 * v0 + v1 * v1; ss += (t[0] + t[1]) + (t[2] + t[3]);
                }
                ss += __shfl_xor(ss, 16); ss += __shfl_xor(ss, 32);
                if (fq == 0) ssqq[(size_t)gr * 16 + u.pn * 4 + wc] = ss;
            }
    }
};
struct EpiUp {
    static constexpr bool PERM = true, AFTER_DRAIN = false;
    bf16* hid; const float* ssq3;
    __device__ __forceinline__ void operator()(const f32x4 (&acc)[2][2][4][2], const pg8::Unit& u, int wr, int wc, int fr, int fq) const {
#pragma unroll
        for (int ai = 0; ai < 2; ++ai)
#pragma unroll
            for (int m = 0; m < 4; ++m) {
                const int gr = u.pm * 256 + ai * 128 + wr * 64 + m * 16 + fr;
                const float rinv = rsqrtf(sum16(ssq3 + (size_t)gr * 16) * (1.f / DM) + EPS);
#pragma unroll
                for (int bj = 0; bj < 2; ++bj) {
                    f32x4 v0 = acc[ai][bj][m][0] * rinv, v1 = acc[ai][bj][m][1] * rinv;
#pragma unroll
                    for (int e = 0; e < 4; ++e) { const float t0 = fmaxf(v0[e], 0.f), t1 = fmaxf(v1[e], 0.f); v0[e] = t0 * t0; v1[e] = t1 * t1; }
                    *(u32x4*)(hid + (size_t)gr * FF + u.pn * 256 + 128 * bj + 32 * wc + 8 * fq) = pack8u(v0, v1);
                }
            }
    }
};
struct EpiDown {
    static constexpr bool PERM = true, AFTER_DRAIN = false;
    float* out;
    __device__ __forceinline__ void operator()(const f32x4 (&acc)[2][2][4][2], const pg8::Unit& u, int wr, int wc, int fr, int fq) const {
#pragma unroll
        for (int ai = 0; ai < 2; ++ai)
#pragma unroll
            for (int m = 0; m < 4; ++m) {
                const int gr = u.pm * 256 + ai * 128 + wr * 64 + m * 16 + fr;
#pragma unroll
                for (int bj = 0; bj < 2; ++bj) {
                    const size_t o = (size_t)gr * DM + u.pn * 256 + 128 * bj + 32 * wc + 8 * fq;
                    const f32x4 r0 = *(const f32x4*)(out + o), r1 = *(const f32x4*)(out + o + 4);
                    *(f32x4*)(out + o) = acc[ai][bj][m][0] + r0; *(f32x4*)(out + o + 4) = acc[ai][bj][m][1] + r1;
                }
            }
    }
};
template <class Epi>
__device__ __forceinline__ void gemm_big(const Frame& F, const bf16* A, const bf16* Bt, int N, int K, const Epi& E) {
    pg8::Gemm g{A, Bt, M, N, K}; pg8::StaticOrder S; S.init(M, N, F.G, F.bid);
    pg8::gemm_phase<Epi, pg8::StaticOrder, true, true>(F.lds, g, S, E);
}

constexpr int LDA_S = 72, LDC_S = 260;
template <class Epi>
__device__ void gemm_phase_v1(const Frame& F, const bf16* A, const bf16* Bt, int Mr, int N, int K, const Epi& E) {
    const int tid = F.tid, lane = F.lane, wave = F.wave;
    const int wr = wave >> 2, wc = wave & 3;
    const int nN = N / 256, nU = (Mr / 128) * nN, nk = K / 64;
    LAS bf16* As = (LAS bf16*)F.lds;
    LAS bf16* Bs = (LAS bf16*)(F.lds + 128 * LDA_S * 2);
    LAS float* Cs = (LAS float*)F.lds;
    const int lr = tid >> 3, lc = (tid & 7) * 8;
    for (int u = F.bid; u < nU; u += F.G) {
        const int pm = u / nN, pn = u % nN;
        const bf16* Ag = A + (size_t)(pm * 128 + lr) * K + lc;
        const bf16* Bg = Bt + (size_t)(pn * 256 + lr) * K + lc;
        f32x4 acc[4][4];
#pragma unroll
        for (int i = 0; i < 4; ++i)
#pragma unroll
            for (int j = 0; j < 4; ++j) acc[i][j] = (f32x4){0.f, 0.f, 0.f, 0.f};
        u32x4 ra[2], rb[4];
#pragma unroll
        for (int i = 0; i < 2; ++i) ra[i] = *(const u32x4*)(Ag + (size_t)(64 * i) * K);
#pragma unroll
        for (int i = 0; i < 4; ++i) rb[i] = *(const u32x4*)(Bg + (size_t)(64 * i) * K);
        for (int kt = 0; kt < nk; ++kt) {
            __syncthreads();
#pragma unroll
            for (int i = 0; i < 2; ++i) *(LAS u32x4*)(As + (lr + 64 * i) * LDA_S + lc) = ra[i];
#pragma unroll
            for (int i = 0; i < 4; ++i) *(LAS u32x4*)(Bs + (lr + 64 * i) * LDA_S + lc) = rb[i];
            __syncthreads();
            if (kt + 1 < nk) {
#pragma unroll
                for (int i = 0; i < 2; ++i) ra[i] = *(const u32x4*)(Ag + (size_t)(64 * i) * K + (kt + 1) * 64);
#pragma unroll
                for (int i = 0; i < 4; ++i) rb[i] = *(const u32x4*)(Bg + (size_t)(64 * i) * K + (kt + 1) * 64);
            }
#pragma unroll
            for (int kk = 0; kk < 2; ++kk) {
                bf16x8 a[4], b[4];
#pragma unroll
                for (int i = 0; i < 4; ++i) a[i] = *(LAS bf16x8*)(As + (wr * 64 + i * 16 + (lane & 15)) * LDA_S + kk * 32 + (lane >> 4) * 8);
#pragma unroll
                for (int j = 0; j < 4; ++j) b[j] = *(LAS bf16x8*)(Bs + (wc * 64 + j * 16 + (lane & 15)) * LDA_S + kk * 32 + (lane >> 4) * 8);
#pragma unroll
                for (int i = 0; i < 4; ++i)
#pragma unroll
                    for (int j = 0; j < 4; ++j) acc[i][j] = __builtin_amdgcn_mfma_f32_16x16x32_bf16(a[i], b[j], acc[i][j], 0, 0, 0);
            }
        }
        __syncthreads();
#pragma unroll
        for (int i = 0; i < 4; ++i)
#pragma unroll
            for (int j = 0; j < 4; ++j)
#pragma unroll
                for (int r = 0; r < 4; ++r) Cs[(wr * 64 + i * 16 + (lane >> 4) * 4 + r) * LDC_S + wc * 64 + j * 16 + (lane & 15)] = acc[i][j][r];
        __syncthreads();
        const bool tr = E.transposed(pn);
        for (int rr = 0; rr < 16; ++rr) {
            const int row = wave * 16 + rr;
            f32x4 v = *(LAS f32x4*)(Cs + row * LDC_S + lane * 4);
            v = E(v, pm * 128 + row, pn, lane);
            if (tr) *(LAS f32x4*)(Cs + row * LDC_S + lane * 4) = v;
        }
        if (tr) { __syncthreads(); E.store_T(Cs, pm, pn, tid); }
    }
    __syncthreads();
}

struct EpiMemKV {
    bf16* memk; bf16* memvT; const float* rinvm; const float* xk_g;
    __device__ __forceinline__ bool transposed(int pn) const { return pn >= 4; }
    __device__ __forceinline__ void store_T(LAS float* Cs, int pm, int pn, int tid) const {
#pragma unroll
        for (int it = 0; it < 8; ++it) {
            const int item = it * NTHR + tid, rg = item & 15, col = item >> 4;
            float f[8];
#pragma unroll
            for (int i = 0; i < 8; ++i) f[i] = Cs[(rg * 8 + i) * LDC_S + col];
            u32x4 o; o[0] = pk2(f[0], f[1]); o[1] = pk2(f[2], f[3]); o[2] = pk2(f[4], f[5]); o[3] = pk2(f[6], f[7]);
            const int row0 = pm * 128 + rg * 8, b = row0 / MEML, key = row0 % MEML;
            *(u32x4*)(memvT + ((size_t)(b * 4 + pn - 4) * 256 + col) * MEML + key) = o;
        }
    }
    __device__ __forceinline__ f32x4 operator()(f32x4 v, int gr, int pn, int lane) const {
        v = v * rinvm[gr];
        if (pn < 4) {
            float ss = wave_sum(v[0] * v[0] + v[1] * v[1] + v[2] * v[2] + v[3] * v[3]);
            const float inv = rsqrtf(ss * (1.f / 256.f) + EPS);
            const float* g = xk_g + pn * 256 + 4 * lane;
            v[0] *= inv * g[0]; v[1] *= inv * g[1]; v[2] *= inv * g[2]; v[3] *= inv * g[3];
            u32x2 o; o[0] = pk2(v[0], v[1]); o[1] = pk2(v[2], v[3]);
            *(u32x2*)(memk + (size_t)gr * DM + pn * 256 + 4 * lane) = o;
        }
        return v;
    }
};

typedef float f32x16 __attribute__((ext_vector_type(16)));
#define MFMA32(a, b, c) __builtin_amdgcn_mfma_f32_32x32x16_bf16((a), (b), (c), 0, 0, 0)
__device__ __forceinline__ bf16x8 pack8(float a0, float a1, float a2, float a3, float a4, float a5, float a6, float a7) {
    u32x4 p; p[0] = pk2(a0, a1); p[1] = pk2(a2, a3); p[2] = pk2(a4, a5); p[3] = pk2(a6, a7);
    return __builtin_bit_cast(bf16x8, p);
}
__device__ void sb_mfma(const Frame& F, const bf16* proj, const bf16* T, bf16* mix) {
    const int lane = F.lane, r = lane & 31, hh = lane >> 5;
    const int gw = F.bid * NWAVES + F.wave, GW = F.G * NWAVES;
    const float c1 = 0.18033688011112042f;
    for (int u = gw; u < BATCH * 8 * 128; u += GW) {
        const int qb = 127 - (u & 127), hd = (u >> 7) & 7, b = u >> 10;
        const int q0 = qb * 32;
        const float gq = wave_max(fabsf(F.sb_q_g[hd * 64 + lane])), gk = wave_max(fabsf(F.sb_k_g[hd * 64 + lane]));
        const float thresh = 152.f + c1 * 64.f * gq * gk * 1.02f;
        bf16x8 qf[4];
        {
            const bf16* qp = proj + ((size_t)b * SEQ + q0 + r) * NPROJ + P_SQ + hd * 64 + 8 * hh;
#pragma unroll
            for (int s = 0; s < 4; ++s) qf[s] = *(const bf16x8*)(qp + 16 * s);
        }
        f32x16 o0, o1;
#pragma unroll
        for (int i = 0; i < 16; ++i) { o0[i] = 0.f; o1[i] = 0.f; }
        float carry = 0.f;
        const bf16* vbase = T + ((size_t)b * NT + TC_SV + hd * 64 + r) * SEQ + 4 * hh;
        for (int k0 = q0; k0 >= 0; k0 -= 32) {
            bf16x8 kf[4];
            {
                const bf16* kp = proj + ((size_t)b * SEQ + k0 + r) * NPROJ + P_SK + hd * 64 + 8 * hh;
#pragma unroll
                for (int s = 0; s < 4; ++s) kf[s] = *(const bf16x8*)(kp + 16 * s);
            }
            u32x2 vl[2][2][2];
#pragma unroll
            for (int n = 0; n < 2; ++n)
#pragma unroll
                for (int ks = 0; ks < 2; ++ks) {
                    const bf16* vp = vbase + (size_t)(32 * n) * SEQ + k0 + 16 * ks;
                    vl[n][ks][0] = *(const u32x2*)(vp); vl[n][ks][1] = *(const u32x2*)(vp + 8);
                }
            f32x16 x;
#pragma unroll
            for (int i = 0; i < 16; ++i) x[i] = 0.f;
#pragma unroll
            for (int s = 0; s < 4; ++s) x = MFMA32(kf[s], qf[s], x);
            const bool diag = (k0 == q0);
            f32x16 tt, ll;
#pragma unroll
            for (int i = 0; i < 16; ++i) {
                const int key = (i & 3) + 8 * (i >> 2) + 4 * hh;
                const bool valid = !diag || (key < r);
                const float t = x[i] * c1;
                const float l = __builtin_amdgcn_logf(1.f + __builtin_amdgcn_exp2f(t));
                tt[i] = valid ? t : -1e30f; ll[i] = valid ? l : 0.f;
            }
            float gt[4], pt[4];
#pragma unroll
            for (int g = 0; g < 4; ++g) {
                ll[4 * g + 2] += ll[4 * g + 3]; ll[4 * g + 1] += ll[4 * g + 2]; ll[4 * g] += ll[4 * g + 1];
                gt[g] = ll[4 * g]; pt[g] = __shfl_xor(gt[g], 32);
            }
            const float T0 = gt[0] + pt[0], T1 = gt[1] + pt[1], T2 = gt[2] + pt[2], T3 = gt[3] + pt[3];
            const float R2 = T3, R1 = R2 + T2, R0 = R1 + T1;
            float bs[4];
            bs[0] = carry + R0 + (hh == 0 ? pt[0] : 0.f); bs[1] = carry + R1 + (hh == 0 ? pt[1] : 0.f);
            bs[2] = carry + R2 + (hh == 0 ? pt[2] : 0.f); bs[3] = carry + (hh == 0 ? pt[3] : 0.f);
            carry += R0 + T0;
#pragma unroll
            for (int i = 0; i < 16; ++i) x[i] = __builtin_amdgcn_exp2f(tt[i] - (bs[i >> 2] + ll[i]));
#pragma unroll
            for (int ks = 0; ks < 2; ++ks) {
                const bf16x8 pf = pack8(x[8 * ks], x[8 * ks + 1], x[8 * ks + 2], x[8 * ks + 3], x[8 * ks + 4], x[8 * ks + 5], x[8 * ks + 6], x[8 * ks + 7]);
                u32x4 v0; v0[0] = vl[0][ks][0][0]; v0[1] = vl[0][ks][0][1]; v0[2] = vl[0][ks][1][0]; v0[3] = vl[0][ks][1][1];
                u32x4 v1; v1[0] = vl[1][ks][0][0]; v1[1] = vl[1][ks][0][1]; v1[2] = vl[1][ks][1][0]; v1[3] = vl[1][ks][1][1];
                o0 = MFMA32(pf, __builtin_bit_cast(bf16x8, v0), o0);
                o1 = MFMA32(pf, __builtin_bit_cast(bf16x8, v1), o1);
            }
            if (__all(carry > thresh)) break;
        }
        bf16* op = mix + ((size_t)b * SEQ + q0 + 4 * hh) * DM + 512 + hd * 64 + r;
#pragma unroll
        for (int i = 0; i < 16; ++i) {
            const int qr = (i & 3) + 8 * (i >> 2);
            op[(size_t)qr * DM] = (bf16)f2bf(o0[i]);
            op[(size_t)qr * DM + 32] = (bf16)f2bf(o1[i]);
        }
    }
}
__device__ void ret_kv(const Frame& F, const bf16* T, float* KVs) {
    const int lane = F.lane, r = lane & 31, hh = lane >> 5, mt = F.wave >> 1, nt0 = (F.wave & 1) * 2;
    for (int u = F.bid; u < BATCH * 4 * 32; u += F.G) {
        const int c = u & 31, h = (u >> 5) & 3, b = u >> 7, s0 = c * 128;
        const bf16* vp = T + ((size_t)b * NT + TC_RV + h * 128 + 32 * mt + r) * SEQ + s0 + 8 * hh;
        const bf16* kp0 = T + ((size_t)b * NT + TC_RK + h * 128 + 32 * nt0 + r) * SEQ + s0 + 8 * hh;
        const bf16* kp1 = kp0 + (size_t)32 * SEQ;
        f32x16 a0, a1;
#pragma unroll
        for (int i = 0; i < 16; ++i) { a0[i] = 0.f; a1[i] = 0.f; }
#pragma unroll
        for (int ks = 0; ks < 8; ++ks) {
            const bf16x8 vf = *(const bf16x8*)(vp + 16 * ks), k0f = *(const bf16x8*)(kp0 + 16 * ks), k1f = *(const bf16x8*)(kp1 + 16 * ks);
            a0 = MFMA32(vf, k0f, a0); a1 = MFMA32(vf, k1f, a1);
        }
        const float g128 = __builtin_amdgcn_exp2f(128.f * lg2gamma(h));
        float* op = KVs + (size_t)u * 16384 + (size_t)(32 * mt + 4 * hh) * 128 + 32 * nt0 + r;
#pragma unroll
        for (int i = 0; i < 16; ++i) { const int row = (i & 3) + 8 * (i >> 2); op[row * 128] = a0[i] * g128; op[row * 128 + 32] = a1[i] * g128; }
    }
}
__device__ void ret_scan(const Frame& F, float* KVs, int wb, int nwb) {
    for (int it = (F.bid - wb) * NTHR + F.tid; it < 16 * 4096; it += nwb * NTHR) {
        const int bh = it >> 12, e4 = (it & 4095) * 4;
        const float g128 = __builtin_amdgcn_exp2f(128.f * lg2gamma(bh & 3));
        float* p = KVs + (size_t)bh * 32 * 16384 + e4;
        f32x4 st = (f32x4){0.f, 0.f, 0.f, 0.f};
#pragma unroll 1
        for (int cb = 0; cb < 4; ++cb) {
            f32x4 t[8];
#pragma unroll
            for (int c = 0; c < 8; ++c) t[c] = *(const f32x4*)(p + (size_t)(cb * 8 + c) * 16384);
#pragma unroll
            for (int c = 0; c < 8; ++c) { *(f32x4*)(p + (size_t)(cb * 8 + c) * 16384) = st; st = st * g128 + t[c]; }
        }
    }
}
__device__ void ret_out(const Frame& F, const bf16* proj, const bf16* T, const float* KVs, bf16* mix) {
    const int lane = F.lane, r = lane & 31, hh = lane >> 5;
    const int gw = F.bid * NWAVES + F.wave, GW = F.G * NWAVES;
    for (int wu = gw; wu < BATCH * 4 * 32 * 4; wu += GW) {
        const int u = wu >> 2, wq = wu & 3, c = u & 31, h = (u >> 5) & 3, b = u >> 7;
        const int q0 = c * 128 + 32 * wq;
        bf16x8 qf[8];
        {
            const bf16* qp = proj + ((size_t)b * SEQ + q0 + r) * NPROJ + P_RQ + h * 128 + 8 * hh;
#pragma unroll
            for (int s = 0; s < 8; ++s) qf[s] = *(const bf16x8*)(qp + 16 * s);
        }
        f32x16 o[4];
#pragma unroll
        for (int n = 0; n < 4; ++n)
#pragma unroll
            for (int i = 0; i < 16; ++i) o[n][i] = 0.f;
        {
            const float* sp = KVs + (size_t)u * 16384 + (size_t)r * 128 + 8 * hh;
#pragma unroll
            for (int n = 0; n < 4; ++n)
#pragma unroll
                for (int ks = 0; ks < 8; ++ks) {
                    const f32x4 lo = *(const f32x4*)(sp + n * 32 * 128 + 16 * ks), hi = *(const f32x4*)(sp + n * 32 * 128 + 16 * ks + 4);
                    o[n] = MFMA32(qf[ks], pack8(lo[0], lo[1], lo[2], lo[3], hi[0], hi[1], hi[2], hi[3]), o[n]);
                }
        }
        for (int kt = 0; kt <= wq; ++kt) {
            const int k0 = c * 128 + 32 * kt;
            f32x16 x;
#pragma unroll
            for (int i = 0; i < 16; ++i) x[i] = 0.f;
            {
                const bf16* kp = proj + ((size_t)b * SEQ + k0 + r) * NPROJ + P_RK + h * 128 + 8 * hh;
#pragma unroll
                for (int s = 0; s < 8; ++s) x = MFMA32(*(const bf16x8*)(kp + 16 * s), qf[s], x);
            }
            if (kt == wq) {
#pragma unroll
                for (int i = 0; i < 16; ++i) { const int key = (i & 3) + 8 * (i >> 2) + 4 * hh; x[i] = (key <= r) ? x[i] : 0.f; }
            }
#pragma unroll
            for (int ks = 0; ks < 2; ++ks) {
                const bf16x8 pf = pack8(x[8 * ks], x[8 * ks + 1], x[8 * ks + 2], x[8 * ks + 3], x[8 * ks + 4], x[8 * ks + 5], x[8 * ks + 6], x[8 * ks + 7]);
#pragma unroll
                for (int n = 0; n < 4; ++n) {
                    const bf16* vp = T + ((size_t)b * NT + TC_RV + h * 128 + 32 * n + r) * SEQ + k0 + 16 * ks + 4 * hh;
                    const u32x2 lo = *(const u32x2*)(vp), hi = *(const u32x2*)(vp + 8);
                    u32x4 vv; vv[0] = lo[0]; vv[1] = lo[1]; vv[2] = hi[0]; vv[3] = hi[1];
                    o[n] = MFMA32(pf, __builtin_bit_cast(bf16x8, vv), o[n]);
                }
            }
        }
#pragma unroll
        for (int i = 0; i < 16; ++i) {
            float ss = o[0][i] * o[0][i] + o[1][i] * o[1][i] + o[2][i] * o[2][i] + o[3][i] * o[3][i];
            ss += __shfl_xor(ss, 1); ss += __shfl_xor(ss, 2); ss += __shfl_xor(ss, 4); ss += __shfl_xor(ss, 8); ss += __shfl_xor(ss, 16);
            const float inv = rsqrtf(ss * (1.f / 128.f) + EPS);
            const size_t row = (size_t)b * SEQ + q0 + (i & 3) + 8 * (i >> 2) + 4 * hh;
#pragma unroll
            for (int n = 0; n < 4; ++n) {
                const int dv = h * 128 + 32 * n + r;
                const float g = bf2f(proj[row * NPROJ + P_RG + dv]);
                const float val = o[n][i] * inv * F.ret_gn_g[dv] * (g / (1.f + __expf(-g)));
                mix[row * DM + dv] = (bf16)f2bf(val);
            }
        }
    }
}
constexpr int XK_ROW = 528, XV_ROW = 80, XV_OFF = 32 * XK_ROW, XBUF = XV_OFF + 256 * XV_ROW;
__device__ void xattn_mfma(const Frame& F, const bf16* xq, const float* ssqq, const bf16* memk, const bf16* memvT, bf16* xo) {
    const int tid = F.tid, lane = F.lane, r = lane & 31, hh = lane >> 5, qg = F.wave >> 1, dh = F.wave & 1;
    const int kr = (r & ~12) | ((r & 4) << 1) | ((r & 8) >> 1);
    for (int u = F.bid; u < BATCH * 4 * 32; u += F.G) {
        const int qblk = u & 31, h = (u >> 5) & 3, b = u >> 7, q0 = qblk * 128 + 32 * qg;
        const bf16* kg = memk + ((size_t)b * MEML + (tid >> 5)) * DM + h * 256 + (tid & 31) * 8;
        const bf16* vg = memvT + ((size_t)(b * 4 + h) * 256 + (tid >> 2)) * MEML + (tid & 3) * 8;
        const int kl = (tid >> 5) * XK_ROW + (tid & 31) * 16, vl = XV_OFF + (tid >> 2) * XV_ROW + (tid & 3) * 16;
        u32x4 sk0 = *(const u32x4*)(kg), sk1 = *(const u32x4*)(kg + (size_t)16 * DM), sv0 = *(const u32x4*)(vg), sv1 = *(const u32x4*)(vg + (size_t)128 * MEML);
        bf16x8 qf[16];
        {
            const size_t grow = (size_t)b * SEQ + q0 + r;
            const f32x4 pq = *(const f32x4*)(ssqq + grow * 16 + h * 4);
            const float sc = rsqrtf(((pq[0] + pq[1]) + (pq[2] + pq[3])) * (1.f / 256.f) + EPS) * 0.09016844005556021f;
            const bf16* qp = xq + grow * DM + h * 256 + 8 * hh;
            const float* gp = F.xq_g + h * 256 + 8 * hh;
#pragma unroll
            for (int s = 0; s < 16; ++s) {
                const u32x4 v = *(const u32x4*)(qp + 16 * s);
                const f32x4 g0 = *(const f32x4*)(gp + 16 * s), g1 = *(const f32x4*)(gp + 16 * s + 4);
                qf[s] = pack8(bflo(v[0]) * sc * g0[0], bfhi(v[0]) * sc * g0[1], bflo(v[1]) * sc * g0[2], bfhi(v[1]) * sc * g0[3],
                              bflo(v[2]) * sc * g1[0], bfhi(v[2]) * sc * g1[1], bflo(v[3]) * sc * g1[2], bfhi(v[3]) * sc * g1[3]);
            }
        }
        *(LAS u32x4*)(F.lds + kl) = sk0; *(LAS u32x4*)(F.lds + kl + 16 * XK_ROW) = sk1; *(LAS u32x4*)(F.lds + vl) = sv0; *(LAS u32x4*)(F.lds + vl + 128 * XV_ROW) = sv1;
        __syncthreads();
        f32x16 o[4];
#pragma unroll
        for (int n = 0; n < 4; ++n)
#pragma unroll
            for (int i = 0; i < 16; ++i) o[n][i] = 0.f;
        float m = 0.f, l = 0.f;
        for (int kt = 0; kt < 8; ++kt) {
            LAS unsigned char* buf = F.lds + (kt & 1) * XBUF;
            if (kt < 7) { sk0 = *(const u32x4*)(kg + (size_t)(kt + 1) * 32 * DM); sk1 = *(const u32x4*)(kg + (size_t)((kt + 1) * 32 + 16) * DM); sv0 = *(const u32x4*)(vg + (kt + 1) * 32); sv1 = *(const u32x4*)(vg + (size_t)128 * MEML + (kt + 1) * 32); }
            f32x16 x;
#pragma unroll
            for (int i = 0; i < 16; ++i) x[i] = 0.f;
#pragma unroll
            for (int s = 0; s < 16; ++s) x = MFMA32(*(LAS bf16x8*)(buf + kr * XK_ROW + 32 * s + 16 * hh), qf[s], x);
            float tmax = x[0];
#pragma unroll
            for (int i = 1; i < 16; ++i) tmax = fmaxf(tmax, x[i]);
            tmax = fmaxf(tmax, __shfl_xor(tmax, 32));
            if (kt == 0) m = tmax;
            else if (__any(tmax > m + 8.f)) {
                const float mn = fmaxf(m, tmax), alpha = __builtin_amdgcn_exp2f(m - mn);
                m = mn; l *= alpha;
#pragma unroll
                for (int i = 0; i < 16; ++i) {
                    const float ai = __shfl(alpha, (i & 3) + 8 * (i >> 2) + 4 * hh);
#pragma unroll
                    for (int n = 0; n < 4; ++n) o[n][i] *= ai;
                }
            }
            float ps = 0.f;
#pragma unroll
            for (int i = 0; i < 16; ++i) { x[i] = __builtin_amdgcn_exp2f(x[i] - m); ps += x[i]; }
            ps += __shfl_xor(ps, 32);
            l += ps;
#pragma unroll
            for (int ks = 0; ks < 2; ++ks) {
                const bf16x8 pf = pack8(x[8 * ks], x[8 * ks + 1], x[8 * ks + 2], x[8 * ks + 3], x[8 * ks + 4], x[8 * ks + 5], x[8 * ks + 6], x[8 * ks + 7]);
#pragma unroll
                for (int n = 0; n < 4; ++n)
                    o[n] = MFMA32(pf, *(LAS bf16x8*)(buf + XV_OFF + (32 * (4 * dh + n) + r) * XV_ROW + 32 * ks + 16 * hh), o[n]);
            }
            if (kt < 7) {
                LAS unsigned char* nb = F.lds + ((kt + 1) & 1) * XBUF;
                *(LAS u32x4*)(nb + kl) = sk0; *(LAS u32x4*)(nb + kl + 16 * XK_ROW) = sk1; *(LAS u32x4*)(nb + vl) = sv0; *(LAS u32x4*)(nb + vl + 128 * XV_ROW) = sv1;
            }
            __syncthreads();
        }
        const float linv = 1.f / l;
#pragma unroll
        for (int i = 0; i < 16; ++i) {
            const int qr = (i & 3) + 8 * (i >> 2) + 4 * hh;
            const float li = __shfl(linv, qr);
            bf16* op = xo + ((size_t)b * SEQ + q0 + qr) * DM + h * 256 + 128 * dh + r;
#pragma unroll
            for (int n = 0; n < 4; ++n) op[32 * n] = (bf16)f2bf(o[n][i] * li);
        }
    }
}

__global__ void __launch_bounds__(NTHR, 2) fwd_kernel(Args args) {
    extern __shared__ __attribute__((aligned(16))) unsigned char lds_raw[];
    Frame F;
    F.lds = (LAS unsigned char*)lds_raw;
    F.tid = threadIdx.x; F.lane = F.tid & 63; F.wave = __builtin_amdgcn_readfirstlane(F.tid >> 6);
    F.G = gridDim.x; F.bid = blockIdx.x;
    F.x = (const float*)args.in[0]; F.mem = (const float*)args.in[1]; F.pos = (const int*)args.in[2];
    F.g_mix = (const float*)args.in[3]; F.w_in = (const float*)args.in[4]; F.ret_gn_g = (const float*)args.in[5];
    F.sb_q_g = (const float*)args.in[6]; F.sb_k_g = (const float*)args.in[7]; F.w_out = (const float*)args.in[8];
    F.g_xattn = (const float*)args.in[9]; F.g_mem = (const float*)args.in[10]; F.w_xq = (const float*)args.in[11];
    F.w_xkv = (const float*)args.in[12]; F.xq_g = (const float*)args.in[13]; F.xk_g = (const float*)args.in[14];
    F.w_xo = (const float*)args.in[15]; F.g_mlp = (const float*)args.in[16]; F.w_up = (const float*)args.in[17]; F.w_down = (const float*)args.in[18];
    F.out = args.out; F.ws = args.ws;
    unsigned char* ws = args.ws;
    volatile LAS unsigned* MISC = (volatile LAS unsigned*)(F.lds + MISC_OFF);
    if (F.tid < 64) MISC[F.tid] = 0u;
    __syncthreads();
    XcdBarrier bar; bar.bar = (unsigned*)(ws + WS_CTL) + 1024 + args.li * 4096; bar.x = 0; bar.st = nullptr;
    if (MK_N_LAUNCHES != NPHASE) bar = xcd_barrier_post(bar.bar, MISC + 8);
#define GRID_BAR() do { if (MK_N_LAUNCHES != NPHASE) xcd_barrier(bar); } while (0)
    const int lo = args.ph_lo, hi = args.ph_hi;
#define IN(k) (lo <= (k) && (k) < hi)
#define BOTH(k) (IN(k) && IN((k) + 1))

    bf16* Wt_in = (bf16*)(ws + WS_WIN); bf16* Wt_out = (bf16*)(ws + WS_WOUT); bf16* Wt_xq = (bf16*)(ws + WS_WXQ); bf16* Wt_xkv = (bf16*)(ws + WS_WXKV);
    bf16* Wt_xo = (bf16*)(ws + WS_WXO); bf16* Wt_up = (bf16*)(ws + WS_WUP); bf16* Wt_dn = (bf16*)(ws + WS_WDN);
    float* rinv1 = (float*)(ws + WS_RINV1); float* rinvm = (float*)(ws + WS_RINVM); float* ssq2 = (float*)(ws + WS_SSQ2); float* ssq3 = (float*)(ws + WS_SSQ3); float* ssqq = (float*)(ws + WS_SSQQ);
    bf16* memb = (bf16*)(ws + WS_MEMB); bf16* memk = (bf16*)(ws + WS_MEMK); bf16* memvT = (bf16*)(ws + WS_MEMV);
    float2* cs = (float2*)(ws + WS_ROPE);
    bf16* xb = (bf16*)(ws + WS_XB); bf16* mix = (bf16*)(ws + WS_MIX); bf16* proj = (bf16*)(ws + WS_PROJ);
    bf16* x1b = (bf16*)(ws + WS_X1B); bf16* xq = (bf16*)(ws + WS_XQ); bf16* xo = (bf16*)(ws + WS_XO); bf16* x2b = (bf16*)(ws + WS_X2B); bf16* hid = (bf16*)(ws + WS_HID); bf16* T = (bf16*)(ws + WS_T); float* KVs = (float*)(ws + WS_KVS);

    if (IN(0)) {
#pragma nounroll
        for (int rep = 0; rep < (((PROBE_MASK >> 0) & 1) ? 2 : 1); ++rep) {
            if (rep) GRID_BAR();
            conv_weight<true>(F, F.w_in, F.g_mix, Wt_in, DM, NIN);
            conv_weight<false>(F, F.w_out, nullptr, Wt_out, DM, DM);
            conv_weight<false>(F, F.w_xq, F.g_xattn, Wt_xq, DM, DM);
            conv_weight<false>(F, F.w_xkv, F.g_mem, Wt_xkv, DM, 2 * DM);
            conv_weight<false>(F, F.w_xo, nullptr, Wt_xo, DM, DM);
            conv_weight<false>(F, F.w_up, F.g_mlp, Wt_up, DM, FF);
            conv_weight<false>(F, F.w_down, nullptr, Wt_dn, FF, DM);
            rows_prep(F, F.x, xb, rinv1, M);
            rows_prep(F, F.mem, memb, rinvm, MROWS);
            rope_table(F, cs);
        }
        if (BOTH(0)) GRID_BAR();
    }
    if (IN(1)) {
#pragma nounroll
        for (int rep = 0; rep < (((PROBE_MASK >> 1) & 1) ? 2 : 1); ++rep) {
            if (rep) GRID_BAR();
            { EpiInProj E{proj, rinv1, cs, F.sb_q_g, F.sb_k_g, T}; gemm_big(F, xb, Wt_in, NIN, DM, E); }
        }
        if (BOTH(1)) GRID_BAR();
    }
    if (IN(2)) {
#pragma nounroll
        for (int rep = 0; rep < (((PROBE_MASK >> 2) & 1) ? 2 : 1); ++rep) {
            if (rep) GRID_BAR();
            ret_kv(F, T, KVs);
            sb_mfma(F, proj, T, mix);
        }
        if (BOTH(2)) GRID_BAR();
    }
    if (IN(3)) {
#pragma nounroll
        for (int rep = 0; rep < (((PROBE_MASK >> 3) & 1) ? 2 : 1); ++rep) {
            if (rep) GRID_BAR();
            const int nmk = (F.G > 128) ? 64 : 0;
            if (nmk == 0 || F.bid < nmk) { Frame Fm = F; if (nmk) Fm.G = nmk; EpiMemKV E{memk, memvT, rinvm, F.xk_g}; gemm_phase_v1(Fm, memb, Wt_xkv, MROWS, 2 * DM, DM, E); }
            if (nmk == 0 || F.bid >= nmk) ret_scan(F, KVs, nmk, F.G - nmk);
        }
        if (BOTH(3)) GRID_BAR();
    }
    if (IN(4)) {
#pragma nounroll
        for (int rep = 0; rep < (((PROBE_MASK >> 4) & 1) ? 2 : 1); ++rep) {
            if (rep) GRID_BAR();
            ret_out(F, proj, T, KVs, mix);
        }
        if (BOTH(4)) GRID_BAR();
    }
    if (IN(5)) {
#pragma nounroll
        for (int rep = 0; rep < (((PROBE_MASK >> 5) & 1) ? 2 : 1); ++rep) {
            if (rep) GRID_BAR();
            EpiResid E{F.x, F.out, x1b, ssq2}; gemm_big(F, mix, Wt_out, DM, DM, E);
        }
        if (BOTH(5)) GRID_BAR();
    }
    if (IN(6)) {
#pragma nounroll
        for (int rep = 0; rep < (((PROBE_MASK >> 6) & 1) ? 2 : 1); ++rep) {
            if (rep) GRID_BAR();
            EpiXQ E{xq, ssq2, ssqq}; gemm_big(F, x1b, Wt_xq, DM, DM, E);
        }
        if (BOTH(6)) GRID_BAR();
    }
    if (IN(7)) {
#pragma nounroll
        for (int rep = 0; rep < (((PROBE_MASK >> 7) & 1) ? 2 : 1); ++rep) {
            if (rep) GRID_BAR();
            xattn_mfma(F, xq, ssqq, memk, memvT, xo);
        }
        if (BOTH(7)) GRID_BAR();
    }
    if (IN(8)) {
#pragma nounroll
        for (int rep = 0; rep < (((PROBE_MASK >> 8) & 1) ? 2 : 1); ++rep) {
            if (rep) GRID_BAR();
            EpiResid E{F.out, F.out, x2b, ssq3}; gemm_big(F, xo, Wt_xo, DM, DM, E);
        }
        if (BOTH(8)) GRID_BAR();
    }
    if (IN(9)) {
#pragma nounroll
        for (int rep = 0; rep < (((PROBE_MASK >> 9) & 1) ? 2 : 1); ++rep) {
            if (rep) GRID_BAR();
            EpiUp E{hid, ssq3}; gemm_big(F, x2b, Wt_up, FF, DM, E);
        }
        if (BOTH(9)) GRID_BAR();
    }
    if (IN(10)) {
#pragma nounroll
        for (int rep = 0; rep < (((PROBE_MASK >> 10) & 1) ? 2 : 1); ++rep) {
            if (rep) GRID_BAR();
            EpiDown E{F.out}; gemm_big(F, hid, Wt_dn, DM, FF, E);
        }
    }
#undef IN
#undef BOTH
}

extern "C" void kernel_launch(void* const* d_in, const int* in_sizes, int n_in, void* d_out, int out_size, void* d_ws, size_t ws_size, hipStream_t stream) {
    static int grid = 0;
    if (grid == 0) {
        if (n_in != 19 || in_sizes[0] != M * DM || out_size != M * DM || ws_size < WS_END) { fprintf(stderr, "kernel_launch: unexpected shapes (n_in %d, in0 %d, out %d, ws %zu); nothing launched\n", n_in, n_in > 0 ? in_sizes[0] : -1, out_size, ws_size); grid = -1; return; }
        int dev = 0, cus = 0, per_cu = 0;
        if (hipGetDevice(&dev) != hipSuccess || hipDeviceGetAttribute(&cus, hipDeviceAttributeMultiprocessorCount, dev) != hipSuccess) { grid = -1; return; }
        if (hipFuncSetAttribute((const void*)fwd_kernel, hipFuncAttributeMaxDynamicSharedMemorySize, LDS_BYTES) != hipSuccess) { fprintf(stderr, "kernel_launch: hipFuncSetAttribute failed\n"); grid = -1; return; }
        if (hipOccupancyMaxActiveBlocksPerMultiprocessor(&per_cu, (const void*)fwd_kernel, NTHR, LDS_BYTES) != hipSuccess || per_cu < 1) fprintf(stderr, "kernel_launch: occupancy query reports %d per CU\n", per_cu);
        (void)hipGetLastError();
        grid = cus;
    }
    if (grid < 0) return;
    (void)hipMemsetAsync((char*)d_ws + WS_CTL, 0, CTL_ZERO_BYTES, stream);
    Args a{};
    for (int i = 0; i < 19; ++i) a.in[i] = d_in[i];
    a.out = (float*)d_out; a.ws = (unsigned char*)d_ws;
    for (int li = 0; li < MK_N_LAUNCHES; ++li) {
        a.ph_lo = (MK_N_LAUNCHES == NPHASE) ? li : 0; a.ph_hi = (MK_N_LAUNCHES == NPHASE) ? li + 1 : NPHASE; a.li = li; a.pad = 0;
        hipLaunchKernelGGL(fwd_kernel, dim3(grid), dim3(NTHR), LDS_BYTES, stream, a);
    }
}
```

```cpp
#include <hip/hip_runtime.h>
#include <stdint.h>
#include <cstdio>

#define LAS __attribute__((address_space(3)))
#define GAS __attribute__((address_space(1)))
typedef unsigned short bf16;
typedef short bf16x8 __attribute__((ext_vector_type(8)));
typedef float f32x4 __attribute__((ext_vector_type(4)));
typedef unsigned u32x4 __attribute__((ext_vector_type(4)));
typedef unsigned u32x2 __attribute__((ext_vector_type(2)));
typedef GAS unsigned gu32;

#ifndef MK_N_LAUNCHES
#define MK_N_LAUNCHES 1
#endif
constexpr int NPHASE = 11;
#ifndef PROBE_MASK
#define PROBE_MASK 0
#endif
constexpr int NWAVES = 8, NTHR = 512;

constexpr int BATCH = 4, SEQ = 4096, DM = 1024, M = BATCH * SEQ;
constexpr int NIN = 3584, FF = 4096, MEML = 256, MROWS = BATCH * MEML;
constexpr int NPROJ = 2560, P_RQ = 0, P_RK = 512, P_RG = 1024, P_SQ = 1536, P_SK = 2048;
constexpr int NT = 1536, TC_RK = 0, TC_RV = 512, TC_SV = 1024;
constexpr float EPS = 1e-6f;

constexpr size_t MiB = 1u << 20;
constexpr size_t WS_CTL = 0, CTL_ZERO_BYTES = 64 * 1024;
constexpr size_t WS_WIN = 1 * MiB, WS_WOUT = 8 * MiB, WS_WXQ = 10 * MiB, WS_WXKV = 12 * MiB, WS_WXO = 16 * MiB, WS_WUP = 18 * MiB, WS_WDN = 26 * MiB;
constexpr size_t WS_RINV1 = 34 * MiB, WS_RINVM = 34 * MiB + 64 * 1024;
constexpr size_t WS_SSQ2 = 241 * MiB, WS_SSQ3 = 242 * MiB, WS_SSQQ = 243 * MiB;
constexpr size_t WS_MEMB = 35 * MiB, WS_MEMK = 37 * MiB, WS_MEMV = 39 * MiB;
constexpr size_t WS_ROPE = 41 * MiB;
constexpr size_t WS_XB = 49 * MiB, WS_MIX = 49 * MiB;
constexpr size_t WS_PROJ = 81 * MiB;
constexpr size_t WS_T = 161 * MiB;
constexpr size_t WS_KVS = 209 * MiB;
constexpr size_t WS_X1B = 81 * MiB, WS_XQ = 113 * MiB, WS_XO = 145 * MiB;
constexpr size_t WS_X2B = 193 * MiB;
constexpr size_t WS_HID = 49 * MiB;
constexpr size_t WS_END = 244 * MiB;

constexpr int LDS_BYTES = 147456;
constexpr int MISC_OFF = 144 * 1024 - 256;

__device__ const double INVF[64] = {1.0, 0.8659643233600653, 0.7498942093324559, 0.6493816315762113, 0.5623413251903491, 0.4869675251658631, 0.4216965034285822, 0.3651741272548377, 0.31622776601683794, 0.27384196342643613, 0.23713737056616552, 0.2053525026457146, 0.1778279410038923, 0.1539926526059492, 0.1333521432163324, 0.11547819846894582, 0.1, 0.08659643233600653, 0.07498942093324558, 0.06493816315762113, 0.05623413251903491, 0.04869675251658631, 0.042169650342858224, 0.03651741272548377, 0.03162277660168379, 0.027384196342643614, 0.023713737056616554, 0.02053525026457146, 0.01778279410038923, 0.01539926526059492, 0.01333521432163324, 0.011547819846894581, 0.01, 0.008659643233600654, 0.007498942093324558, 0.006493816315762113, 0.005623413251903491, 0.004869675251658631, 0.004216965034285823, 0.003651741272548377, 0.0031622776601683794, 0.0027384196342643613, 0.0023713737056616554, 0.002053525026457146, 0.0017782794100389228, 0.001539926526059492, 0.001333521432163324, 0.0011547819846894581, 0.001, 0.0008659643233600654, 0.0007498942093324559, 0.0006493816315762113, 0.0005623413251903491, 0.0004869675251658631, 0.00042169650342858224, 0.0003651741272548377, 0.00031622776601683794, 0.0002738419634264361, 0.00023713737056616554, 0.0002053525026457146, 0.00017782794100389227, 0.0001539926526059492, 0.0001333521432163324, 0.00011547819846894582};

__device__ __forceinline__ float bflo(unsigned u) { return __uint_as_float(u << 16); }
__device__ __forceinline__ float bfhi(unsigned u) { return __uint_as_float(u & 0xffff0000u); }
__device__ __forceinline__ float bf2f(bf16 v) { return __uint_as_float(((unsigned)v) << 16); }
__device__ __forceinline__ unsigned f2bf(float f) { unsigned u = __float_as_uint(f); return (u + 0x7fffu + ((u >> 16) & 1u)) >> 16; }
__device__ __forceinline__ unsigned pk2(float lo, float hi) { return f2bf(lo) | (f2bf(hi) << 16); }
__device__ __forceinline__ float wave_sum(float v) {
#pragma unroll
    for (int o = 1; o < 64; o <<= 1) v += __shfl_xor(v, o);
    return v;
}
__device__ __forceinline__ float wave_max(float v) {
#pragma unroll
    for (int o = 1; o < 64; o <<= 1) v = fmaxf(v, __shfl_xor(v, o));
    return v;
}
#define CBAR() asm volatile("" ::: "memory")
__device__ __forceinline__ float lg2gamma(int h) { return h == 0 ? -0.04580368961312479f : h == 1 ? -0.02272007650008353f : h == 2 ? -0.011315313227834146f : -0.005646563141142063f; }

#define XB_TMO      128
#define XB_XCNT(j)  (256  + 64 * (j))
#define XB_XSUB(j)  (1280 + 64 * (j))
#define XB_XGEN(j)  (2304 + 64 * (j))
#define XB_TOP      3328
#define XB_TOPGEN   3392
#define XCD_BAR_WORDS 3456
#define XB_SPIN_CAP (1u << 22)
__device__ __forceinline__ unsigned xb_ld(unsigned* p)              { return __hip_atomic_load(p, __ATOMIC_RELAXED, __HIP_MEMORY_SCOPE_AGENT); }
__device__ __forceinline__ unsigned xb_add(unsigned* p, unsigned v) { return __hip_atomic_fetch_add(p, v, __ATOMIC_RELAXED, __HIP_MEMORY_SCOPE_AGENT); }
__device__ __forceinline__ unsigned xb_xcc_id() { return (unsigned)__builtin_amdgcn_s_getreg((3 << 11) | 20) & 0xFu; }
#define XB_SPIN(cond, bar) do { unsigned _sp = 0; while (cond) { __builtin_amdgcn_s_sleep(1); \
    if ((++_sp & 255u) == 0u) { if (xb_ld(&(bar)[XB_TMO])) break; if (_sp > XB_SPIN_CAP) { atomicAdd(&(bar)[XB_TMO], 1u); break; } } } } while (0)
struct XcdBarrier { unsigned* bar; unsigned x; volatile LAS unsigned* st; };
__device__ __forceinline__ XcdBarrier xcd_barrier_post(unsigned* bar, volatile LAS unsigned* st) {
    XcdBarrier b; b.bar = bar; b.x = xb_xcc_id(); b.st = st;
    if (threadIdx.x == 0) (void)xb_add(&bar[XB_XCNT(b.x)], 1u);
    return b;
}
__device__ __forceinline__ void xcd_barrier_complete(unsigned* bar, unsigned x, unsigned& nloc, unsigned& nx) {
    const unsigned G = gridDim.x * gridDim.y * gridDim.z;
    unsigned sum, cnt, mine, sp = 0u;
    for (;;) {
        sum = 0u; cnt = 0u; mine = 0u;
#pragma unroll
        for (unsigned j = 0; j < 16; ++j) { const unsigned c = xb_ld(&bar[XB_XCNT(j)]); sum += c; cnt += (c > 0u) ? 1u : 0u; mine = (j == x) ? c : mine; }
        if (sum == G) break;
        __builtin_amdgcn_s_sleep(1);
        if ((++sp & 255u) == 0u) { if (xb_ld(&bar[XB_TMO])) break; if (sp > XB_SPIN_CAP) { atomicAdd(&bar[XB_TMO], 1u); break; } }
    }
    nloc = mine > 0u ? mine : 1u; nx = cnt > 0u ? cnt : 1u;
}
__device__ __forceinline__ void xcd_barrier(const XcdBarrier& b) {
    asm volatile("s_waitcnt vmcnt(0)" ::: "memory");
    __syncthreads();
    if (threadIdx.x == 0) {
        unsigned* bar = b.bar;
        __builtin_amdgcn_s_waitcnt(0);
        unsigned nloc = b.st[0], nx = b.st[1];
        if (nloc == 0u) { xcd_barrier_complete(bar, b.x, nloc, nx); b.st[0] = nloc; b.st[1] = nx; }
        const unsigned old = xb_add(&bar[XB_XSUB(b.x)], 1u);
        const unsigned gen = old / nloc;
        if (old + 1u == (gen + 1u) * nloc) {
            __builtin_amdgcn_fence(__ATOMIC_RELEASE, "agent");
            asm volatile("s_waitcnt vmcnt(0)" ::: "memory");
            const unsigned og = xb_add(&bar[XB_TOP], 1u);
            const unsigned tg = og / nx;
            if (og + 1u == (tg + 1u) * nx) xb_add(&bar[XB_TOPGEN], 1u);
            else XB_SPIN(xb_ld(&bar[XB_TOPGEN]) == tg, bar);
            __builtin_amdgcn_fence(__ATOMIC_ACQUIRE, "agent");
            xb_add(&bar[XB_XGEN(b.x)], 1u);
            asm volatile("s_waitcnt vmcnt(0)" ::: "memory");
        } else {
            XB_SPIN(xb_ld(&bar[XB_XGEN(b.x)]) == gen, bar);
            __builtin_amdgcn_fence(__ATOMIC_ACQUIRE, "agent");
            asm volatile("s_waitcnt vmcnt(0)" ::: "memory");
        }
    }
    __syncthreads();
}

struct Args { const void* in[19]; float* out; unsigned char* ws; int ph_lo, ph_hi, li, pad; };
struct Frame {
    LAS unsigned char* lds;
    int tid, lane, wave, G, bid;
    const float *x, *mem; const int* pos;
    const float *g_mix, *w_in, *ret_gn_g, *sb_q_g, *sb_k_g, *w_out, *g_xattn, *g_mem, *w_xq, *w_xkv, *xq_g, *xk_g, *w_xo, *g_mlp, *w_up, *w_down;
    float* out; unsigned char* ws;
};

__device__ __forceinline__ int inproj_src_col(int np) {
    const int pn = np >> 8, p = np & 255, seg = pn >> 1, half = pn & 1, bj = p >> 7, wc = (p >> 5) & 3, i = p & 31;
    if (seg <= 1) { const int h = 2 * half + bj, g = 4 * wc + (i >> 3), e = i & 7; return seg * 512 + h * 128 + (e < 4 ? 4 * g + e : 64 + 4 * g + e - 4); }
    if (seg == 4 || seg == 5) { const int head = 4 * half + wc; return seg * 512 + head * 64 + 32 * bj + i; }
    return np;
}
template <bool PERM_IN>
__device__ void conv_weight(const Frame& F, const float* W, const float* g, bf16* Wt, int K, int N) {
    LAS float* T = (LAS float*)F.lds;
    const int tk = K / 64, tn = N / 64, nt = tk * tn;
    for (int t = F.bid; t < nt; t += F.G) {
        const int k0 = (t / tn) * 64, n0 = (t % tn) * 64;
        __syncthreads();
#pragma unroll
        for (int i = 0; i < 2; ++i) {
            const int r = (F.tid >> 4) + 32 * i, c = (F.tid & 15) * 4;
            const int sc = PERM_IN ? inproj_src_col(n0 + c) : n0 + c;
            f32x4 v = *(const f32x4*)(W + (size_t)(k0 + r) * N + sc);
            const float gg = g ? g[k0 + r] : 1.f;
            T[r * 65 + c + 0] = v[0] * gg; T[r * 65 + c + 1] = v[1] * gg; T[r * 65 + c + 2] = v[2] * gg; T[r * 65 + c + 3] = v[3] * gg;
        }
        __syncthreads();
#pragma unroll
        for (int i = 0; i < 2; ++i) {
            const int n = (F.tid >> 4) + 32 * i, k = (F.tid & 15) * 4;
            u32x2 o; o[0] = pk2(T[(k + 0) * 65 + n], T[(k + 1) * 65 + n]); o[1] = pk2(T[(k + 2) * 65 + n], T[(k + 3) * 65 + n]);
            *(u32x2*)(Wt + (size_t)(n0 + n) * K + k0 + k) = o;
        }
    }
    __syncthreads();
}
__device__ void rows_prep(const Frame& F, const float* X, bf16* Xb, float* rinv, int rows) {
    const int gw = F.bid * NWAVES + F.wave, GW = F.G * NWAVES;
    for (int r = gw; r < rows; r += GW) {
        float ss = 0.f;
#pragma unroll
        for (int i = 0; i < 4; ++i) {
            const int c = i * 256 + F.lane * 4;
            f32x4 v = *(const f32x4*)(X + (size_t)r * DM + c);
            ss += v[0] * v[0] + v[1] * v[1] + v[2] * v[2] + v[3] * v[3];
            u32x2 o; o[0] = pk2(v[0], v[1]); o[1] = pk2(v[2], v[3]);
            *(u32x2*)(Xb + (size_t)r * DM + c) = o;
        }
        ss = wave_sum(ss);
        if (F.lane == 0) rinv[r] = rsqrtf(ss * (1.f / DM) + EPS);
    }
}
__device__ void rope_table(const Frame& F, float2* cs) {
    const int total = M * 64;
    for (int e = F.bid * NTHR + F.tid; e < total; e += F.G * NTHR) {
        const int row = e >> 6, j = e & 63;
        const double ang = (double)F.pos[row] * INVF[j];
        const double rev = ang * 0.15915494309189535;
        const float fr = (float)(rev - floor(rev));
        float2 o; o.x = __builtin_amdgcn_cosf(fr); o.y = __builtin_amdgcn_sinf(fr);
        cs[e] = o;
    }
}

namespace pg8 {
#define PG8_LAS __attribute__((address_space(3)))
typedef unsigned short bf16_t;
typedef short bf16x8 __attribute__((ext_vector_type(8)));
typedef float f32x4 __attribute__((ext_vector_type(4)));
typedef unsigned u32x4 __attribute__((ext_vector_type(4)));
constexpr int BM = 256, BK = 64, HALF = 128, HTB = HALF * BK * 2  , STAGE_BYTES = 8 * HTB, NXCD = 8, WGM = 8;

__host__ __device__ __forceinline__ int lds_byte(int r, int c) { const int st = (r >> 4) * 2 + (c >> 5), rr = r & 15, cc = c & 31, ob = rr * 64 + cc * 2; return st * 1024 + (ob ^ (((ob >> 9) & 1) << 5)); }
__host__ __device__ __forceinline__ void stage_rc(int b, int& R, int& C) { const int st = b / 1024, sb = b % 1024, swz = sb ^ (((sb >> 9) & 1) << 5); R = (st >> 1) * 16 + swz / 64; C = (st & 1) * 32 + (swz % 64) / 2; }
__host__ __device__ __forceinline__ int perm32(int rho) { const int n = rho >> 4, i = rho & 15; return 8 * (i >> 2) + 4 * n + (i & 3); }

struct Unit { int pm, pn; };
struct Gemm { const bf16_t* A; const bf16_t* Bt; int M, N, K; };

struct StaticOrder {
    int nM, nN, nwg, G, c;
    __host__ __device__ void init(int M, int N, int G_, int c_) { nM = M / BM; nN = N / BM; nwg = nM * nN; G = G_; c = c_; }
    __host__ __device__ bool next(int i, Unit& u) const {
        const long L = (long)i * G + c; if (L >= nwg) return false;
        int wgid = (int)L; { const int q = nwg / NXCD, r = nwg % NXCD, xcd = wgid % NXCD, off = wgid / NXCD; wgid = (xcd < r ? xcd * (q + 1) : r * (q + 1) + (xcd - r) * q) + off; }
        const int nig = WGM * nN, gid = wgid / nig, fm = gid * WGM, gsz = (nM - fm) < WGM ? (nM - fm) : WGM;
        u.pm = fm + ((wgid % nig) % gsz); u.pn = (wgid % nig) / gsz; return true;
    }
    __device__ __forceinline__ void a_ready(const Unit&) const {}
    __device__ __forceinline__ void done(const Unit&) const {}
};

__device__ __forceinline__ unsigned cvt_pk_bf16(float lo, float hi) { unsigned r; asm volatile("v_cvt_pk_bf16_f32 %0, %1, %2" : "=v"(r) : "v"(lo), "v"(hi)); return r; }
template <class Epi, class Sched, bool ALIGN_EPI = false, bool SP2 = false>
__device__ __forceinline__ void gemm_phase(PG8_LAS unsigned char* lds, const Gemm g, const Sched& S, const Epi& E) {
    const int tid = threadIdx.x, wid = __builtin_amdgcn_readfirstlane(tid >> 6), lane = tid & 63, wr = wid >> 2, wc = wid & 3, fr = lane & 15, fq = lane >> 4;
    const int K = g.K, nt = K / BK;
    unsigned voffA[2], voffB[2];
#pragma unroll
    for (int i = 0; i < 2; ++i) { int R, C; stage_rc(tid * 16 + i * 8192, R, C); const int Rb = Epi::PERM ? ((R & ~31) + perm32(R & 31)) : R;
        voffA[i] = (unsigned)(R * K + C) * 2u; voffB[i] = (unsigned)(Rb * K + C) * 2u; }
    const size_t kstep = (size_t)(BK * 2);
    const size_t hstep = (size_t)HALF * K * 2;
    const size_t tstep = 2 * hstep;
    const unsigned ldsw = (unsigned)wid * 1024u;
    const int aoff = lds_byte(wr * 64 + fr, fq * 8), boff = lds_byte(wc * 32 + fr, fq * 8);
#define PG8_SA(b, h) (((b) * 2 + (h)) * HTB)
#define PG8_SB(b, h) ((4 + (b) * 2 + (h)) * HTB)
#define PG8_STAGE(bufoff, gbase, voff) do { _Pragma("unroll") for (int _i = 0; _i < 2; ++_i) \
        __builtin_amdgcn_global_load_lds((const unsigned*)((const char*)(gbase) + (voff)[_i]), (PG8_LAS unsigned*)(lds + (bufoff) + ldsw + _i * 8192), 16, 0, 0); } while (0)
#define PG8_LDA(dst, b, h) do { _Pragma("unroll") for (int m = 0; m < 4; ++m) _Pragma("unroll") for (int k = 0; k < 2; ++k) dst[m][k] = *(const PG8_LAS bf16x8*)(lds + PG8_SA(b, h) + aoff + m * 2048 + k * 1024); } while (0)
#define PG8_LDB(dst, b, h) do { _Pragma("unroll") for (int n = 0; n < 2; ++n) _Pragma("unroll") for (int k = 0; k < 2; ++k) dst[n][k] = *(const PG8_LAS bf16x8*)(lds + PG8_SB(b, h) + boff + n * 2048 + k * 1024); } while (0)
#define PG8_MMA(ai, bj, At, Bt) do { __builtin_amdgcn_s_setprio(1); _Pragma("unroll") for (int m = 0; m < 4; ++m) _Pragma("unroll") for (int n = 0; n < 2; ++n) _Pragma("unroll") for (int k = 0; k < 2; ++k) \
        acc[ai][bj][m][n] = __builtin_amdgcn_mfma_f32_16x16x32_bf16(Bt[n][k], At[m][k], acc[ai][bj][m][n], 0, 0, 0); __builtin_amdgcn_s_setprio(0); } while (0)
#define PG8_WAIT_V(n) asm volatile("s_waitcnt vmcnt(" #n ")" ::: "memory")
#define PG8_WAIT_L(n) asm volatile("s_waitcnt lgkmcnt(" #n ")" ::: "memory")
#define PG8_BAR __builtin_amdgcn_s_barrier()
#define PG8_SCHED __builtin_amdgcn_sched_barrier(0)
    Unit cur, nxt; int ui = 0;
    if (!S.next(0, cur)) return;
    f32x4 acc[2][2][4][2];
#pragma unroll
    for (int a = 0; a < 2; ++a)
#pragma unroll
        for (int b = 0; b < 2; ++b)
#pragma unroll
            for (int m = 0; m < 4; ++m)
#pragma unroll
                for (int n = 0; n < 2; ++n) acc[a][b][m][n] = (f32x4){0.f, 0.f, 0.f, 0.f};
    bf16x8 At[4][2], B0[2][2], B1[2][2];
    const char* cA = (const char*)g.A + (size_t)cur.pm * tstep; const char* cB = (const char*)g.Bt + (size_t)cur.pn * tstep;
    S.a_ready(cur);
    if constexpr (SP2) {
        PG8_STAGE(PG8_SB(0, 0), cB, voffB); PG8_STAGE(PG8_SB(0, 1), cB + hstep, voffB); PG8_STAGE(PG8_SA(0, 0), cA, voffA); PG8_STAGE(PG8_SA(0, 1), cA + hstep, voffA);
        if (wr == 1) PG8_BAR;
        PG8_WAIT_V(2); PG8_BAR;
        PG8_STAGE(PG8_SB(1, 0), cB + kstep, voffB); PG8_STAGE(PG8_SA(1, 0), cA + kstep, voffA); PG8_STAGE(PG8_SB(1, 1), cB + hstep + kstep, voffB);
        PG8_WAIT_V(6); PG8_BAR;
    } else {
        PG8_STAGE(PG8_SB(0, 0), cB, voffB); PG8_STAGE(PG8_SA(0, 0), cA, voffA); PG8_STAGE(PG8_SB(0, 1), cB + hstep, voffB); PG8_STAGE(PG8_SA(0, 1), cA + hstep, voffA);
        if (wr == 1) PG8_BAR;
        PG8_WAIT_V(4); PG8_BAR;
        PG8_STAGE(PG8_SB(1, 0), cB + kstep, voffB); PG8_STAGE(PG8_SA(1, 0), cA + kstep, voffA); PG8_STAGE(PG8_SB(1, 1), cB + hstep + kstep, voffB);
        PG8_WAIT_V(6); PG8_BAR;
    }
    for (;;) {
        const bool has_next = S.next(ui + 1, nxt);
        const char* nA = has_next ? (const char*)g.A + (size_t)nxt.pm * tstep : cA; const char* nB = has_next ? (const char*)g.Bt + (size_t)nxt.pn * tstep : cB;
        for (int t = 0; t < nt; t += 2) {
            const bool last = (t == nt - 2);
            const char* a1 = cA + (size_t)(t + 1) * kstep;
            const char* a2 = last ? nA : cA + (size_t)(t + 2) * kstep; const char* b2 = last ? nB : cB + (size_t)(t + 2) * kstep;
            const char* a3 = a2 + kstep; const char* b3 = b2 + kstep;
            if (last && has_next) S.a_ready(nxt);
            if constexpr (SP2) {
            PG8_LDB(B0, 0, 0); PG8_LDB(B1, 0, 1); PG8_SCHED; PG8_LDA(At, 0, 0); PG8_STAGE(PG8_SA(1, 1), a1 + hstep, voffA);
            PG8_WAIT_V(8); PG8_WAIT_L(0); PG8_BAR; PG8_MMA(0, 0, At, B0); PG8_MMA(0, 1, At, B1); PG8_BAR; PG8_SCHED;
            PG8_LDA(At, 0, 1); PG8_STAGE(PG8_SB(0, 0), b2, voffB); PG8_STAGE(PG8_SB(0, 1), b2 + hstep, voffB); PG8_STAGE(PG8_SA(0, 0), a2, voffA);
            PG8_WAIT_V(8); PG8_WAIT_L(0); PG8_BAR; PG8_MMA(1, 0, At, B0); PG8_MMA(1, 1, At, B1); PG8_BAR; PG8_SCHED;
            PG8_LDB(B0, 1, 0); PG8_LDB(B1, 1, 1); PG8_SCHED; PG8_LDA(At, 1, 0); PG8_STAGE(PG8_SA(0, 1), a2 + hstep, voffA);
            PG8_WAIT_V(8); PG8_WAIT_L(0); PG8_BAR; PG8_MMA(0, 0, At, B0); PG8_MMA(0, 1, At, B1); PG8_BAR; PG8_SCHED;
            PG8_LDA(At, 1, 1); PG8_STAGE(PG8_SB(1, 0), b3, voffB); PG8_STAGE(PG8_SB(1, 1), b3 + hstep, voffB); PG8_STAGE(PG8_SA(1, 0), a3, voffA);
            PG8_WAIT_V(8); PG8_WAIT_L(0); PG8_BAR; PG8_MMA(1, 0, At, B0); PG8_MMA(1, 1, At, B1); PG8_BAR; PG8_SCHED;
            } else {
            PG8_LDB(B0, 0, 0); PG8_SCHED; PG8_LDA(At, 0, 0); PG8_STAGE(PG8_SA(1, 1), a1 + hstep, voffA);
            PG8_WAIT_L(8); PG8_BAR; PG8_WAIT_L(0); PG8_MMA(0, 0, At, B0); PG8_BAR; PG8_SCHED;
            PG8_LDB(B1, 0, 1); PG8_STAGE(PG8_SB(0, 0), b2, voffB);
            PG8_BAR; PG8_WAIT_L(0); PG8_MMA(0, 1, At, B1); PG8_BAR;
            PG8_LDA(At, 0, 1); PG8_STAGE(PG8_SA(0, 0), a2, voffA);
            PG8_BAR; PG8_WAIT_L(0); PG8_MMA(1, 0, At, B0); PG8_BAR; PG8_SCHED;
            PG8_STAGE(PG8_SB(0, 1), b2 + hstep, voffB);
            PG8_WAIT_V(6); PG8_BAR; PG8_MMA(1, 1, At, B1); PG8_BAR;
            PG8_LDB(B0, 1, 0); PG8_SCHED; PG8_LDA(At, 1, 0); PG8_STAGE(PG8_SA(0, 1), a2 + hstep, voffA);
            PG8_WAIT_L(8); PG8_BAR; PG8_WAIT_L(0); PG8_MMA(0, 0, At, B0); PG8_BAR; PG8_SCHED;
            PG8_LDB(B1, 1, 1); PG8_STAGE(PG8_SB(1, 0), b3, voffB);
            PG8_BAR; PG8_WAIT_L(0); PG8_MMA(0, 1, At, B1); PG8_BAR;
            PG8_LDA(At, 1, 1); PG8_STAGE(PG8_SA(1, 0), a3, voffA);
            PG8_BAR; PG8_WAIT_L(0); PG8_MMA(1, 0, At, B0); PG8_BAR; PG8_SCHED;
            PG8_STAGE(PG8_SB(1, 1), b3 + hstep, voffB);
            PG8_WAIT_V(6); PG8_BAR; PG8_MMA(1, 1, At, B1); PG8_BAR;
            }
        }
        if constexpr (ALIGN_EPI) { if (wr == 0) PG8_BAR; }
        if constexpr (!Epi::AFTER_DRAIN) { E(acc, cur, wr, wc, fr, fq); S.done(cur); }
        if (!has_next) break;
#pragma unroll
        for (int a = 0; a < 2; ++a)
#pragma unroll
            for (int b = 0; b < 2; ++b)
#pragma unroll
                for (int m = 0; m < 4; ++m)
#pragma unroll
                    for (int n = 0; n < 2; ++n) acc[a][b][m][n] = (f32x4){0.f, 0.f, 0.f, 0.f};
        cur = nxt; cA = nA; cB = nB; ++ui;
        if constexpr (ALIGN_EPI) { if (wr == 1) PG8_BAR; }
    }
    PG8_WAIT_V(0);
    if constexpr (!ALIGN_EPI) { if (wr == 0) PG8_BAR; }
    PG8_BAR;
    if constexpr (Epi::AFTER_DRAIN) { E.fused(acc, cur, wr, wc, fr, fq, lds, wid, lane); S.done(cur); }
#undef PG8_SA
#undef PG8_SB
#undef PG8_STAGE
#undef PG8_LDA
#undef PG8_LDB
#undef PG8_MMA
#undef PG8_WAIT_V
#undef PG8_WAIT_L
#undef PG8_BAR
#undef PG8_SCHED
}
}

__device__ __forceinline__ float sum16(const float* p) { const f32x4 a = *(const f32x4*)p, b = *(const f32x4*)(p + 4), c = *(const f32x4*)(p + 8), d = *(const f32x4*)(p + 12); const f32x4 t = (a + b) + (c + d); return (t[0] + t[1]) + (t[2] + t[3]); }
__device__ __forceinline__ u32x4 pack8u(const f32x4& a, const f32x4& b) { u32x4 w; w[0] = pg8::cvt_pk_bf16(a[0], a[1]); w[1] = pg8::cvt_pk_bf16(a[2], a[3]); w[2] = pg8::cvt_pk_bf16(b[0], b[1]); w[3] = pg8::cvt_pk_bf16(b[2], b[3]); return w; }
__device__ __forceinline__ void store_T8(bf16* T, size_t chan0, int sq, const u32x4& w) {
    bf16* t = T + chan0 * SEQ + sq;
#pragma unroll
    for (int e = 0; e < 4; ++e) { t[(size_t)(2 * e) * SEQ] = (bf16)(w[e] & 0xffffu); t[(size_t)(2 * e + 1) * SEQ] = (bf16)(w[e] >> 16); }
}
struct EpiInProj {
    static constexpr bool PERM = true, AFTER_DRAIN = false;
    bf16* proj; const float* rinv1; const float2* cs; const float* sb_q_g; const float* sb_k_g; bf16* T;
    __device__ __forceinline__ void operator()(const f32x4 (&acc)[2][2][4][2], const pg8::Unit& u, int wr, int wc, int fr, int fq) const {
        const int pn = u.pn, seg = pn >> 1, half = pn & 1;
#pragma unroll
        for (int ai = 0; ai < 2; ++ai)
#pragma unroll
            for (int m = 0; m < 4; ++m) {
                const int gr = u.pm * 256 + ai * 128 + wr * 64 + m * 16 + fr, b = gr >> 12, sq = gr & (SEQ - 1);
                const float s = rinv1[gr];
                f32x4 a[2][2];
#pragma unroll
                for (int bj = 0; bj < 2; ++bj) { a[bj][0] = acc[ai][bj][m][0] * s; a[bj][1] = acc[ai][bj][m][1] * s; }
                if (seg <= 1) {
                    const int g = 4 * wc + fq;
                    const f32x4* c4 = (const f32x4*)(cs + (size_t)gr * 64 + 4 * g);
                    const f32x4 c01 = c4[0], c23 = c4[1];
                    const f32x4 cosv = (f32x4){c01[0], c01[2], c23[0], c23[2]}, sinv = (f32x4){c01[1], c01[3], c23[1], c23[3]};
                    const float eidx = (float)((gr & 127) + 1);
#pragma unroll
                    for (int bj = 0; bj < 2; ++bj) {
                        const int h = 2 * half + bj;
                        const float e = eidx * lg2gamma(h);
                        const float sc = (seg == 0) ? __builtin_amdgcn_exp2f(e) : 0.08838834764831845f * __builtin_amdgcn_exp2f(-e);
                        const f32x4 x = a[bj][0], y = a[bj][1];
                        const f32x4 o1 = (x * cosv - y * sinv) * sc, o2 = (y * cosv + x * sinv) * sc;
                        const u32x4 w = pack8u(o1, o2);
                        *(u32x4*)(proj + (size_t)gr * NPROJ + (seg == 0 ? P_RQ : P_RK) + h * 128 + 8 * g) = w;
                        if (seg == 1) store_T8(T, (size_t)b * NT + TC_RK + h * 128 + 8 * g, sq, w);
                    }
                } else if (seg == 4 || seg == 5) {
                    float ss = 0.f;
#pragma unroll
                    for (int bj = 0; bj < 2; ++bj)
#pragma unroll
                        for (int n = 0; n < 2; ++n) { const f32x4 t = a[bj][n] * a[bj][n]; ss += (t[0] + t[1]) + (t[2] + t[3]); }
                    ss += __shfl_xor(ss, 16); ss += __shfl_xor(ss, 32);
                    const float inv = rsqrtf(ss * (1.f / 64.f) + EPS);
                    const int head = 4 * half + wc;
                    const float* gp = (seg == 4 ? sb_q_g : sb_k_g) + head * 64 + 8 * fq;
#pragma unroll
                    for (int bj = 0; bj < 2; ++bj) {
                        const f32x4 g0 = *(const f32x4*)(gp + 32 * bj), g1 = *(const f32x4*)(gp + 32 * bj + 4);
                        const u32x4 w = pack8u(a[bj][0] * g0 * inv, a[bj][1] * g1 * inv);
                        *(u32x4*)(proj + (size_t)gr * NPROJ + (seg == 4 ? P_SQ : P_SK) + head * 64 + 32 * bj + 8 * fq) = w;
                    }
                } else if (seg == 3) {
#pragma unroll
                    for (int bj = 0; bj < 2; ++bj) *(u32x4*)(proj + (size_t)gr * NPROJ + P_RG + half * 256 + 128 * bj + 32 * wc + 8 * fq) = pack8u(a[bj][0], a[bj][1]);
                } else {
                    const int chb = (seg == 2 ? TC_RV : TC_SV) + half * 256 + 32 * wc + 8 * fq;
#pragma unroll
                    for (int bj = 0; bj < 2; ++bj) store_T8(T, (size_t)b * NT + chb + 128 * bj, sq, pack8u(a[bj][0], a[bj][1]));
                }
            }
    }
};
template <bool RES_BF16>
struct EpiResid {
    static constexpr bool PERM = true, AFTER_DRAIN = false;
    const void* resid; bf16* xb; float* ssq;
    __device__ __forceinline__ void operator()(const f32x4 (&acc)[2][2][4][2], const pg8::Unit& u, int wr, int wc, int fr, int fq) const {
#pragma unroll
        for (int ai = 0; ai < 2; ++ai)
#pragma unroll
            for (int m = 0; m < 4; ++m) {
                const int gr = u.pm * 256 + ai * 128 + wr * 64 + m * 16 + fr;
                float ss = 0.f;
#pragma unroll
                for (int bj = 0; bj < 2; ++bj) {
                    const size_t o = (size_t)gr * DM + u.pn * 256 + 128 * bj + 32 * wc + 8 * fq;
                    f32x4 r0, r1;
                    if (RES_BF16) { const u32x4 rw = *(const u32x4*)((const bf16*)resid + o); r0 = (f32x4){bflo(rw[0]), bfhi(rw[0]), bflo(rw[1]), bfhi(rw[1])}; r1 = (f32x4){bflo(rw[2]), bfhi(rw[2]), bflo(rw[3]), bfhi(rw[3])}; }
                    else { r0 = *(const f32x4*)((const float*)resid + o); r1 = *(const f32x4*)((const float*)resid + o + 4); }
                    const f32x4 v0 = acc[ai][bj][m][0] + r0, v1 = acc[ai][bj][m][1] + r1;
                    *(u32x4*)(xb + o) = pack8u(v0, v1);
                    const f32x4 t = v0 * v0 + v1 * v1; ss += (t[0] + t[1]) + (t[2] + t[3]);
                }
                ss += __shfl_xor(ss, 16); ss += __shfl_xor(ss, 32);
                if (fq == 0) ssq[(size_t)gr * 16 + u.pn * 4 + wc] = ss;
            }
    }
};
struct EpiXQ {
    static constexpr bool PERM = true, AFTER_DRAIN = false;
    bf16* xq; const float* ssq2; float* ssqq;
    __device__ __forceinline__ void operator()(const f32x4 (&acc)[2][2][4][2], const pg8::Unit& u, int wr, int wc, int fr, int fq) const {
#pragma unroll
        for (int ai = 0; ai < 2; ++ai)
#pragma unroll
            for (int m = 0; m < 4; ++m) {
                const int gr = u.pm * 256 + ai * 128 + wr * 64 + m * 16 + fr;
                const float rinv = rsqrtf(sum16(ssq2 + (size_t)gr * 16) * (1.f / DM) + EPS);
                float ss = 0.f;
#pragma unroll
                for (int bj = 0; bj < 2; ++bj) {
                    const f32x4 v0 = acc[ai][bj][m][0] * rinv, v1 = acc[ai][bj][m][1] * rinv;
                    *(u32x4*)(xq + (size_t)gr * DM + u.pn * 256 + 128 * bj + 32 * wc + 8 * fq) = pack8u(v0, v1);
                    const f32x4 t = v0 * v0 + v1 * v1; ss += (t[0] + t[1]) + (t[2] + t[3]);
                }
                ss += __shfl_xor(ss, 16); ss += __shfl_xor(ss, 32);
                if (fq == 0) ssqq[(size_t)gr * 16 + u.pn * 4 + wc] = ss;
            }
    }
};
struct EpiUp {
    static constexpr bool PERM = true, AFTER_DRAIN = false;
    bf16* hid; const float* ssq3;
    __device__ __forceinline__ void operator()(const f32x4 (&acc)[2][2][4][2], const pg8::Unit& u, int wr, int wc, int fr, int fq) const {
#pragma unroll
        for (int ai = 0; ai < 2; ++ai)
#pragma unroll
            for (int m = 0; m < 4; ++m) {
                const int gr = u.pm * 256 + ai * 128 + wr * 64 + m * 16 + fr;
                const float rinv = rsqrtf(sum16(ssq3 + (size_t)gr * 16) * (1.f / DM) + EPS);
#pragma unroll
                for (int bj = 0; bj < 2; ++bj) {
                    f32x4 v0 = acc[ai][bj][m][0] * rinv, v1 = acc[ai][bj][m][1] * rinv;
#pragma unroll
                    for (int e = 0; e < 4; ++e) { const float t0 = fmaxf(v0[e], 0.f), t1 = fmaxf(v1[e], 0.f); v0[e] = t0 * t0; v1[e] = t1 * t1; }
                    *(u32x4*)(hid + (size_t)gr * FF + u.pn * 256 + 128 * bj + 32 * wc + 8 * fq) = pack8u(v0, v1);
                }
            }
    }
};
struct EpiDown {
    static constexpr bool PERM = true, AFTER_DRAIN = false;
    const bf16* resid; float* out;
    __device__ __forceinline__ void operator()(const f32x4 (&acc)[2][2][4][2], const pg8::Unit& u, int wr, int wc, int fr, int fq) const {
#pragma unroll
        for (int ai = 0; ai < 2; ++ai)
#pragma unroll
            for (int m = 0; m < 4; ++m) {
                const int gr = u.pm * 256 + ai * 128 + wr * 64 + m * 16 + fr;
#pragma unroll
                for (int bj = 0; bj < 2; ++bj) {
                    const size_t o = (size_t)gr * DM + u.pn * 256 + 128 * bj + 32 * wc + 8 * fq;
                    const u32x4 rw = *(const u32x4*)(resid + o);
                    const f32x4 r0 = (f32x4){bflo(rw[0]), bfhi(rw[0]), bflo(rw[1]), bfhi(rw[1])}, r1 = (f32x4){bflo(rw[2]), bfhi(rw[2]), bflo(rw[3]), bfhi(rw[3])};
                    *(f32x4*)(out + o) = acc[ai][bj][m][0] + r0; *(f32x4*)(out + o + 4) = acc[ai][bj][m][1] + r1;
                }
            }
    }
};
template <class Epi>
__device__ __forceinline__ void gemm_big(const Frame& F, const bf16* A, const bf16* Bt, int N, int K, const Epi& E) {
    pg8::Gemm g{A, Bt, M, N, K}; pg8::StaticOrder S; S.init(M, N, F.G, F.bid);
    pg8::gemm_phase<Epi, pg8::StaticOrder, true, true>(F.lds, g, S, E);
}

constexpr int LDA_S = 72, LDC_S = 260;
template <class Epi>
__device__ void gemm_phase_v1(const Frame& F, const bf16* A, const bf16* Bt, int Mr, int N, int K, const Epi& E) {
    const int tid = F.tid, lane = F.lane, wave = F.wave;
    const int wr = wave >> 2, wc = wave & 3;
    const int nN = N / 256, nU = (Mr / 128) * nN, nk = K / 64;
    LAS bf16* As = (LAS bf16*)F.lds;
    LAS bf16* Bs = (LAS bf16*)(F.lds + 128 * LDA_S * 2);
    LAS float* Cs = (LAS float*)F.lds;
    const int lr = tid >> 3, lc = (tid & 7) * 8;
    for (int u = F.bid; u < nU; u += F.G) {
        const int pm = u / nN, pn = u % nN;
        const bf16* Ag = A + (size_t)(pm * 128 + lr) * K + lc;
        const bf16* Bg = Bt + (size_t)(pn * 256 + lr) * K + lc;
        f32x4 acc[4][4];
#pragma unroll
        for (int i = 0; i < 4; ++i)
#pragma unroll
            for (int j = 0; j < 4; ++j) acc[i][j] = (f32x4){0.f, 0.f, 0.f, 0.f};
        u32x4 ra[2], rb[4];
#pragma unroll
        for (int i = 0; i < 2; ++i) ra[i] = *(const u32x4*)(Ag + (size_t)(64 * i) * K);
#pragma unroll
        for (int i = 0; i < 4; ++i) rb[i] = *(const u32x4*)(Bg + (size_t)(64 * i) * K);
        for (int kt = 0; kt < nk; ++kt) {
            __syncthreads();
#pragma unroll
            for (int i = 0; i < 2; ++i) *(LAS u32x4*)(As + (lr + 64 * i) * LDA_S + lc) = ra[i];
#pragma unroll
            for (int i = 0; i < 4; ++i) *(LAS u32x4*)(Bs + (lr + 64 * i) * LDA_S + lc) = rb[i];
            __syncthreads();
            if (kt + 1 < nk) {
#pragma unroll
                for (int i = 0; i < 2; ++i) ra[i] = *(const u32x4*)(Ag + (size_t)(64 * i) * K + (kt + 1) * 64);
#pragma unroll
                for (int i = 0; i < 4; ++i) rb[i] = *(const u32x4*)(Bg + (size_t)(64 * i) * K + (kt + 1) * 64);
            }
#pragma unroll
            for (int kk = 0; kk < 2; ++kk) {
                bf16x8 a[4], b[4];
#pragma unroll
                for (int i = 0; i < 4; ++i) a[i] = *(LAS bf16x8*)(As + (wr * 64 + i * 16 + (lane & 15)) * LDA_S + kk * 32 + (lane >> 4) * 8);
#pragma unroll
                for (int j = 0; j < 4; ++j) b[j] = *(LAS bf16x8*)(Bs + (wc * 64 + j * 16 + (lane & 15)) * LDA_S + kk * 32 + (lane >> 4) * 8);
#pragma unroll
                for (int i = 0; i < 4; ++i)
#pragma unroll
                    for (int j = 0; j < 4; ++j) acc[i][j] = __builtin_amdgcn_mfma_f32_16x16x32_bf16(a[i], b[j], acc[i][j], 0, 0, 0);
            }
        }
        __syncthreads();
#pragma unroll
        for (int i = 0; i < 4; ++i)
#pragma unroll
            for (int j = 0; j < 4; ++j)
#pragma unroll
                for (int r = 0; r < 4; ++r) Cs[(wr * 64 + i * 16 + (lane >> 4) * 4 + r) * LDC_S + wc * 64 + j * 16 + (lane & 15)] = acc[i][j][r];
        __syncthreads();
        const bool tr = E.transposed(pn);
        for (int rr = 0; rr < 16; ++rr) {
            const int row = wave * 16 + rr;
            f32x4 v = *(LAS f32x4*)(Cs + row * LDC_S + lane * 4);
            v = E(v, pm * 128 + row, pn, lane);
            if (tr) *(LAS f32x4*)(Cs + row * LDC_S + lane * 4) = v;
        }
        if (tr) { __syncthreads(); E.store_T(Cs, pm, pn, tid); }
    }
    __syncthreads();
}

struct EpiMemKV {
    bf16* memk; bf16* memvT; const float* rinvm; const float* xk_g;
    __device__ __forceinline__ bool transposed(int pn) const { return pn >= 4; }
    __device__ __forceinline__ void store_T(LAS float* Cs, int pm, int pn, int tid) const {
#pragma unroll
        for (int it = 0; it < 8; ++it) {
            const int item = it * NTHR + tid, rg = item & 15, col = item >> 4;
            float f[8];
#pragma unroll
            for (int i = 0; i < 8; ++i) f[i] = Cs[(rg * 8 + i) * LDC_S + col];
            u32x4 o; o[0] = pk2(f[0], f[1]); o[1] = pk2(f[2], f[3]); o[2] = pk2(f[4], f[5]); o[3] = pk2(f[6], f[7]);
            const int row0 = pm * 128 + rg * 8, b = row0 / MEML, key = row0 % MEML;
            *(u32x4*)(memvT + ((size_t)(b * 4 + pn - 4) * 256 + col) * MEML + key) = o;
        }
    }
    __device__ __forceinline__ f32x4 operator()(f32x4 v, int gr, int pn, int lane) const {
        v = v * rinvm[gr];
        if (pn < 4) {
            float ss = wave_sum(v[0] * v[0] + v[1] * v[1] + v[2] * v[2] + v[3] * v[3]);
            const float inv = rsqrtf(ss * (1.f / 256.f) + EPS);
            const float* g = xk_g + pn * 256 + 4 * lane;
            v[0] *= inv * g[0]; v[1] *= inv * g[1]; v[2] *= inv * g[2]; v[3] *= inv * g[3];
            u32x2 o; o[0] = pk2(v[0], v[1]); o[1] = pk2(v[2], v[3]);
            *(u32x2*)(memk + (size_t)gr * DM + pn * 256 + 4 * lane) = o;
        }
        return v;
    }
};

typedef float f32x16 __attribute__((ext_vector_type(16)));
#define MFMA32(a, b, c) __builtin_amdgcn_mfma_f32_32x32x16_bf16((a), (b), (c), 0, 0, 0)
__device__ __forceinline__ bf16x8 pack8(float a0, float a1, float a2, float a3, float a4, float a5, float a6, float a7) {
    u32x4 p; p[0] = pk2(a0, a1); p[1] = pk2(a2, a3); p[2] = pk2(a4, a5); p[3] = pk2(a6, a7);
    return __builtin_bit_cast(bf16x8, p);
}
__device__ void sb_mfma(const Frame& F, const bf16* proj, const bf16* T, bf16* mix) {
    const int lane = F.lane, r = lane & 31, hh = lane >> 5;
    const int kr = (r & ~12) | ((r & 4) << 1) | ((r & 8) >> 1);
    const int gw = F.bid * NWAVES + F.wave, GW = F.G * NWAVES;
    const float c1 = 0.18033688011112042f;
    LAS bf16* os = (LAS bf16*)(F.lds + F.wave * 4608);
    for (int u = gw; u < BATCH * 8 * 128; u += GW) {
        const int qb = 127 - (u & 127), hd = (u >> 7) & 7, b = u >> 10;
        const int q0 = qb * 32;
        const float gq = wave_max(fabsf(F.sb_q_g[hd * 64 + lane])), gk = wave_max(fabsf(F.sb_k_g[hd * 64 + lane]));
        const float thresh = 152.f + c1 * 64.f * gq * gk * 1.02f;
        const bf16* kbase = proj + ((size_t)b * SEQ + kr) * NPROJ + P_SK + hd * 64 + 8 * hh;
        const bf16* vbase = T + ((size_t)b * NT + TC_SV + hd * 64 + r) * SEQ + 8 * hh;
        bf16x8 qf[4], kn[4], vn[4];
        {
            const bf16* qp = proj + ((size_t)b * SEQ + q0 + r) * NPROJ + P_SQ + hd * 64 + 8 * hh;
#pragma unroll
            for (int s = 0; s < 4; ++s) qf[s] = *(const bf16x8*)(qp + 16 * s);
#pragma unroll
            for (int s = 0; s < 4; ++s) kn[s] = *(const bf16x8*)(kbase + (size_t)q0 * NPROJ + 16 * s);
#pragma unroll
            for (int n = 0; n < 2; ++n)
#pragma unroll
                for (int ks = 0; ks < 2; ++ks) vn[2 * n + ks] = *(const bf16x8*)(vbase + (size_t)(32 * n) * SEQ + q0 + 16 * ks);
        }
        f32x16 o0, o1;
#pragma unroll
        for (int i = 0; i < 16; ++i) { o0[i] = 0.f; o1[i] = 0.f; }
        float carry = 0.f;
        for (int k0 = q0; k0 >= 0; k0 -= 32) {
            bf16x8 kf[4], vf[4];
#pragma unroll
            for (int s = 0; s < 4; ++s) { kf[s] = kn[s]; vf[s] = vn[s]; }
            if (k0 >= 32) {
#pragma unroll
                for (int s = 0; s < 4; ++s) kn[s] = *(const bf16x8*)(kbase + (size_t)(k0 - 32) * NPROJ + 16 * s);
#pragma unroll
                for (int n = 0; n < 2; ++n)
#pragma unroll
                    for (int ks = 0; ks < 2; ++ks) vn[2 * n + ks] = *(const bf16x8*)(vbase + (size_t)(32 * n) * SEQ + (k0 - 32) + 16 * ks);
            }
            f32x16 x;
#pragma unroll
            for (int i = 0; i < 16; ++i) x[i] = 0.f;
#pragma unroll
            for (int s = 0; s < 4; ++s) x = MFMA32(kf[s], qf[s], x);
            const bool diag = (k0 == q0);
            f32x16 tt, ll;
#pragma unroll
            for (int i = 0; i < 16; ++i) {
                const int key = 16 * (i >> 3) + 8 * hh + (i & 7);
                const bool valid = !diag || (key < r);
                const float t = x[i] * c1;
                const float l = __builtin_amdgcn_logf(1.f + __builtin_amdgcn_exp2f(t));
                tt[i] = valid ? t : -1e30f; ll[i] = valid ? l : 0.f;
            }
#pragma unroll
            for (int g = 0; g < 2; ++g)
#pragma unroll
                for (int e = 6; e >= 0; --e) ll[8 * g + e] += ll[8 * g + e + 1];
            const float tlo = ll[0], thi = ll[8], plo = __shfl_xor(tlo, 32), phi = __shfl_xor(thi, 32);
            const float blo = carry + (hh == 0 ? (plo + thi + phi) : (phi + thi)), bhi = carry + (hh == 0 ? phi : 0.f);
            carry += (tlo + thi) + (plo + phi);
#pragma unroll
            for (int i = 0; i < 16; ++i) x[i] = __builtin_amdgcn_exp2f(tt[i] - ((i < 8 ? blo : bhi) + ll[i]));
#pragma unroll
            for (int ks = 0; ks < 2; ++ks) {
                const bf16x8 pf = pack8(x[8 * ks], x[8 * ks + 1], x[8 * ks + 2], x[8 * ks + 3], x[8 * ks + 4], x[8 * ks + 5], x[8 * ks + 6], x[8 * ks + 7]);
                o0 = MFMA32(pf, vf[ks], o0);
                o1 = MFMA32(pf, vf[2 + ks], o1);
            }
            if (__all(carry > thresh)) break;
        }
        CBAR();
#pragma unroll
        for (int i = 0; i < 16; ++i) {
            const int qr = (i & 3) + 8 * (i >> 2) + 4 * hh;
            os[qr * 72 + r] = (bf16)f2bf(o0[i]);
            os[qr * 72 + 32 + r] = (bf16)f2bf(o1[i]);
        }
        CBAR();
#pragma unroll
        for (int i = 0; i < 4; ++i) {
            const int id = i * 64 + lane, row = id >> 3, ch = id & 7;
            *(u32x4*)(mix + ((size_t)b * SEQ + q0 + row) * DM + 512 + hd * 64 + ch * 8) = *(LAS u32x4*)(os + row * 72 + ch * 8);
        }
        CBAR();
    }
}

__device__ void ret_kv(const Frame& F, const bf16* T, float* KVs) {
    const int lane = F.lane, r = lane & 31, hh = lane >> 5, mt = F.wave >> 1, nt0 = (F.wave & 1) * 2;
    for (int u = F.bid; u < BATCH * 4 * 32; u += F.G) {
        const int c = u & 31, h = (u >> 5) & 3, b = u >> 7, s0 = c * 128;
        const bf16* vp = T + ((size_t)b * NT + TC_RV + h * 128 + 32 * mt + r) * SEQ + s0 + 8 * hh;
        const bf16* kp0 = T + ((size_t)b * NT + TC_RK + h * 128 + 32 * nt0 + r) * SEQ + s0 + 8 * hh;
        const bf16* kp1 = kp0 + (size_t)32 * SEQ;
        f32x16 a0, a1;
#pragma unroll
        for (int i = 0; i < 16; ++i) { a0[i] = 0.f; a1[i] = 0.f; }
#pragma unroll
        for (int ks = 0; ks < 8; ++ks) {
            const bf16x8 vf = *(const bf16x8*)(vp + 16 * ks), k0f = *(const bf16x8*)(kp0 + 16 * ks), k1f = *(const bf16x8*)(kp1 + 16 * ks);
            a0 = MFMA32(vf, k0f, a0); a1 = MFMA32(vf, k1f, a1);
        }
        const float g128 = __builtin_amdgcn_exp2f(128.f * lg2gamma(h));
        float* op = KVs + (size_t)u * 16384 + (size_t)(32 * mt + 4 * hh) * 128 + 32 * nt0 + r;
#pragma unroll
        for (int i = 0; i < 16; ++i) { const int row = (i & 3) + 8 * (i >> 2); op[row * 128] = a0[i] * g128; op[row * 128 + 32] = a1[i] * g128; }
    }
}
__device__ void ret_scan(const Frame& F, float* KVs, int wb, int nwb) {
    for (int it = (F.bid - wb) * NTHR + F.tid; it < 16 * 4096; it += nwb * NTHR) {
        const int bh = it >> 12, e4 = (it & 4095) * 4;
        const float g128 = __builtin_amdgcn_exp2f(128.f * lg2gamma(bh & 3));
        float* p = KVs + (size_t)bh * 32 * 16384 + e4;
        f32x4 st = (f32x4){0.f, 0.f, 0.f, 0.f};
#pragma unroll 1
        for (int cb = 0; cb < 4; ++cb) {
            f32x4 t[8];
#pragma unroll
            for (int c = 0; c < 8; ++c) t[c] = *(const f32x4*)(p + (size_t)(cb * 8 + c) * 16384);
#pragma unroll
            for (int c = 0; c < 8; ++c) { *(f32x4*)(p + (size_t)(cb * 8 + c) * 16384) = st; st = st * g128 + t[c]; }
        }
    }
}
constexpr int RO_ROW = 272, RO_ST = 0, RO_KT = 128 * RO_ROW, RO_VT = 2 * 128 * RO_ROW, RO_OS = 3 * 128 * RO_ROW, RO_OSW = 32 * 144, RO_SS = RO_OS + 8 * RO_OSW;
__device__ void ret_out(const Frame& F, const bf16* proj, const bf16* T, const float* KVs, bf16* mix) {
    const int tid = F.tid, lane = F.lane, r = lane & 31, hh = lane >> 5, qg = F.wave >> 1, dh = F.wave & 1;
    const int kr = (r & ~12) | ((r & 4) << 1) | ((r & 8) >> 1);
    LAS unsigned char* L = F.lds;
    LAS float* ssx = (LAS float*)(L + RO_SS);
    for (int u = F.bid; u < BATCH * 4 * 32; u += F.G) {
        const int c = u & 31, h = (u >> 5) & 3, b = u >> 7, q0 = c * 128 + 32 * qg;
        f32x4 sst[8]; u32x4 skt[4], svt[4];
        {
            const float* sp = KVs + (size_t)u * 16384;
#pragma unroll
            for (int i = 0; i < 8; ++i) sst[i] = *(const f32x4*)(sp + (size_t)(i * NTHR + tid) * 4);
            const bf16* kp = proj + ((size_t)b * SEQ + c * 128) * NPROJ + P_RK + h * 128;
            const bf16* vp = T + ((size_t)b * NT + TC_RV + h * 128) * SEQ + c * 128;
#pragma unroll
            for (int i = 0; i < 4; ++i) { const int id = i * NTHR + tid, row = id >> 4, ch = id & 15; skt[i] = *(const u32x4*)(kp + (size_t)row * NPROJ + ch * 8); svt[i] = *(const u32x4*)(vp + (size_t)row * SEQ + ch * 8); }
        }
        bf16x8 qf[8];
        {
            const bf16* qp = proj + ((size_t)b * SEQ + q0 + r) * NPROJ + P_RQ + h * 128 + 8 * hh;
#pragma unroll
            for (int s = 0; s < 8; ++s) qf[s] = *(const bf16x8*)(qp + 16 * s);
        }
#pragma unroll
        for (int i = 0; i < 8; ++i) { const int id = i * NTHR + tid, row = id >> 5, c4 = id & 31; u32x2 w; w[0] = pk2(sst[i][0], sst[i][1]); w[1] = pk2(sst[i][2], sst[i][3]); *(LAS u32x2*)(L + RO_ST + row * RO_ROW + c4 * 8) = w; }
#pragma unroll
        for (int i = 0; i < 4; ++i) { const int id = i * NTHR + tid, row = id >> 4, ch = id & 15; *(LAS u32x4*)(L + RO_KT + row * RO_ROW + ch * 16) = skt[i]; *(LAS u32x4*)(L + RO_VT + row * RO_ROW + ch * 16) = svt[i]; }
        __syncthreads();
        f32x16 o[2];
#pragma unroll
        for (int n = 0; n < 2; ++n)
#pragma unroll
            for (int i = 0; i < 16; ++i) o[n][i] = 0.f;
#pragma unroll
        for (int ks = 0; ks < 8; ++ks)
#pragma unroll
            for (int n = 0; n < 2; ++n) o[n] = MFMA32(qf[ks], *(LAS bf16x8*)(L + RO_ST + (32 * (2 * dh + n) + r) * RO_ROW + 32 * ks + 16 * hh), o[n]);
        for (int kt = 0; kt <= qg; ++kt) {
            f32x16 x;
#pragma unroll
            for (int i = 0; i < 16; ++i) x[i] = 0.f;
#pragma unroll
            for (int s = 0; s < 8; ++s) x = MFMA32(*(LAS bf16x8*)(L + RO_KT + (32 * kt + kr) * RO_ROW + 32 * s + 16 * hh), qf[s], x);
            if (kt == qg) {
#pragma unroll
                for (int i = 0; i < 16; ++i) { const int key = 16 * (i >> 3) + 8 * hh + (i & 7); x[i] = (key <= r) ? x[i] : 0.f; }
            }
#pragma unroll
            for (int ks = 0; ks < 2; ++ks) {
                const bf16x8 pf = pack8(x[8 * ks], x[8 * ks + 1], x[8 * ks + 2], x[8 * ks + 3], x[8 * ks + 4], x[8 * ks + 5], x[8 * ks + 6], x[8 * ks + 7]);
#pragma unroll
                for (int n = 0; n < 2; ++n) o[n] = MFMA32(pf, *(LAS bf16x8*)(L + RO_VT + (32 * (2 * dh + n) + r) * RO_ROW + (32 * kt + 16 * ks + 8 * hh) * 2), o[n]);
            }
        }
        float ssr[16];
#pragma unroll
        for (int i = 0; i < 16; ++i) {
            float ss = o[0][i] * o[0][i] + o[1][i] * o[1][i];
            ss += __shfl_xor(ss, 1); ss += __shfl_xor(ss, 2); ss += __shfl_xor(ss, 4); ss += __shfl_xor(ss, 8); ss += __shfl_xor(ss, 16);
            ssr[i] = ss;
            if (r == 0) ssx[F.wave * 32 + (i & 3) + 8 * (i >> 2) + 4 * hh] = ss;
        }
        __syncthreads();
        LAS bf16* os = (LAS bf16*)(L + RO_OS + F.wave * RO_OSW);
#pragma unroll
        for (int i = 0; i < 16; ++i) {
            const int qr = (i & 3) + 8 * (i >> 2) + 4 * hh;
            const float inv = rsqrtf((ssr[i] + ssx[(F.wave ^ 1) * 32 + qr]) * (1.f / 128.f) + EPS);
            const size_t row = (size_t)b * SEQ + q0 + qr;
#pragma unroll
            for (int n = 0; n < 2; ++n) {
                const int dv = h * 128 + 64 * dh + 32 * n + r;
                const float g = bf2f(proj[row * NPROJ + P_RG + dv]);
                os[qr * 72 + 32 * n + r] = (bf16)f2bf(o[n][i] * inv * F.ret_gn_g[dv] * (g / (1.f + __expf(-g))));
            }
        }
        CBAR();
#pragma unroll
        for (int i = 0; i < 4; ++i) {
            const int id = i * 64 + lane, row = id >> 3, ch = id & 7;
            *(u32x4*)(mix + ((size_t)b * SEQ + q0 + row) * DM + h * 128 + 64 * dh + ch * 8) = *(LAS u32x4*)(os + row * 72 + ch * 8);
        }
    }
}

constexpr int XK_ROW = 528, XV_ROW = 80, XV_OFF = 32 * XK_ROW, XBUF = XV_OFF + 256 * XV_ROW;
__device__ void xattn_mfma(const Frame& F, const bf16* xq, const float* ssqq, const bf16* memk, const bf16* memvT, bf16* xo) {
    const int tid = F.tid, lane = F.lane, r = lane & 31, hh = lane >> 5, qg = F.wave >> 1, dh = F.wave & 1;
    const int kr = (r & ~12) | ((r & 4) << 1) | ((r & 8) >> 1);
    for (int u = F.bid; u < BATCH * 4 * 32; u += F.G) {
        const int qblk = u & 31, h = (u >> 5) & 3, b = u >> 7, q0 = qblk * 128 + 32 * qg;
        const bf16* kg = memk + ((size_t)b * MEML + (tid >> 5)) * DM + h * 256 + (tid & 31) * 8;
        const bf16* vg = memvT + ((size_t)(b * 4 + h) * 256 + (tid >> 2)) * MEML + (tid & 3) * 8;
        const int kl = (tid >> 5) * XK_ROW + (tid & 31) * 16, vl = XV_OFF + (tid >> 2) * XV_ROW + (tid & 3) * 16;
        u32x4 sk0 = *(const u32x4*)(kg), sk1 = *(const u32x4*)(kg + (size_t)16 * DM), sv0 = *(const u32x4*)(vg), sv1 = *(const u32x4*)(vg + (size_t)128 * MEML);
        bf16x8 qf[16];
        {
            const size_t grow = (size_t)b * SEQ + q0 + r;
            const f32x4 pq = *(const f32x4*)(ssqq + grow * 16 + h * 4);
            const float sc = rsqrtf(((pq[0] + pq[1]) + (pq[2] + pq[3])) * (1.f / 256.f) + EPS) * 0.09016844005556021f;
            const bf16* qp = xq + grow * DM + h * 256 + 8 * hh;
            const float* gp = F.xq_g + h * 256 + 8 * hh;
#pragma unroll
            for (int s = 0; s < 16; ++s) {
                const u32x4 v = *(const u32x4*)(qp + 16 * s);
                const f32x4 g0 = *(const f32x4*)(gp + 16 * s), g1 = *(const f32x4*)(gp + 16 * s + 4);
                qf[s] = pack8(bflo(v[0]) * sc * g0[0], bfhi(v[0]) * sc * g0[1], bflo(v[1]) * sc * g0[2], bfhi(v[1]) * sc * g0[3],
                              bflo(v[2]) * sc * g1[0], bfhi(v[2]) * sc * g1[1], bflo(v[3]) * sc * g1[2], bfhi(v[3]) * sc * g1[3]);
            }
        }
        *(LAS u32x4*)(F.lds + kl) = sk0; *(LAS u32x4*)(F.lds + kl + 16 * XK_ROW) = sk1; *(LAS u32x4*)(F.lds + vl) = sv0; *(LAS u32x4*)(F.lds + vl + 128 * XV_ROW) = sv1;
        __syncthreads();
        f32x16 o[4];
#pragma unroll
        for (int n = 0; n < 4; ++n)
#pragma unroll
            for (int i = 0; i < 16; ++i) o[n][i] = 0.f;
        float m = 0.f, l = 0.f;
        for (int kt = 0; kt < 8; ++kt) {
            LAS unsigned char* buf = F.lds + (kt & 1) * XBUF;
            if (kt < 7) { sk0 = *(const u32x4*)(kg + (size_t)(kt + 1) * 32 * DM); sk1 = *(const u32x4*)(kg + (size_t)((kt + 1) * 32 + 16) * DM); sv0 = *(const u32x4*)(vg + (kt + 1) * 32); sv1 = *(const u32x4*)(vg + (size_t)128 * MEML + (kt + 1) * 32); }
            f32x16 x;
#pragma unroll
            for (int i = 0; i < 16; ++i) x[i] = 0.f;
#pragma unroll
            for (int s = 0; s < 16; ++s) x = MFMA32(*(LAS bf16x8*)(buf + kr * XK_ROW + 32 * s + 16 * hh), qf[s], x);
            float tmax = x[0];
#pragma unroll
            for (int i = 1; i < 16; ++i) tmax = fmaxf(tmax, x[i]);
            tmax = fmaxf(tmax, __shfl_xor(tmax, 32));
            if (kt == 0) m = tmax;
            else if (__any(tmax > m + 8.f)) {
                const float mn = fmaxf(m, tmax), alpha = __builtin_amdgcn_exp2f(m - mn);
                m = mn; l *= alpha;
#pragma unroll
                for (int i = 0; i < 16; ++i) {
                    const float ai = __shfl(alpha, (i & 3) + 8 * (i >> 2) + 4 * hh);
#pragma unroll
                    for (int n = 0; n < 4; ++n) o[n][i] *= ai;
                }
            }
            float ps = 0.f;
#pragma unroll
            for (int i = 0; i < 16; ++i) { x[i] = __builtin_amdgcn_exp2f(x[i] - m); ps += x[i]; }
            ps += __shfl_xor(ps, 32);
            l += ps;
#pragma unroll
            for (int ks = 0; ks < 2; ++ks) {
                const bf16x8 pf = pack8(x[8 * ks], x[8 * ks + 1], x[8 * ks + 2], x[8 * ks + 3], x[8 * ks + 4], x[8 * ks + 5], x[8 * ks + 6], x[8 * ks + 7]);
#pragma unroll
                for (int n = 0; n < 4; ++n)
                    o[n] = MFMA32(pf, *(LAS bf16x8*)(buf + XV_OFF + (32 * (4 * dh + n) + r) * XV_ROW + 32 * ks + 16 * hh), o[n]);
            }
            if (kt < 7) {
                LAS unsigned char* nb = F.lds + ((kt + 1) & 1) * XBUF;
                *(LAS u32x4*)(nb + kl) = sk0; *(LAS u32x4*)(nb + kl + 16 * XK_ROW) = sk1; *(LAS u32x4*)(nb + vl) = sv0; *(LAS u32x4*)(nb + vl + 128 * XV_ROW) = sv1;
            }
            __syncthreads();
        }
        const float linv = 1.f / l;
#pragma unroll
        for (int i = 0; i < 16; ++i) {
            const int qr = (i & 3) + 8 * (i >> 2) + 4 * hh;
            const float li = __shfl(linv, qr);
            bf16* op = xo + ((size_t)b * SEQ + q0 + qr) * DM + h * 256 + 128 * dh + r;
#pragma unroll
            for (int n = 0; n < 4; ++n) op[32 * n] = (bf16)f2bf(o[n][i] * li);
        }
    }
}

__global__ void __launch_bounds__(NTHR, 2) fwd_kernel(Args args) {
    extern __shared__ __attribute__((aligned(16))) unsigned char lds_raw[];
    Frame F;
    F.lds = (LAS unsigned char*)lds_raw;
    F.tid = threadIdx.x; F.lane = F.tid & 63; F.wave = __builtin_amdgcn_readfirstlane(F.tid >> 6);
    F.G = gridDim.x; F.bid = blockIdx.x;
    F.x = (const float*)args.in[0]; F.mem = (const float*)args.in[1]; F.pos = (const int*)args.in[2];
    F.g_mix = (const float*)args.in[3]; F.w_in = (const float*)args.in[4]; F.ret_gn_g = (const float*)args.in[5];
    F.sb_q_g = (const float*)args.in[6]; F.sb_k_g = (const float*)args.in[7]; F.w_out = (const float*)args.in[8];
    F.g_xattn = (const float*)args.in[9]; F.g_mem = (const float*)args.in[10]; F.w_xq = (const float*)args.in[11];
    F.w_xkv = (const float*)args.in[12]; F.xq_g = (const float*)args.in[13]; F.xk_g = (const float*)args.in[14];
    F.w_xo = (const float*)args.in[15]; F.g_mlp = (const float*)args.in[16]; F.w_up = (const float*)args.in[17]; F.w_down = (const float*)args.in[18];
    F.out = args.out; F.ws = args.ws;
    unsigned char* ws = args.ws;
    volatile LAS unsigned* MISC = (volatile LAS unsigned*)(F.lds + MISC_OFF);
    if (F.tid < 64) MISC[F.tid] = 0u;
    __syncthreads();
    XcdBarrier bar; bar.bar = (unsigned*)(ws + WS_CTL) + 1024 + args.li * 4096; bar.x = 0; bar.st = nullptr;
    if (MK_N_LAUNCHES != NPHASE) bar = xcd_barrier_post(bar.bar, MISC + 8);
#define GRID_BAR() do { if (MK_N_LAUNCHES != NPHASE) xcd_barrier(bar); } while (0)
    const int lo = args.ph_lo, hi = args.ph_hi;
#define IN(k) (lo <= (k) && (k) < hi)
#define BOTH(k) (IN(k) && IN((k) + 1))

    bf16* Wt_in = (bf16*)(ws + WS_WIN); bf16* Wt_out = (bf16*)(ws + WS_WOUT); bf16* Wt_xq = (bf16*)(ws + WS_WXQ); bf16* Wt_xkv = (bf16*)(ws + WS_WXKV);
    bf16* Wt_xo = (bf16*)(ws + WS_WXO); bf16* Wt_up = (bf16*)(ws + WS_WUP); bf16* Wt_dn = (bf16*)(ws + WS_WDN);
    float* rinv1 = (float*)(ws + WS_RINV1); float* rinvm = (float*)(ws + WS_RINVM); float* ssq2 = (float*)(ws + WS_SSQ2); float* ssq3 = (float*)(ws + WS_SSQ3); float* ssqq = (float*)(ws + WS_SSQQ);
    bf16* memb = (bf16*)(ws + WS_MEMB); bf16* memk = (bf16*)(ws + WS_MEMK); bf16* memvT = (bf16*)(ws + WS_MEMV);
    float2* cs = (float2*)(ws + WS_ROPE);
    bf16* xb = (bf16*)(ws + WS_XB); bf16* mix = (bf16*)(ws + WS_MIX); bf16* proj = (bf16*)(ws + WS_PROJ);
    bf16* x1b = (bf16*)(ws + WS_X1B); bf16* xq = (bf16*)(ws + WS_XQ); bf16* xo = (bf16*)(ws + WS_XO); bf16* x2b = (bf16*)(ws + WS_X2B); bf16* hid = (bf16*)(ws + WS_HID); bf16* T = (bf16*)(ws + WS_T); float* KVs = (float*)(ws + WS_KVS);

    if (IN(0)) {
#pragma nounroll
        for (int rep = 0; rep < (((PROBE_MASK >> 0) & 1) ? 2 : 1); ++rep) {
            if (rep) GRID_BAR();
            conv_weight<true>(F, F.w_in, F.g_mix, Wt_in, DM, NIN);
            conv_weight<false>(F, F.w_out, nullptr, Wt_out, DM, DM);
            conv_weight<false>(F, F.w_xq, F.g_xattn, Wt_xq, DM, DM);
            conv_weight<false>(F, F.w_xkv, F.g_mem, Wt_xkv, DM, 2 * DM);
            conv_weight<false>(F, F.w_xo, nullptr, Wt_xo, DM, DM);
            conv_weight<false>(F, F.w_up, F.g_mlp, Wt_up, DM, FF);
            conv_weight<false>(F, F.w_down, nullptr, Wt_dn, FF, DM);
            rows_prep(F, F.x, xb, rinv1, M);
            rows_prep(F, F.mem, memb, rinvm, MROWS);
            rope_table(F, cs);
        }
        if (BOTH(0)) GRID_BAR();
    }
    if (IN(1)) {
#pragma nounroll
        for (int rep = 0; rep < (((PROBE_MASK >> 1) & 1) ? 2 : 1); ++rep) {
            if (rep) GRID_BAR();
            { EpiInProj E{proj, rinv1, cs, F.sb_q_g, F.sb_k_g, T}; gemm_big(F, xb, Wt_in, NIN, DM, E); }
        }
        if (BOTH(1)) GRID_BAR();
    }
    if (IN(2)) {
#pragma nounroll
        for (int rep = 0; rep < (((PROBE_MASK >> 2) & 1) ? 2 : 1); ++rep) {
            if (rep) GRID_BAR();
            ret_kv(F, T, KVs);
            sb_mfma(F, proj, T, mix);
        }
        if (BOTH(2)) GRID_BAR();
    }
    if (IN(3)) {
#pragma nounroll
        for (int rep = 0; rep < (((PROBE_MASK >> 3) & 1) ? 2 : 1); ++rep) {
            if (rep) GRID_BAR();
            const int nmk = (F.G > 128) ? 64 : 0;
            if (nmk == 0 || F.bid < nmk) { Frame Fm = F; if (nmk) Fm.G = nmk; EpiMemKV E{memk, memvT, rinvm, F.xk_g}; gemm_phase_v1(Fm, memb, Wt_xkv, MROWS, 2 * DM, DM, E); }
            if (nmk == 0 || F.bid >= nmk) ret_scan(F, KVs, nmk, F.G - nmk);
        }
        if (BOTH(3)) GRID_BAR();
    }
    if (IN(4)) {
#pragma nounroll
        for (int rep = 0; rep < (((PROBE_MASK >> 4) & 1) ? 2 : 1); ++rep) {
            if (rep) GRID_BAR();
            ret_out(F, proj, T, KVs, mix);
        }
        if (BOTH(4)) GRID_BAR();
    }
    if (IN(5)) {
#pragma nounroll
        for (int rep = 0; rep < (((PROBE_MASK >> 5) & 1) ? 2 : 1); ++rep) {
            if (rep) GRID_BAR();
            EpiResid<false> E{F.x, x1b, ssq2}; gemm_big(F, mix, Wt_out, DM, DM, E);
        }
        if (BOTH(5)) GRID_BAR();
    }
    if (IN(6)) {
#pragma nounroll
        for (int rep = 0; rep < (((PROBE_MASK >> 6) & 1) ? 2 : 1); ++rep) {
            if (rep) GRID_BAR();
            EpiXQ E{xq, ssq2, ssqq}; gemm_big(F, x1b, Wt_xq, DM, DM, E);
        }
        if (BOTH(6)) GRID_BAR();
    }
    if (IN(7)) {
#pragma nounroll
        for (int rep = 0; rep < (((PROBE_MASK >> 7) & 1) ? 2 : 1); ++rep) {
            if (rep) GRID_BAR();
            xattn_mfma(F, xq, ssqq, memk, memvT, xo);
        }
        if (BOTH(7)) GRID_BAR();
    }
    if (IN(8)) {
#pragma nounroll
        for (int rep = 0; rep < (((PROBE_MASK >> 8) & 1) ? 2 : 1); ++rep) {
            if (rep) GRID_BAR();
            EpiResid<true> E{x1b, x2b, ssq3}; gemm_big(F, xo, Wt_xo, DM, DM, E);
        }
        if (BOTH(8)) GRID_BAR();
    }
    if (IN(9)) {
#pragma nounroll
        for (int rep = 0; rep < (((PROBE_MASK >> 9) & 1) ? 2 : 1); ++rep) {
            if (rep) GRID_BAR();
            EpiUp E{hid, ssq3}; gemm_big(F, x2b, Wt_up, FF, DM, E);
        }
        if (BOTH(9)) GRID_BAR();
    }
    if (IN(10)) {
#pragma nounroll
        for (int rep = 0; rep < (((PROBE_MASK >> 10) & 1) ? 2 : 1); ++rep) {
            if (rep) GRID_BAR();
            EpiDown E{x2b, F.out}; gemm_big(F, hid, Wt_dn, DM, FF, E);
        }
    }
#undef IN
#undef BOTH
}

extern "C" void kernel_launch(void* const* d_in, const int* in_sizes, int n_in, void* d_out, int out_size, void* d_ws, size_t ws_size, hipStream_t stream) {
    static int grid = 0;
    if (grid == 0) {
        if (n_in != 19 || in_sizes[0] != M * DM || out_size != M * DM || ws_size < WS_END) { fprintf(stderr, "kernel_launch: unexpected shapes (n_in %d, in0 %d, out %d, ws %zu); nothing launched\n", n_in, n_in > 0 ? in_sizes[0] : -1, out_size, ws_size); grid = -1; return; }
        int dev = 0, cus = 0, per_cu = 0;
        if (hipGetDevice(&dev) != hipSuccess || hipDeviceGetAttribute(&cus, hipDeviceAttributeMultiprocessorCount, dev) != hipSuccess) { grid = -1; return; }
        if (hipFuncSetAttribute((const void*)fwd_kernel, hipFuncAttributeMaxDynamicSharedMemorySize, LDS_BYTES) != hipSuccess) { fprintf(stderr, "kernel_launch: hipFuncSetAttribute failed\n"); grid = -1; return; }
        if (hipOccupancyMaxActiveBlocksPerMultiprocessor(&per_cu, (const void*)fwd_kernel, NTHR, LDS_BYTES) != hipSuccess || per_cu < 1) fprintf(stderr, "kernel_launch: occupancy query reports %d per CU\n", per_cu);
        (void)hipGetLastError();
        grid = cus;
    }
    if (grid < 0) return;
    (void)hipMemsetAsync((char*)d_ws + WS_CTL, 0, CTL_ZERO_BYTES, stream);
    Args a{};
    for (int i = 0; i < 19; ++i) a.in[i] = d_in[i];
    a.out = (float*)d_out; a.ws = (unsigned char*)d_ws;
    for (int li = 0; li < MK_N_LAUNCHES; ++li) {
        a.ph_lo = (MK_N_LAUNCHES == NPHASE) ? li : 0; a.ph_hi = (MK_N_LAUNCHES == NPHASE) ? li + 1 : NPHASE; a.li = li; a.pad = 0;
        hipLaunchKernelGGL(fwd_kernel, dim3(grid), dim3(NTHR), LDS_BYTES, stream, a);
    }
}
```

```cpp
#include <hip/hip_runtime.h>
#include <stdint.h>
#include <cstdio>

#define LAS __attribute__((address_space(3)))
#define GAS __attribute__((address_space(1)))
typedef unsigned short bf16;
typedef short bf16x8 __attribute__((ext_vector_type(8)));
typedef float f32x4 __attribute__((ext_vector_type(4)));
typedef unsigned u32x4 __attribute__((ext_vector_type(4)));
typedef unsigned u32x2 __attribute__((ext_vector_type(2)));
typedef GAS unsigned gu32;

#ifndef MK_N_LAUNCHES
#define MK_N_LAUNCHES 1
#endif
constexpr int NPHASE = 11;
#ifndef PROBE_MASK
#define PROBE_MASK 0
#endif
#ifndef PROBE_SPIN
#define PROBE_SPIN -1
#endif
#ifndef PROBE_A
#define PROBE_A (PROBE_SPIN)
#endif
#ifndef PROBE_B
#define PROBE_B (PROBE_SPIN + 1)
#endif
constexpr int NWAVES = 8, NTHR = 512;

constexpr int BATCH = 4, SEQ = 4096, DM = 1024, M = BATCH * SEQ;
constexpr int NIN = 3584, FF = 4096, MEML = 256, MROWS = BATCH * MEML;
constexpr int NPROJ = 2560, P_RQ = 0, P_RK = 512, P_RG = 1024, P_SQ = 1536, P_SK = 2048;
constexpr int NT = 1536, TC_RK = 0, TC_RV = 512, TC_SV = 1024, TS = 4160;
constexpr float EPS = 1e-6f;

constexpr size_t MiB = 1u << 20;
constexpr size_t WS_CTL = 0, CTL_ZERO_BYTES = 64 * 1024;
constexpr size_t WS_WIN = 1 * MiB, WS_WOUT = 8 * MiB, WS_WXQ = 10 * MiB, WS_WXKV = 12 * MiB, WS_WXO = 16 * MiB, WS_WUP = 18 * MiB, WS_WDN = 26 * MiB;
constexpr size_t WS_RINV1 = 34 * MiB, WS_RINVM = 34 * MiB + 64 * 1024;
constexpr size_t WS_SSQ2 = 242 * MiB, WS_SSQ3 = 243 * MiB, WS_SSQQ = 244 * MiB;
constexpr size_t WS_MEMB = 35 * MiB, WS_MEMK = 37 * MiB, WS_MEMV = 39 * MiB;
constexpr size_t WS_ROPE = 41 * MiB;
constexpr size_t WS_XB = 49 * MiB, WS_MIX = 49 * MiB;
constexpr size_t WS_PROJ = 81 * MiB;
constexpr size_t WS_T = 161 * MiB;
constexpr size_t WS_KVS = 210 * MiB;
constexpr size_t WS_X1B = 81 * MiB, WS_XQ = 113 * MiB, WS_XO = 145 * MiB;
constexpr size_t WS_X2B = 193 * MiB;
constexpr size_t WS_HID = 49 * MiB;
constexpr size_t WS_SSQK = 245 * MiB;
constexpr size_t WS_END = 246 * MiB;

constexpr int LDS_BYTES = 159744;
constexpr int MISC_OFF = LDS_BYTES - 256;

__device__ const double INVF[64] = {1.0, 0.8659643233600653, 0.7498942093324559, 0.6493816315762113, 0.5623413251903491, 0.4869675251658631, 0.4216965034285822, 0.3651741272548377, 0.31622776601683794, 0.27384196342643613, 0.23713737056616552, 0.2053525026457146, 0.1778279410038923, 0.1539926526059492, 0.1333521432163324, 0.11547819846894582, 0.1, 0.08659643233600653, 0.07498942093324558, 0.06493816315762113, 0.05623413251903491, 0.04869675251658631, 0.042169650342858224, 0.03651741272548377, 0.03162277660168379, 0.027384196342643614, 0.023713737056616554, 0.02053525026457146, 0.01778279410038923, 0.01539926526059492, 0.01333521432163324, 0.011547819846894581, 0.01, 0.008659643233600654, 0.007498942093324558, 0.006493816315762113, 0.005623413251903491, 0.004869675251658631, 0.004216965034285823, 0.003651741272548377, 0.0031622776601683794, 0.0027384196342643613, 0.0023713737056616554, 0.002053525026457146, 0.0017782794100389228, 0.001539926526059492, 0.001333521432163324, 0.0011547819846894581, 0.001, 0.0008659643233600654, 0.0007498942093324559, 0.0006493816315762113, 0.0005623413251903491, 0.0004869675251658631, 0.00042169650342858224, 0.0003651741272548377, 0.00031622776601683794, 0.0002738419634264361, 0.00023713737056616554, 0.0002053525026457146, 0.00017782794100389227, 0.0001539926526059492, 0.0001333521432163324, 0.00011547819846894582};

__device__ __forceinline__ float bflo(unsigned u) { return __uint_as_float(u << 16); }
__device__ __forceinline__ float bfhi(unsigned u) { return __uint_as_float(u & 0xffff0000u); }
__device__ __forceinline__ float bf2f(bf16 v) { return __uint_as_float(((unsigned)v) << 16); }
__device__ __forceinline__ unsigned f2bf(float f) { unsigned u = __float_as_uint(f); return (u + 0x7fffu + ((u >> 16) & 1u)) >> 16; }
__device__ __forceinline__ unsigned cvtpk(float lo, float hi);
__device__ __forceinline__ unsigned pk2(float lo, float hi) { return cvtpk(lo, hi); }
typedef float f32x2_t __attribute__((ext_vector_type(2)));
typedef __bf16 bf16x2_t __attribute__((ext_vector_type(2)));
__device__ __forceinline__ unsigned cvtpk(float lo, float hi) { const f32x2_t v = {lo, hi}; return __builtin_bit_cast(unsigned, __builtin_convertvector(v, bf16x2_t)); }
__device__ __forceinline__ float wave_sum(float v) {
#pragma unroll
    for (int o = 1; o < 64; o <<= 1) v += __shfl_xor(v, o);
    return v;
}
__device__ __forceinline__ float wave_max(float v) {
#pragma unroll
    for (int o = 1; o < 64; o <<= 1) v = fmaxf(v, __shfl_xor(v, o));
    return v;
}
__device__ __forceinline__ void swap32(float a, float& r0, float& r1) {
    const auto rr_ = __builtin_amdgcn_permlane32_swap(__float_as_uint(a), __float_as_uint(a), false, false);
    r0 = __uint_as_float(rr_[0]); r1 = __uint_as_float(rr_[1]);
}
__device__ __forceinline__ float sum_xor32(float a) { float r0, r1; swap32(a, r0, r1); return r0 + r1; }
__device__ __forceinline__ float max_xor32(float a) { float r0, r1; swap32(a, r0, r1); return fmaxf(r0, r1); }
__device__ __forceinline__ float get_xor32(float a, int hh) { float r0, r1; swap32(a, r0, r1); return hh == 0 ? r1 : r0; }
#define CBAR() asm volatile("" ::: "memory")
__device__ __forceinline__ int opaque_tid() { int t = threadIdx.x; asm volatile("" : "+v"(t)); return t; }
__device__ __forceinline__ float lg2gamma(int h) { return h == 0 ? -0.04580368961312479f : h == 1 ? -0.02272007650008353f : h == 2 ? -0.011315313227834146f : -0.005646563141142063f; }

#define XB_TMO      128
#define XB_XCNT(j)  (256  + 64 * (j))
#define XB_XSUB(j)  (1280 + 64 * (j))
#define XB_XGEN(j)  (2304 + 64 * (j))
#define XB_TOP      3328
#define XB_TOPGEN   3392
#define XCD_BAR_WORDS 3456
#define XB_SPIN_CAP (1u << 22)
__device__ __forceinline__ unsigned xb_ld(unsigned* p)              { return __hip_atomic_load(p, __ATOMIC_RELAXED, __HIP_MEMORY_SCOPE_AGENT); }
__device__ __forceinline__ unsigned xb_add(unsigned* p, unsigned v) { return __hip_atomic_fetch_add(p, v, __ATOMIC_RELAXED, __HIP_MEMORY_SCOPE_AGENT); }
__device__ __forceinline__ unsigned xb_xcc_id() { return (unsigned)__builtin_amdgcn_s_getreg((3 << 11) | 20) & 0xFu; }
#define XB_SPIN(cond, bar) do { unsigned _sp = 0; while (cond) { __builtin_amdgcn_s_sleep(1); \
    if ((++_sp & 255u) == 0u) { if (xb_ld(&(bar)[XB_TMO])) break; if (_sp > XB_SPIN_CAP) { atomicAdd(&(bar)[XB_TMO], 1u); break; } } } } while (0)
struct XcdBarrier { unsigned* bar; unsigned x; volatile LAS unsigned* st; };
__device__ __forceinline__ XcdBarrier xcd_barrier_post(unsigned* bar, volatile LAS unsigned* st) {
    XcdBarrier b; b.bar = bar; b.x = xb_xcc_id(); b.st = st;
    if (threadIdx.x == 0) (void)xb_add(&bar[XB_XCNT(b.x)], 1u);
    return b;
}
__device__ __forceinline__ void xcd_barrier_complete(unsigned* bar, unsigned x, unsigned& nloc, unsigned& nx) {
    const unsigned G = gridDim.x * gridDim.y * gridDim.z;
    unsigned sum, cnt, mine, sp = 0u;
    for (;;) {
        sum = 0u; cnt = 0u; mine = 0u;
#pragma unroll
        for (unsigned j = 0; j < 16; ++j) { const unsigned c = xb_ld(&bar[XB_XCNT(j)]); sum += c; cnt += (c > 0u) ? 1u : 0u; mine = (j == x) ? c : mine; }
        if (sum == G) break;
        __builtin_amdgcn_s_sleep(1);
        if ((++sp & 255u) == 0u) { if (xb_ld(&bar[XB_TMO])) break; if (sp > XB_SPIN_CAP) { atomicAdd(&bar[XB_TMO], 1u); break; } }
    }
    nloc = mine > 0u ? mine : 1u; nx = cnt > 0u ? cnt : 1u;
}
__device__ __forceinline__ void xcd_barrier(const XcdBarrier& b) {
    asm volatile("s_waitcnt vmcnt(0)" ::: "memory");
    __syncthreads();
    if (threadIdx.x == 0) {
        unsigned* bar = b.bar;
        __builtin_amdgcn_s_waitcnt(0);
        unsigned nloc = b.st[0], nx = b.st[1];
        if (nloc == 0u) { xcd_barrier_complete(bar, b.x, nloc, nx); b.st[0] = nloc; b.st[1] = nx; }
        const unsigned old = xb_add(&bar[XB_XSUB(b.x)], 1u);
        const unsigned gen = old / nloc;
        if (old + 1u == (gen + 1u) * nloc) {
            __builtin_amdgcn_fence(__ATOMIC_RELEASE, "agent");
            asm volatile("s_waitcnt vmcnt(0)" ::: "memory");
            const unsigned og = xb_add(&bar[XB_TOP], 1u);
            const unsigned tg = og / nx;
            if (og + 1u == (tg + 1u) * nx) xb_add(&bar[XB_TOPGEN], 1u);
            else XB_SPIN(xb_ld(&bar[XB_TOPGEN]) == tg, bar);
            __builtin_amdgcn_fence(__ATOMIC_ACQUIRE, "agent");
            xb_add(&bar[XB_XGEN(b.x)], 1u);
            asm volatile("s_waitcnt vmcnt(0)" ::: "memory");
        } else {
            XB_SPIN(xb_ld(&bar[XB_XGEN(b.x)]) == gen, bar);
            __builtin_amdgcn_fence(__ATOMIC_ACQUIRE, "agent");
            asm volatile("s_waitcnt vmcnt(0)" ::: "memory");
        }
    }
    __syncthreads();
}

struct Args { const void* in[19]; float* out; unsigned char* ws; int ph_lo, ph_hi, li, pad; };
struct Frame {
    LAS unsigned char* lds;
    int tid, lane, wave, G, bid;
    const float *x, *mem; const int* pos;
    const float *g_mix, *w_in, *ret_gn_g, *sb_q_g, *sb_k_g, *w_out, *g_xattn, *g_mem, *w_xq, *w_xkv, *xq_g, *xk_g, *w_xo, *g_mlp, *w_up, *w_down;
    float* out; unsigned char* ws;
};
#define STAMPF(Fr, k) do { if (PROBE_A >= 0 && (Fr).bid == 0 && threadIdx.x == 0 && ((k) == PROBE_A || (k) == PROBE_B)) { const unsigned long long t_ = __builtin_amdgcn_s_memrealtime(); \
        volatile LAS unsigned* M_ = (volatile LAS unsigned*)((Fr).lds + MISC_OFF); M_[16 + 2 * ((k) == PROBE_B ? 1 : 0)] = (unsigned)t_; M_[17 + 2 * ((k) == PROBE_B ? 1 : 0)] = (unsigned)(t_ >> 32); } } while (0)

__device__ __forceinline__ int inproj_src_col(int np) {
    const int pn = np >> 8, p = np & 255, seg = pn >> 1, half = pn & 1, bj = p >> 7, wc = (p >> 5) & 3, i = p & 31;
    if (seg <= 1) { const int h = 2 * half + bj, g = 4 * wc + (i >> 3), e = i & 7; return seg * 512 + h * 128 + (e < 4 ? 4 * g + e : 64 + 4 * g + e - 4); }
    if (seg == 4 || seg == 5) { const int head = 4 * half + wc; return seg * 512 + head * 64 + 32 * bj + i; }
    return np;
}
struct WD { const float* W; const float* g; bf16* Wt; int K, N; bool perm; };
__device__ __forceinline__ void conv_batch4(const Frame& F, const WD& d0, int t0, const WD& d1, int t1, const WD& d2, int t2, const WD& d3, int t3) {
    LAS float* T = (LAS float*)F.lds;
    const int r0 = F.tid >> 4, c = (F.tid & 15) * 4;
    f32x4 v[4][2]; int k0[4], n0[4];
#define CW_LOAD(j, d, t) do { if ((t) >= 0) { const int tn = (d).N >> 6; k0[j] = ((t) / tn) * 64; n0[j] = ((t) % tn) * 64; const int sc = (d).perm ? inproj_src_col(n0[j] + c) : n0[j] + c; \
        _Pragma("unroll") for (int i = 0; i < 2; ++i) { const int r = r0 + 32 * i; v[j][i] = *(const f32x4*)((d).W + (size_t)(k0[j] + r) * (d).N + sc); if ((d).g) v[j][i] = v[j][i] * (d).g[k0[j] + r]; } } } while (0)
    CW_LOAD(0, d0, t0); CW_LOAD(1, d1, t1); CW_LOAD(2, d2, t2); CW_LOAD(3, d3, t3);
    __syncthreads();
#define CW_LDSW(j, t) do { if ((t) >= 0) { _Pragma("unroll") for (int i = 0; i < 2; ++i) { LAS float* Tj = T + (j) * (64 * 65) + (r0 + 32 * i) * 65 + c; Tj[0] = v[j][i][0]; Tj[1] = v[j][i][1]; Tj[2] = v[j][i][2]; Tj[3] = v[j][i][3]; } } } while (0)
    CW_LDSW(0, t0); CW_LDSW(1, t1); CW_LDSW(2, t2); CW_LDSW(3, t3);
    __syncthreads();
#define CW_STORE(j, d, t) do { if ((t) >= 0) { const LAS float* Tj = T + (j) * (64 * 65); _Pragma("unroll") for (int i = 0; i < 2; ++i) { const int n = r0 + 32 * i; \
        u32x2 o; o[0] = pk2(Tj[(c + 0) * 65 + n], Tj[(c + 1) * 65 + n]); o[1] = pk2(Tj[(c + 2) * 65 + n], Tj[(c + 3) * 65 + n]); *(u32x2*)((d).Wt + (size_t)(n0[j] + n) * (d).K + k0[j] + c) = o; } } } while (0)
    CW_STORE(0, d0, t0); CW_STORE(1, d1, t1); CW_STORE(2, d2, t2); CW_STORE(3, d3, t3);
#undef CW_LOAD
#undef CW_LDSW
#undef CW_STORE
}
__device__ __forceinline__ void conv_weights(const Frame& F, bf16* Wt_in, bf16* Wt_out, bf16* Wt_xq, bf16* Wt_xkv, bf16* Wt_xo, bf16* Wt_up, bf16* Wt_dn) {
    const WD win{F.w_in, F.g_mix, Wt_in, DM, NIN, true}, wout{F.w_out, nullptr, Wt_out, DM, DM, false}, wxq{F.w_xq, F.g_xattn, Wt_xq, DM, DM, false}, wxkv{F.w_xkv, F.g_mem, Wt_xkv, DM, 2 * DM, false},
             wxo{F.w_xo, nullptr, Wt_xo, DM, DM, false}, wup{F.w_up, F.g_mlp, Wt_up, DM, FF, false}, wdn{F.w_down, nullptr, Wt_dn, FF, DM, false};
    for (int c = F.bid; c < 256; c += F.G) {
        conv_batch4(F, win, c, win, c + 256, win, c + 512, win, (c + 768 < 896) ? c + 768 : -1);
        conv_batch4(F, wout, c, wxq, c, wxo, c, wxkv, c);
        conv_batch4(F, wxkv, c + 256, wup, c, wup, c + 256, wup, c + 512);
        conv_batch4(F, wup, c + 768, wdn, c, wdn, c + 256, wdn, c + 512);
        conv_batch4(F, wdn, c + 768, wdn, -1, wdn, -1, wdn, -1);
    }
    __syncthreads();
}
__device__ __forceinline__ void rows_prep(const Frame& F, const float* X, bf16* Xb, float* rinv, int rows) {
    const int gw = F.bid * NWAVES + F.wave, GW = F.G * NWAVES;
    for (int rb = gw; rb < rows; rb += 4 * GW) {
        f32x4 v[4][4];
#pragma unroll
        for (int j = 0; j < 4; ++j) {
            const int r = min(rb + j * GW, rows - 1);
#pragma unroll
            for (int i = 0; i < 4; ++i) v[j][i] = *(const f32x4*)(X + (size_t)r * DM + i * 256 + F.lane * 4);
        }
#pragma unroll
        for (int j = 0; j < 4; ++j) {
            const int r = rb + j * GW;
            if (r < rows) {
                float ss = 0.f;
#pragma unroll
                for (int i = 0; i < 4; ++i) {
                    const f32x4 t = v[j][i] * v[j][i]; ss += (t[0] + t[1]) + (t[2] + t[3]);
                    u32x2 o; o[0] = pk2(v[j][i][0], v[j][i][1]); o[1] = pk2(v[j][i][2], v[j][i][3]);
                    *(u32x2*)(Xb + (size_t)r * DM + i * 256 + F.lane * 4) = o;
                }
                ss = wave_sum(ss);
                if (F.lane == 0) rinv[r] = rsqrtf(ss * (1.f / DM) + EPS);
            }
        }
    }
}
__device__ __forceinline__ void rope_table(const Frame& F, float2* cs) {
    const int total = M * 64;
    for (int e = F.bid * NTHR + F.tid; e < total; e += F.G * NTHR) {
        const int row = e >> 6, j = e & 63;
        const double ang = (double)F.pos[row] * INVF[j];
        const double rev = ang * 0.15915494309189535;
        const float fr = (float)(rev - floor(rev));
        float2 o; o.x = __builtin_amdgcn_cosf(fr); o.y = __builtin_amdgcn_sinf(fr);
        cs[e] = o;
    }
}

__device__ __forceinline__ void p0_fused(const Frame& F, bf16* Wt_in, bf16* Wt_out, bf16* Wt_xq, bf16* Wt_xkv, bf16* Wt_xo, bf16* Wt_up, bf16* Wt_dn,
                                         bf16* xb, float* rinv1, bf16* memb, float* rinvm, float2* cs) {
    const WD win{F.w_in, F.g_mix, Wt_in, DM, NIN, true}, wout{F.w_out, nullptr, Wt_out, DM, DM, false}, wxq{F.w_xq, F.g_xattn, Wt_xq, DM, DM, false}, wxkv{F.w_xkv, F.g_mem, Wt_xkv, DM, 2 * DM, false},
             wxo{F.w_xo, nullptr, Wt_xo, DM, DM, false}, wup{F.w_up, F.g_mlp, Wt_up, DM, FF, false}, wdn{F.w_down, nullptr, Wt_dn, FF, DM, false};
    LAS float* T = (LAS float*)F.lds;
    const int r0 = F.tid >> 4, c = (F.tid & 15) * 4, lane = F.lane;
    const int gw = F.bid * NWAVES + F.wave, GW = F.G * NWAVES;
    f32x4 vA[4][2], vB[4][2]; int k0A[4], n0A[4], k0B[4], n0B[4];
    f32x4 rv[4][4];
#define CW_LOAD(V, K0, N0, j, d, t) do { if ((t) >= 0) { const int tn = (d).N >> 6; K0[j] = ((t) / tn) * 64; N0[j] = ((t) % tn) * 64; const int sc = (d).perm ? inproj_src_col(N0[j] + c) : N0[j] + c; \
        _Pragma("unroll") for (int i = 0; i < 2; ++i) { const int r = r0 + 32 * i; V[j][i] = __builtin_nontemporal_load((const f32x4*)((d).W + (size_t)(K0[j] + r) * (d).N + sc)); if ((d).g) V[j][i] = V[j][i] * (d).g[K0[j] + r]; } } } while (0)
#define CW_LDSW(V, j, t) do { if ((t) >= 0) { _Pragma("unroll") for (int i = 0; i < 2; ++i) { LAS float* Tj = T + (j) * (64 * 65) + (r0 + 32 * i) * 65 + c; Tj[0] = V[j][i][0]; Tj[1] = V[j][i][1]; Tj[2] = V[j][i][2]; Tj[3] = V[j][i][3]; } } } while (0)
#define CW_STORE(K0, N0, j, d, t) do { if ((t) >= 0) { const LAS float* Tj = T + (j) * (64 * 65); _Pragma("unroll") for (int i = 0; i < 2; ++i) { const int n = r0 + 32 * i; \
        u32x2 o; o[0] = pk2(Tj[(c + 0) * 65 + n], Tj[(c + 1) * 65 + n]); o[1] = pk2(Tj[(c + 2) * 65 + n], Tj[(c + 3) * 65 + n]); *(u32x2*)((d).Wt + (size_t)(N0[j] + n) * (d).K + K0[j] + c) = o; } } } while (0)
#define CW_ISSUE(S, d0, t0, d1, t1, d2, t2, d3, t3) do { CW_LOAD(v##S, k0##S, n0##S, 0, d0, t0); CW_LOAD(v##S, k0##S, n0##S, 1, d1, t1); CW_LOAD(v##S, k0##S, n0##S, 2, d2, t2); CW_LOAD(v##S, k0##S, n0##S, 3, d3, t3); __builtin_amdgcn_sched_barrier(0); } while (0)
#define CW_FINISH(S, d0, t0, d1, t1, d2, t2, d3, t3) do { __syncthreads(); CW_LDSW(v##S, 0, t0); CW_LDSW(v##S, 1, t1); CW_LDSW(v##S, 2, t2); CW_LDSW(v##S, 3, t3); __syncthreads(); \
        CW_STORE(k0##S, n0##S, 0, d0, t0); CW_STORE(k0##S, n0##S, 1, d1, t1); CW_STORE(k0##S, n0##S, 2, d2, t2); CW_STORE(k0##S, n0##S, 3, d3, t3); __builtin_amdgcn_sched_barrier(0); } while (0)
#define ROW_ISSUE(X, rows, jb) do { _Pragma("unroll") for (int j = 0; j < 4; ++j) { const int r = min(gw + ((jb) + j) * GW, (rows) - 1); \
        _Pragma("unroll") for (int i = 0; i < 4; ++i) rv[j][i] = __builtin_nontemporal_load((const f32x4*)((X) + (size_t)r * DM + i * 256 + lane * 4)); } __builtin_amdgcn_sched_barrier(0); } while (0)
#define ROW_FINISH(Xb, rinv, rows, jb, nj) do { _Pragma("unroll") for (int j = 0; j < (nj); ++j) { const int r = gw + ((jb) + j) * GW; if (r < (rows)) { float ss = 0.f; \
        _Pragma("unroll") for (int i = 0; i < 4; ++i) { const f32x4 t = rv[j][i] * rv[j][i]; ss += (t[0] + t[1]) + (t[2] + t[3]); u32x2 o; o[0] = pk2(rv[j][i][0], rv[j][i][1]); o[1] = pk2(rv[j][i][2], rv[j][i][3]); \
            *(u32x2*)((Xb) + (size_t)r * DM + i * 256 + lane * 4) = o; } \
        ss = wave_sum(ss); if (lane == 0) (rinv)[r] = rsqrtf(ss * (1.f / DM) + EPS); } } __builtin_amdgcn_sched_barrier(0); } while (0)
    const int cb = F.bid;
    const int t3a = (cb + 768 < 896) ? cb + 768 : -1;
    ROW_ISSUE(F.x, M, 0);
    CW_ISSUE(A, win, cb, win, cb + 256, win, cb + 512, win, t3a);
    ROW_FINISH(xb, rinv1, M, 0, 4);
    STAMPF(F, 20);
    ROW_ISSUE(F.x, M, 4);
    CW_ISSUE(B, wout, cb, wxq, cb, wxo, cb, wxkv, cb);
    CW_FINISH(A, win, cb, win, cb + 256, win, cb + 512, win, t3a);
    STAMPF(F, 21);
    ROW_FINISH(xb, rinv1, M, 4, 4);
    STAMPF(F, 22);
    ROW_ISSUE(F.mem, MROWS, 0);
    CW_ISSUE(A, wxkv, cb + 256, wup, cb, wup, cb + 256, wup, cb + 512);
    CW_FINISH(B, wout, cb, wxq, cb, wxo, cb, wxkv, cb);
    STAMPF(F, 23);
    ROW_FINISH(memb, rinvm, MROWS, 0, 1);
    CW_ISSUE(B, wup, cb + 768, wdn, cb, wdn, cb + 256, wdn, cb + 512);
    CW_FINISH(A, wxkv, cb + 256, wup, cb, wup, cb + 256, wup, cb + 512);
    STAMPF(F, 24);
    CW_ISSUE(A, wdn, cb + 768, wdn, -1, wdn, -1, wdn, -1);
    CW_FINISH(B, wup, cb + 768, wdn, cb, wdn, cb + 256, wdn, cb + 512);
    STAMPF(F, 25);
    CW_FINISH(A, wdn, cb + 768, wdn, -1, wdn, -1, wdn, -1);
    STAMPF(F, 26);
#undef CW_LOAD
#undef CW_LDSW
#undef CW_STORE
#undef CW_ISSUE
#undef CW_FINISH
#undef ROW_ISSUE
#undef ROW_FINISH
    __syncthreads();
}

namespace pg8 {
#define PG8_LAS __attribute__((address_space(3)))
typedef unsigned short bf16_t;
typedef short bf16x8 __attribute__((ext_vector_type(8)));
typedef float f32x4 __attribute__((ext_vector_type(4)));
typedef unsigned u32x4 __attribute__((ext_vector_type(4)));
constexpr int BM = 256, BK = 64, HALF = 128, HTB = HALF * BK * 2  , STAGE_BYTES = 8 * HTB, NXCD = 8, WGM = 8;

__host__ __device__ __forceinline__ int lds_byte(int r, int c) { const int st = (r >> 4) * 2 + (c >> 5), rr = r & 15, cc = c & 31, ob = rr * 64 + cc * 2; return st * 1024 + (ob ^ (((ob >> 9) & 1) << 5)); }
__host__ __device__ __forceinline__ void stage_rc(int b, int& R, int& C) { const int st = b / 1024, sb = b % 1024, swz = sb ^ (((sb >> 9) & 1) << 5); R = (st >> 1) * 16 + swz / 64; C = (st & 1) * 32 + (swz % 64) / 2; }
__host__ __device__ __forceinline__ int perm32(int rho) { const int n = rho >> 4, i = rho & 15; return 8 * (i >> 2) + 4 * n + (i & 3); }

struct Unit { int pm, pn, prob, idx; };
struct Gemm { const bf16_t* A; const bf16_t* Bt; int M, N, K; const bf16_t* A2; const bf16_t* Bt2; };

struct StaticOrder {
    int nM, nN, nwg, G, c;
    __host__ __device__ __forceinline__ void init(int M, int N, int G_, int c_) { nM = M / BM; nN = N / BM; nwg = nM * nN; G = G_; c = c_; }
    __host__ __device__ __forceinline__ bool next(int i, Unit& u) const {
        const long L = (long)i * G + c; if (L >= nwg) return false;
        int wgid = (int)L; { const int q = nwg / NXCD, r = nwg % NXCD, xcd = wgid % NXCD, off = wgid / NXCD; wgid = (xcd < r ? xcd * (q + 1) : r * (q + 1) + (xcd - r) * q) + off; }
        const int nig = WGM * nN, gid = wgid / nig, fm = gid * WGM, gsz = (nM - fm) < WGM ? (nM - fm) : WGM;
        u.pm = fm + ((wgid % nig) % gsz); u.pn = (wgid % nig) / gsz; u.prob = 0; u.idx = i; return true;
    }
    __device__ __forceinline__ void a_ready(const Unit&) const {}
    __device__ __forceinline__ void done(const Unit&) const {}
};

__device__ __forceinline__ unsigned cvt_pk_bf16(float lo, float hi) { unsigned r; asm volatile("v_cvt_pk_bf16_f32 %0, %1, %2" : "=v"(r) : "v"(lo), "v"(hi)); return r; }
struct TwoOrder {
    StaticOrder S1; int nM2, nwg2;
    __host__ __device__ __forceinline__ void init(int M, int N, int M2, int N2, int G_, int c_) { S1.init(M, N, G_, c_); nM2 = M2 / BM; nwg2 = nM2 * (N2 / BM); }
    __host__ __device__ __forceinline__ bool next(int i, Unit& u) const {
        const long L = (long)i * S1.G + S1.c;
        if (L < S1.nwg) return S1.next(i, u);
        const int l2 = (int)(L - S1.nwg); if (l2 >= nwg2) return false;
        u.pm = l2 % nM2; u.pn = l2 / nM2; u.prob = 1; u.idx = i; return true;
    }
    __device__ __forceinline__ void a_ready(const Unit&) const {}
    __device__ __forceinline__ void done(const Unit&) const {}
};

template <class Epi, class Sched, bool ALIGN_EPI = false, bool SP2 = false>
__device__ __forceinline__ void gemm_phase(PG8_LAS unsigned char* lds, const Gemm g, const Sched& S, const Epi& E) {
    int tid_ = threadIdx.x; asm volatile("" : "+v"(tid_));
    const int tid = tid_, wid = __builtin_amdgcn_readfirstlane(tid >> 6), lane = tid & 63, wr = wid >> 2, wc = wid & 3, fr = lane & 15, fq = lane >> 4;
    const int K = g.K, nt = K / BK;
    unsigned voffA[2], voffB[2];
#pragma unroll
    for (int i = 0; i < 2; ++i) { int R, C; stage_rc(tid * 16 + i * 8192, R, C); const int Rb = Epi::PERM ? ((R & ~31) + perm32(R & 31)) : R;
        voffA[i] = (unsigned)(R * K + C) * 2u; voffB[i] = (unsigned)(Rb * K + C) * 2u; }
    const size_t kstep = (size_t)(BK * 2);
    const size_t hstep = (size_t)HALF * K * 2;
    const size_t tstep = 2 * hstep;
    const unsigned ldsw = (unsigned)wid * 1024u;
    const int aoff = lds_byte(wr * 64 + fr, fq * 8), boff = lds_byte(wc * 32 + fr, fq * 8);
#define PG8_SA(b, h) (((b) * 2 + (h)) * HTB)
#define PG8_SB(b, h) ((4 + (b) * 2 + (h)) * HTB)
#define PG8_STAGE(bufoff, gbase, voff) do { _Pragma("unroll") for (int _i = 0; _i < 2; ++_i) \
        __builtin_amdgcn_global_load_lds((const unsigned*)((const char*)(gbase) + (voff)[_i]), (PG8_LAS unsigned*)(lds + (bufoff) + ldsw + _i * 8192), 16, 0, 0); } while (0)
#define PG8_LDA(dst, b, h) do { _Pragma("unroll") for (int m = 0; m < 4; ++m) _Pragma("unroll") for (int k = 0; k < 2; ++k) dst[m][k] = *(const PG8_LAS bf16x8*)(lds + PG8_SA(b, h) + aoff + m * 2048 + k * 1024); } while (0)
#define PG8_LDB(dst, b, h) do { _Pragma("unroll") for (int n = 0; n < 2; ++n) _Pragma("unroll") for (int k = 0; k < 2; ++k) dst[n][k] = *(const PG8_LAS bf16x8*)(lds + PG8_SB(b, h) + boff + n * 2048 + k * 1024); } while (0)
#define PG8_MMA(ai, bj, At, Bt) do { __builtin_amdgcn_s_setprio(1); _Pragma("unroll") for (int m = 0; m < 4; ++m) _Pragma("unroll") for (int n = 0; n < 2; ++n) _Pragma("unroll") for (int k = 0; k < 2; ++k) \
        acc[ai][bj][m][n] = __builtin_amdgcn_mfma_f32_16x16x32_bf16(Bt[n][k], At[m][k], acc[ai][bj][m][n], 0, 0, 0); __builtin_amdgcn_s_setprio(0); } while (0)
#define PG8_WAIT_V(n) asm volatile("s_waitcnt vmcnt(" #n ")" ::: "memory")
#define PG8_WAIT_L(n) asm volatile("s_waitcnt lgkmcnt(" #n ")" ::: "memory")
#define PG8_BAR __builtin_amdgcn_s_barrier()
#define PG8_SCHED __builtin_amdgcn_sched_barrier(0)
    Unit cur, nxt; int ui = 0;
    if (!S.next(0, cur)) return;
    f32x4 acc[2][2][4][2];
#pragma unroll
    for (int a = 0; a < 2; ++a)
#pragma unroll
        for (int b = 0; b < 2; ++b)
#pragma unroll
            for (int m = 0; m < 4; ++m)
#pragma unroll
                for (int n = 0; n < 2; ++n) acc[a][b][m][n] = (f32x4){0.f, 0.f, 0.f, 0.f};
    bf16x8 At[4][2], B0[2][2], B1[2][2];
    const char* cA = (const char*)(cur.prob ? g.A2 : g.A) + (size_t)cur.pm * tstep; const char* cB = (const char*)(cur.prob ? g.Bt2 : g.Bt) + (size_t)cur.pn * tstep;
    S.a_ready(cur);
    if constexpr (SP2) {
        PG8_STAGE(PG8_SB(0, 0), cB, voffB); PG8_STAGE(PG8_SB(0, 1), cB + hstep, voffB); PG8_STAGE(PG8_SA(0, 0), cA, voffA); PG8_STAGE(PG8_SA(0, 1), cA + hstep, voffA);
        if (wr == 1) PG8_BAR;
        PG8_WAIT_V(2); PG8_BAR;
        PG8_STAGE(PG8_SB(1, 0), cB + kstep, voffB); PG8_STAGE(PG8_SA(1, 0), cA + kstep, voffA); PG8_STAGE(PG8_SB(1, 1), cB + hstep + kstep, voffB);
        PG8_WAIT_V(6); PG8_BAR;
    } else {
        PG8_STAGE(PG8_SB(0, 0), cB, voffB); PG8_STAGE(PG8_SA(0, 0), cA, voffA); PG8_STAGE(PG8_SB(0, 1), cB + hstep, voffB); PG8_STAGE(PG8_SA(0, 1), cA + hstep, voffA);
        if (wr == 1) PG8_BAR;
        PG8_WAIT_V(4); PG8_BAR;
        PG8_STAGE(PG8_SB(1, 0), cB + kstep, voffB); PG8_STAGE(PG8_SA(1, 0), cA + kstep, voffA); PG8_STAGE(PG8_SB(1, 1), cB + hstep + kstep, voffB);
        PG8_WAIT_V(6); PG8_BAR;
    }
    for (;;) {
        const bool has_next = S.next(ui + 1, nxt);
        const char* nA = has_next ? (const char*)(nxt.prob ? g.A2 : g.A) + (size_t)nxt.pm * tstep : cA; const char* nB = has_next ? (const char*)(nxt.prob ? g.Bt2 : g.Bt) + (size_t)nxt.pn * tstep : cB;
#define PG8_STAMP(id) do { if (PROBE_A >= 0 && blockIdx.x == 0 && threadIdx.x == 0 && ui == 1 && (Epi::STAMP_BASE + (id) == PROBE_A || Epi::STAMP_BASE + (id) == PROBE_B)) { const unsigned long long t_ = __builtin_amdgcn_s_memrealtime(); \
            volatile PG8_LAS unsigned* M_ = (volatile PG8_LAS unsigned*)(lds + MISC_OFF); const int o_ = (Epi::STAMP_BASE + (id) == PROBE_B) ? 2 : 0; M_[16 + o_] = (unsigned)t_; M_[17 + o_] = (unsigned)(t_ >> 32); } } while (0)
        PG8_STAMP(0);
        for (int t = 0; t < nt; t += 2) {
            const bool last = (t == nt - 2);
            const char* a1 = cA + (size_t)(t + 1) * kstep;
            const char* a2 = last ? nA : cA + (size_t)(t + 2) * kstep; const char* b2 = last ? nB : cB + (size_t)(t + 2) * kstep;
            const char* a3 = a2 + kstep; const char* b3 = b2 + kstep;
            if (last && has_next) S.a_ready(nxt);
            if constexpr (SP2) {
            PG8_LDB(B0, 0, 0); PG8_LDB(B1, 0, 1); PG8_SCHED; PG8_LDA(At, 0, 0); PG8_STAGE(PG8_SA(1, 1), a1 + hstep, voffA);
            PG8_WAIT_V(8); PG8_WAIT_L(0); PG8_BAR; PG8_MMA(0, 0, At, B0); PG8_MMA(0, 1, At, B1); PG8_BAR; PG8_SCHED;
            PG8_LDA(At, 0, 1); PG8_STAGE(PG8_SB(0, 0), b2, voffB); PG8_STAGE(PG8_SB(0, 1), b2 + hstep, voffB); PG8_STAGE(PG8_SA(0, 0), a2, voffA);
            PG8_WAIT_V(8); PG8_WAIT_L(0); PG8_BAR; PG8_MMA(1, 0, At, B0); PG8_MMA(1, 1, At, B1); PG8_BAR; PG8_SCHED;
            PG8_LDB(B0, 1, 0); PG8_LDB(B1, 1, 1); PG8_SCHED; PG8_LDA(At, 1, 0); PG8_STAGE(PG8_SA(0, 1), a2 + hstep, voffA);
            PG8_WAIT_V(8); PG8_WAIT_L(0); PG8_BAR; PG8_MMA(0, 0, At, B0); PG8_MMA(0, 1, At, B1); PG8_BAR; PG8_SCHED;
            PG8_LDA(At, 1, 1); PG8_STAGE(PG8_SB(1, 0), b3, voffB); PG8_STAGE(PG8_SB(1, 1), b3 + hstep, voffB); PG8_STAGE(PG8_SA(1, 0), a3, voffA);
            PG8_WAIT_V(8); PG8_WAIT_L(0); PG8_BAR; PG8_MMA(1, 0, At, B0); PG8_MMA(1, 1, At, B1); PG8_BAR; PG8_SCHED;
            } else {
            PG8_LDB(B0, 0, 0); PG8_SCHED; PG8_LDA(At, 0, 0); PG8_STAGE(PG8_SA(1, 1), a1 + hstep, voffA);
            PG8_WAIT_L(8); PG8_BAR; PG8_WAIT_L(0); PG8_MMA(0, 0, At, B0); PG8_BAR; PG8_SCHED;
            PG8_LDB(B1, 0, 1); PG8_STAGE(PG8_SB(0, 0), b2, voffB);
            PG8_BAR; PG8_WAIT_L(0); PG8_MMA(0, 1, At, B1); PG8_BAR;
            PG8_LDA(At, 0, 1); PG8_STAGE(PG8_SA(0, 0), a2, voffA);
            PG8_BAR; PG8_WAIT_L(0); PG8_MMA(1, 0, At, B0); PG8_BAR; PG8_SCHED;
            PG8_STAGE(PG8_SB(0, 1), b2 + hstep, voffB);
            PG8_WAIT_V(6); PG8_BAR; PG8_MMA(1, 1, At, B1); PG8_BAR;
            PG8_LDB(B0, 1, 0); PG8_SCHED; PG8_LDA(At, 1, 0); PG8_STAGE(PG8_SA(0, 1), a2 + hstep, voffA);
            PG8_WAIT_L(8); PG8_BAR; PG8_WAIT_L(0); PG8_MMA(0, 0, At, B0); PG8_BAR; PG8_SCHED;
            PG8_LDB(B1, 1, 1); PG8_STAGE(PG8_SB(1, 0), b3, voffB);
            PG8_BAR; PG8_WAIT_L(0); PG8_MMA(0, 1, At, B1); PG8_BAR;
            PG8_LDA(At, 1, 1); PG8_STAGE(PG8_SA(1, 0), a3, voffA);
            PG8_BAR; PG8_WAIT_L(0); PG8_MMA(1, 0, At, B0); PG8_BAR; PG8_SCHED;
            PG8_STAGE(PG8_SB(1, 1), b3 + hstep, voffB);
            PG8_WAIT_V(6); PG8_BAR; PG8_MMA(1, 1, At, B1); PG8_BAR;
            }
        }
        PG8_STAMP(1);
        if constexpr (ALIGN_EPI) { if (wr == 0) PG8_BAR; }
        PG8_STAMP(2);
        if constexpr (!Epi::AFTER_DRAIN) { E(acc, cur, wr, wc, fr, fq); S.done(cur); }
        PG8_STAMP(3);
        if (!has_next) break;
#pragma unroll
        for (int a = 0; a < 2; ++a)
#pragma unroll
            for (int b = 0; b < 2; ++b)
#pragma unroll
                for (int m = 0; m < 4; ++m)
#pragma unroll
                    for (int n = 0; n < 2; ++n) acc[a][b][m][n] = (f32x4){0.f, 0.f, 0.f, 0.f};
        cur = nxt; cA = nA; cB = nB; ++ui;
        if constexpr (ALIGN_EPI) { if (wr == 1) PG8_BAR; }
    }
    PG8_WAIT_V(0);
    if constexpr (!ALIGN_EPI) { if (wr == 0) PG8_BAR; }
    PG8_BAR;
    if constexpr (Epi::AFTER_DRAIN) { E.fused(acc, cur, wr, wc, fr, fq, lds, wid, lane); S.done(cur); }
#undef PG8_SA
#undef PG8_SB
#undef PG8_STAGE
#undef PG8_LDA
#undef PG8_LDB
#undef PG8_MMA
#undef PG8_WAIT_V
#undef PG8_WAIT_L
#undef PG8_BAR
#undef PG8_SCHED
}
}

__device__ __forceinline__ float sum16(const float* p) { const f32x4 a = *(const f32x4*)p, b = *(const f32x4*)(p + 4), c = *(const f32x4*)(p + 8), d = *(const f32x4*)(p + 12); const f32x4 t = (a + b) + (c + d); return (t[0] + t[1]) + (t[2] + t[3]); }
__device__ __forceinline__ u32x4 pack8u(const f32x4& a, const f32x4& b) { u32x4 w; w[0] = cvtpk(a[0], a[1]); w[1] = cvtpk(a[2], a[3]); w[2] = cvtpk(b[0], b[1]); w[3] = cvtpk(b[2], b[3]); return w; }
template <int STRIDE>
__device__ __forceinline__ void store_T8s(bf16* t, const u32x4& w) {
#pragma unroll
    for (int e = 0; e < 4; ++e) { t[(size_t)(2 * e) * STRIDE] = (bf16)(w[e] & 0xffffu); t[(size_t)(2 * e + 1) * STRIDE] = (bf16)(w[e] >> 16); }
}
__device__ __forceinline__ void store_T8(bf16* T, size_t chan0, int sq, const u32x4& w) { store_T8s<TS>(T + chan0 * TS + sq, w); }
struct EpiInProj {
    static constexpr bool PERM = true, AFTER_DRAIN = false; static constexpr int STAMP_BASE = -1000;
    bf16* proj; const LAS float* rtab; const LAS int* ptab; const LAS float* ftab; const float* sb_q_g; const float* sb_k_g; bf16* T;
    bf16* memk; bf16* memvT; float* ssqk;
    __device__ __forceinline__ void memkv(const f32x4 (&acc)[2][2][4][2], const pg8::Unit& u, int wr, int wc, int fr_, int fq_) const {
        int fr = fr_, fq = fq_; asm volatile("" : "+v"(fr), "+v"(fq));
#pragma unroll
        for (int ai = 0; ai < 2; ++ai)
#pragma unroll
            for (int m = 0; m < 4; ++m) {
                const int lr = ai * 128 + wr * 64 + m * 16 + fr, gr = u.pm * 256 + lr;
                const float s = rtab[u.idx * 256 + lr];
                if (u.pn < 4) {
                    float ss = 0.f;
#pragma unroll
                    for (int bj = 0; bj < 2; ++bj) {
                        const f32x4 v0 = acc[ai][bj][m][0] * s, v1 = acc[ai][bj][m][1] * s;
                        *(u32x4*)(memk + (size_t)gr * DM + u.pn * 256 + 128 * bj + 32 * wc + 8 * fq) = pack8u(v0, v1);
                        const f32x4 t = v0 * v0 + v1 * v1; ss += (t[0] + t[1]) + (t[2] + t[3]);
                    }
                    ss += __shfl_xor(ss, 16); ss = sum_xor32(ss);
                    if (fq == 0) ssqk[(size_t)gr * 16 + u.pn * 4 + wc] = ss;
                } else {
                    const int b = gr >> 8, key = gr & (MEML - 1);
#pragma unroll
                    for (int bj = 0; bj < 2; ++bj)
                        store_T8s<MEML>(memvT + ((size_t)(b * 4 + u.pn - 4) * 256 + 128 * bj + 32 * wc + 8 * fq) * MEML + key, pack8u(acc[ai][bj][m][0] * s, acc[ai][bj][m][1] * s));
                }
            }
    }
    __device__ __forceinline__ void operator()(const f32x4 (&acc)[2][2][4][2], const pg8::Unit& u, int wr, int wc, int fr_, int fq_) const {
        int fr = fr_, fq = fq_; asm volatile("" : "+v"(fr), "+v"(fq));
        if (u.prob) { memkv(acc, u, wr, wc, fr, fq); return; }
        const int pn = u.pn, seg = pn >> 1, half = pn & 1;
#pragma unroll
        for (int ai = 0; ai < 2; ++ai)
#pragma unroll
            for (int m = 0; m < 4; ++m) {
                const int lr = ai * 128 + wr * 64 + m * 16 + fr, gr = u.pm * 256 + lr, b = gr >> 12, sq = gr & (SEQ - 1);
                const float s = rtab[u.idx * 256 + lr];
                f32x4 a[2][2];
#pragma unroll
                for (int bj = 0; bj < 2; ++bj) { a[bj][0] = acc[ai][bj][m][0] * s; a[bj][1] = acc[ai][bj][m][1] * s; }
                if (seg <= 1) {
                    const int g = 4 * wc + fq;
                    const float posf = (float)ptab[u.idx * 256 + lr];
                    f32x4 cosv, sinv;
#pragma unroll
                    for (int e4 = 0; e4 < 4; ++e4) {
                        const float fhi = ftab[2 * (4 * g + e4)], flo = ftab[2 * (4 * g + e4) + 1];
                        const float ph = posf * fhi, rev = (ph - floorf(ph)) + posf * flo;
                        cosv[e4] = __builtin_amdgcn_cosf(rev); sinv[e4] = __builtin_amdgcn_sinf(rev);
                    }
                    const float eidx = (float)((gr & 127) + 1);
#pragma unroll
                    for (int bj = 0; bj < 2; ++bj) {
                        const int h = 2 * half + bj;
                        const float e = eidx * lg2gamma(h);
                        const float sc = (seg == 0) ? __builtin_amdgcn_exp2f(e) : 0.08838834764831845f * __builtin_amdgcn_exp2f(-e);
                        const f32x4 x = a[bj][0], y = a[bj][1];
                        const f32x4 o1 = (x * cosv - y * sinv) * sc, o2 = (y * cosv + x * sinv) * sc;
                        const u32x4 w = pack8u(o1, o2);
                        *(u32x4*)(proj + (size_t)gr * NPROJ + (seg == 0 ? P_RQ : P_RK) + h * 128 + 8 * g) = w;
                        if (seg == 1) store_T8(T, (size_t)b * NT + TC_RK + h * 128 + 8 * g, sq, w);
                    }
                } else if (seg == 4 || seg == 5) {
                    float ss = 0.f;
#pragma unroll
                    for (int bj = 0; bj < 2; ++bj)
#pragma unroll
                        for (int n = 0; n < 2; ++n) { const f32x4 t = a[bj][n] * a[bj][n]; ss += (t[0] + t[1]) + (t[2] + t[3]); }
                    ss += __shfl_xor(ss, 16); ss = sum_xor32(ss);
                    const float inv = rsqrtf(ss * (1.f / 64.f) + EPS);
                    const int head = 4 * half + wc;
                    const float* gp = (seg == 4 ? sb_q_g : sb_k_g) + head * 64 + 8 * fq;
#pragma unroll
                    for (int bj = 0; bj < 2; ++bj) {
                        const f32x4 g0 = *(const f32x4*)(gp + 32 * bj), g1 = *(const f32x4*)(gp + 32 * bj + 4);
                        const float sc4 = (seg == 4) ? inv * 0.18033688011112042f : inv;
                        const u32x4 w = pack8u(a[bj][0] * g0 * sc4, a[bj][1] * g1 * sc4);
                        *(u32x4*)(proj + (size_t)gr * NPROJ + (seg == 4 ? P_SQ : P_SK) + head * 64 + 32 * bj + 8 * fq) = w;
                    }
                } else if (seg == 3) {
#pragma unroll
                    for (int bj = 0; bj < 2; ++bj) *(u32x4*)(proj + (size_t)gr * NPROJ + P_RG + half * 256 + 128 * bj + 32 * wc + 8 * fq) = pack8u(a[bj][0], a[bj][1]);
                } else {
                    const int chb = (seg == 2 ? TC_RV : TC_SV) + half * 256 + 32 * wc + 8 * fq;
#pragma unroll
                    for (int bj = 0; bj < 2; ++bj) store_T8(T, (size_t)b * NT + chb + 128 * bj, sq, pack8u(a[bj][0], a[bj][1]));
                }
            }
    }
};
template <bool RES_BF16>
struct EpiResid {
    static constexpr bool PERM = true, AFTER_DRAIN = false; static constexpr int STAMP_BASE = -1000;
    const void* resid; bf16* xb; float* ssq;
    __device__ __forceinline__ void operator()(const f32x4 (&acc)[2][2][4][2], const pg8::Unit& u, int wr, int wc, int fr_, int fq_) const {
        int fr = fr_, fq = fq_; asm volatile("" : "+v"(fr), "+v"(fq));
#pragma unroll
        for (int ai = 0; ai < 2; ++ai)
#pragma unroll
            for (int m = 0; m < 4; ++m) {
                const int gr = u.pm * 256 + ai * 128 + wr * 64 + m * 16 + fr;
                float ss = 0.f;
#pragma unroll
                for (int bj = 0; bj < 2; ++bj) {
                    const size_t o = (size_t)gr * DM + u.pn * 256 + 128 * bj + 32 * wc + 8 * fq;
                    f32x4 r0, r1;
                    if (RES_BF16) { const u32x4 rw = *(const u32x4*)((const bf16*)resid + o); r0 = (f32x4){bflo(rw[0]), bfhi(rw[0]), bflo(rw[1]), bfhi(rw[1])}; r1 = (f32x4){bflo(rw[2]), bfhi(rw[2]), bflo(rw[3]), bfhi(rw[3])}; }
                    else { r0 = *(const f32x4*)((const float*)resid + o); r1 = *(const f32x4*)((const float*)resid + o + 4); }
                    const f32x4 v0 = acc[ai][bj][m][0] + r0, v1 = acc[ai][bj][m][1] + r1;
                    *(u32x4*)(xb + o) = pack8u(v0, v1);
                    const f32x4 t = v0 * v0 + v1 * v1; ss += (t[0] + t[1]) + (t[2] + t[3]);
                }
                ss += __shfl_xor(ss, 16); ss = sum_xor32(ss);
                if (fq == 0) ssq[(size_t)gr * 16 + u.pn * 4 + wc] = ss;
            }
    }
};
struct EpiXQ {
    static constexpr bool PERM = true, AFTER_DRAIN = false; static constexpr int STAMP_BASE = -1000;
    bf16* xq; const LAS float* rtab; float* ssqq;
    __device__ __forceinline__ void operator()(const f32x4 (&acc)[2][2][4][2], const pg8::Unit& u, int wr, int wc, int fr_, int fq_) const {
        int fr = fr_, fq = fq_; asm volatile("" : "+v"(fr), "+v"(fq));
#pragma unroll
        for (int ai = 0; ai < 2; ++ai)
#pragma unroll
            for (int m = 0; m < 4; ++m) {
                const int lr = ai * 128 + wr * 64 + m * 16 + fr, gr = u.pm * 256 + lr;
                const float rinv = rtab[u.idx * 256 + lr];
                float ss = 0.f;
#pragma unroll
                for (int bj = 0; bj < 2; ++bj) {
                    const f32x4 v0 = acc[ai][bj][m][0] * rinv, v1 = acc[ai][bj][m][1] * rinv;
                    *(u32x4*)(xq + (size_t)gr * DM + u.pn * 256 + 128 * bj + 32 * wc + 8 * fq) = pack8u(v0, v1);
                    const f32x4 t = v0 * v0 + v1 * v1; ss += (t[0] + t[1]) + (t[2] + t[3]);
                }
                ss += __shfl_xor(ss, 16); ss = sum_xor32(ss);
                if (fq == 0) ssqq[(size_t)gr * 16 + u.pn * 4 + wc] = ss;
            }
    }
};
struct EpiUp {
    static constexpr bool PERM = true, AFTER_DRAIN = false; static constexpr int STAMP_BASE = 40;
    bf16* hid; const LAS float* rtab;
    __device__ __forceinline__ void operator()(const f32x4 (&acc)[2][2][4][2], const pg8::Unit& u, int wr, int wc, int fr_, int fq_) const {
        int fr = fr_, fq = fq_; asm volatile("" : "+v"(fr), "+v"(fq));
#pragma unroll
        for (int ai = 0; ai < 2; ++ai)
#pragma unroll
            for (int m = 0; m < 4; ++m) {
                const int lr = ai * 128 + wr * 64 + m * 16 + fr, gr = u.pm * 256 + lr;
                const float rinv = rtab[u.idx * 256 + lr];
#pragma unroll
                for (int bj = 0; bj < 2; ++bj) {
                    f32x4 v0 = acc[ai][bj][m][0] * rinv, v1 = acc[ai][bj][m][1] * rinv;
#pragma unroll
                    for (int e = 0; e < 4; ++e) { const float t0 = fmaxf(v0[e], 0.f), t1 = fmaxf(v1[e], 0.f); v0[e] = t0 * t0; v1[e] = t1 * t1; }
                    *(u32x4*)(hid + (size_t)gr * FF + u.pn * 256 + 128 * bj + 32 * wc + 8 * fq) = pack8u(v0, v1);
                }
            }
    }
};
struct EpiDown {
    static constexpr bool PERM = true, AFTER_DRAIN = false; static constexpr int STAMP_BASE = -1000;
    const bf16* resid; float* out;
    __device__ __forceinline__ void operator()(const f32x4 (&acc)[2][2][4][2], const pg8::Unit& u, int wr, int wc, int fr_, int fq_) const {
        int fr = fr_, fq = fq_; asm volatile("" : "+v"(fr), "+v"(fq));
#pragma unroll
        for (int ai = 0; ai < 2; ++ai)
#pragma unroll
            for (int m = 0; m < 4; ++m) {
                const int gr = u.pm * 256 + ai * 128 + wr * 64 + m * 16 + fr;
#pragma unroll
                for (int bj = 0; bj < 2; ++bj) {
                    const size_t o = (size_t)gr * DM + u.pn * 256 + 128 * bj + 32 * wc + 8 * fq;
                    const u32x4 rw = *(const u32x4*)(resid + o);
                    const f32x4 r0 = (f32x4){bflo(rw[0]), bfhi(rw[0]), bflo(rw[1]), bfhi(rw[1])}, r1 = (f32x4){bflo(rw[2]), bfhi(rw[2]), bflo(rw[3]), bfhi(rw[3])};
                    __builtin_nontemporal_store(acc[ai][bj][m][0] + r0, (f32x4*)(out + o)); __builtin_nontemporal_store(acc[ai][bj][m][1] + r1, (f32x4*)(out + o + 4));
                }
            }
    }
};
template <class Epi>
__device__ __forceinline__ void gemm_big(const Frame& F, const bf16* A, const bf16* Bt, int N, int K, const Epi& E) {
    pg8::Gemm g{A, Bt, M, N, K, nullptr, nullptr}; pg8::StaticOrder S; S.init(M, N, F.G, F.bid);
    pg8::gemm_phase<Epi, pg8::StaticOrder, true, true>(F.lds, g, S, E);
}

typedef float f32x16 __attribute__((ext_vector_type(16)));
#define MFMA32(a, b, c) __builtin_amdgcn_mfma_f32_32x32x16_bf16((a), (b), (c), 0, 0, 0)
__device__ __forceinline__ bf16x8 pack8(float a0, float a1, float a2, float a3, float a4, float a5, float a6, float a7) {
    u32x4 p; p[0] = cvtpk(a0, a1); p[1] = cvtpk(a2, a3); p[2] = cvtpk(a4, a5); p[3] = cvtpk(a6, a7);
    return __builtin_bit_cast(bf16x8, p);
}
constexpr int SBK_SLOT = 32 * 144, SBV_ROW = 17 * 64 + 16, SBV_OFF = 17 * SBK_SLOT;
__device__ __forceinline__ void sb_mfma(const Frame& F, const bf16* proj, const bf16* T, bf16* mix) {
    const int tid = opaque_tid(), lane = tid & 63, r = lane & 31, hh = lane >> 5, w = F.wave;
    const int kr = (r & ~12) | ((r & 4) << 1) | ((r & 8) >> 1);
    const float c1 = 0.18033688011112042f;
    LAS unsigned char* L = F.lds;
    for (int u = F.bid; u < BATCH * 8 * 8; u += F.G) {
        const int qblk = 7 - (u & 7), hd = (u >> 3) & 7, b = u >> 6;
        const int q0g = qblk * 512, tg = q0g >> 5;
        const float gq = wave_max(fabsf(F.sb_q_g[hd * 64 + lane])), gk = wave_max(fabsf(F.sb_k_g[hd * 64 + lane]));
        const float thresh = 152.f + c1 * 64.f * gq * gk * 1.02f;
        const bf16* kgu = proj + (size_t)b * SEQ * NPROJ + P_SK + hd * 64;
        const bf16* vgu = T + ((size_t)b * NT + TC_SV + hd * 64) * TS;
        const int ldrow = (tid & 255) >> (tid < 256 ? 3 : 2), ldch = (tid & 255) & (tid < 256 ? 7 : 3);
#define SB_TLOAD(ti) ((tid < 256) ? *(const u32x4*)(kgu + (size_t)((ti) * 32 + ldrow) * NPROJ + ldch * 8) : *(const u32x4*)(vgu + (size_t)ldrow * TS + (ti) * 32 + ldch * 8))
#define SB_TWRITE(ti, val) do { const int sl_ = (ti) % 17; if (tid < 256) *(LAS u32x4*)(L + sl_ * SBK_SLOT + ldrow * 144 + ldch * 16) = (val); \
                                else *(LAS u32x4*)(L + SBV_OFF + ldrow * SBV_ROW + sl_ * 64 + ldch * 16) = (val); } while (0)
        {
            u32x4 pv[16];
#pragma unroll
            for (int i = 0; i < 16; ++i) pv[i] = SB_TLOAD(tg + i);
#pragma unroll
            for (int i = 0; i < 16; ++i) SB_TWRITE(tg + i, pv[i]);
        }
        bf16x8 qf[2][4];
#pragma unroll
        for (int g = 0; g < 2; ++g) {
            const bf16* qp = proj + ((size_t)b * SEQ + q0g + 64 * w + 32 * g + r) * NPROJ + P_SQ + hd * 64 + 8 * hh;
#pragma unroll
            for (int s = 0; s < 4; ++s) qf[g][s] = *(const bf16x8*)(qp + 16 * s);
        }
        __syncthreads();
        f32x16 o[2][2];
#pragma unroll
        for (int g = 0; g < 2; ++g)
#pragma unroll
            for (int n = 0; n < 2; ++n)
#pragma unroll
                for (int i = 0; i < 16; ++i) o[g][n][i] = 0.f;
        float carry[2] = {0.f, 0.f}, cprod[2] = {1.f, 1.f};
        bool done0 = false, done1 = false;
        for (int st = 0;; ++st) {
            const int tnew = tg - st - 1;
            const bool more = tnew >= 0;
            u32x4 nv;
            if (more) nv = SB_TLOAD(tnew);
#pragma unroll
            for (int g = 0; g < 2; ++g) {
                const int ti = tg + 2 * w + g - st;
                bool& done = g ? done1 : done0;
                if (!done && ti >= 0) {
                    const int sl = ti % 17;
                    LAS unsigned char* kb = L + sl * SBK_SLOT + kr * 144 + 16 * hh;
                    LAS unsigned char* vb = L + SBV_OFF + r * SBV_ROW + sl * 64 + 16 * hh;
                    bf16x8 kf[4], vf[4];
#pragma unroll
                    for (int s = 0; s < 4; ++s) kf[s] = *(LAS bf16x8*)(kb + 32 * s);
#pragma unroll
                    for (int n = 0; n < 2; ++n)
#pragma unroll
                        for (int ks = 0; ks < 2; ++ks) vf[2 * n + ks] = *(LAS bf16x8*)(vb + (32 * n) * SBV_ROW + 32 * ks);
                    f32x16 x;
#pragma unroll
                    for (int i = 0; i < 16; ++i) x[i] = 0.f;
#pragma unroll
                    for (int s = 0; s < 4; ++s) x = MFMA32(kf[s], qf[g][s], x);
                    const bool diag = (st == 0);
                    f32x16 ee, rr;
#pragma unroll
                    for (int i = 0; i < 16; ++i) {
                        const int key = 16 * (i >> 3) + 8 * hh + (i & 7);
                        const float t = (diag && !(key < r)) ? -1e30f : x[i];
                        ee[i] = __builtin_amdgcn_exp2f(t);
                        rr[i] = __builtin_amdgcn_rcpf(1.f + ee[i]);
                    }
#pragma unroll
                    for (int gg = 0; gg < 2; ++gg)
#pragma unroll
                        for (int e = 6; e >= 0; --e) rr[8 * gg + e] *= rr[8 * gg + e + 1];
                    const float tlo = rr[0], thi = rr[8], plo = get_xor32(tlo, hh), phi = get_xor32(thi, hh);
                    const float cp = cprod[g];
                    const float blo = cp * (hh == 0 ? (plo * thi) * phi : phi * thi), bhi = hh == 0 ? cp * phi : cp;
                    const float lown = __builtin_amdgcn_logf(tlo) + __builtin_amdgcn_logf(thi);
                    carry[g] -= sum_xor32(lown);
                    cprod[g] = cp * ((tlo * plo) * (thi * phi));
#pragma unroll
                    for (int i = 0; i < 16; ++i) x[i] = ee[i] * ((i < 8 ? blo : bhi) * rr[i]);
#pragma unroll
                    for (int ks = 0; ks < 2; ++ks) {
                        const bf16x8 pf = pack8(x[8 * ks], x[8 * ks + 1], x[8 * ks + 2], x[8 * ks + 3], x[8 * ks + 4], x[8 * ks + 5], x[8 * ks + 6], x[8 * ks + 7]);
                        o[g][0] = MFMA32(pf, vf[ks], o[g][0]);
                        o[g][1] = MFMA32(pf, vf[2 + ks], o[g][1]);
                    }
                    if (ti == 0 || __all(carry[g] > thresh)) done = true;
                } else done = true;
            }
            if (more) SB_TWRITE(tnew, nv);
            const int alldone = __syncthreads_and((done0 && done1) ? 1 : 0);
            if (alldone) break;
        }
#undef SB_TLOAD
#undef SB_TWRITE
        LAS bf16* os = (LAS bf16*)(L + w * (64 * 144));
#pragma unroll
        for (int g = 0; g < 2; ++g)
#pragma unroll
            for (int i = 0; i < 16; ++i) {
                const int qr = 32 * g + (i & 3) + 8 * (i >> 2) + 4 * hh;
                os[qr * 72 + r] = (bf16)f2bf(o[g][0][i]);
                os[qr * 72 + 32 + r] = (bf16)f2bf(o[g][1][i]);
            }
        CBAR();
        int lane2 = lane; asm volatile("" : "+v"(lane2));
#pragma unroll
        for (int i = 0; i < 8; ++i) {
            const int id = i * 64 + lane2, row = id >> 3, ch = id & 7;
            *(u32x4*)(mix + ((size_t)b * SEQ + q0g + 64 * w + row) * DM + 512 + hd * 64 + ch * 8) = *(LAS u32x4*)(os + row * 72 + ch * 8);
        }
        __syncthreads();
    }
}

__device__ __forceinline__ void ret_kv(const Frame& F, const bf16* T, bf16* KVs) {
    const int tid = opaque_tid(), lane = tid & 63, r = lane & 31, hh = lane >> 5, mt = F.wave >> 1, nt0 = (F.wave & 1) * 2;
    LAS unsigned char* L = F.lds;
    for (int u0 = F.bid; u0 < BATCH * 4 * 32; u0 += 2 * F.G) {
        u32x4 sk[2][4], sv[2][4];
#pragma unroll
        for (int j = 0; j < 2; ++j) {
            const int u = min(u0 + j * F.G, BATCH * 4 * 32 - 1), c = u & 31, h = (u >> 5) & 3, b = u >> 7;
            const bf16* kp = T + ((size_t)b * NT + TC_RK + h * 128) * TS + c * 128;
            const bf16* vp = T + ((size_t)b * NT + TC_RV + h * 128) * TS + c * 128;
#pragma unroll
            for (int i = 0; i < 4; ++i) { const int id = i * NTHR + tid, row = id >> 4, ch = id & 15; sk[j][i] = *(const u32x4*)(kp + (size_t)row * TS + ch * 8); sv[j][i] = *(const u32x4*)(vp + (size_t)row * TS + ch * 8); }
        }
        __syncthreads();
#pragma unroll
        for (int j = 0; j < 2; ++j)
#pragma unroll
            for (int i = 0; i < 4; ++i) { const int id = i * NTHR + tid, row = id >> 4, ch = id & 15; *(LAS u32x4*)(L + j * 69632 + row * 272 + ch * 16) = sk[j][i]; *(LAS u32x4*)(L + j * 69632 + 34816 + row * 272 + ch * 16) = sv[j][i]; }
        __syncthreads();
#pragma unroll
        for (int j = 0; j < 2; ++j) {
            const int u = u0 + j * F.G;
            if (u < BATCH * 4 * 32) {
                const int h = (u >> 5) & 3;
                LAS unsigned char* vb = L + j * 69632 + 34816 + (32 * mt + r) * 272 + 16 * hh;
                LAS unsigned char* kb = L + j * 69632 + (32 * nt0 + r) * 272 + 16 * hh;
                f32x16 a0, a1;
#pragma unroll
                for (int i = 0; i < 16; ++i) { a0[i] = 0.f; a1[i] = 0.f; }
                bf16x8 vf[8], k0f[8], k1f[8];
#pragma unroll
                for (int ks = 0; ks < 8; ++ks) { vf[ks] = *(LAS bf16x8*)(vb + 32 * ks); k0f[ks] = *(LAS bf16x8*)(kb + 32 * ks); k1f[ks] = *(LAS bf16x8*)(kb + 32 * 272 + 32 * ks); }
#pragma unroll
                for (int ks = 0; ks < 8; ++ks) { a0 = MFMA32(vf[ks], k0f[ks], a0); a1 = MFMA32(vf[ks], k1f[ks], a1); }
                const float g128 = __builtin_amdgcn_exp2f(128.f * lg2gamma(h));
                bf16* op = KVs + (size_t)u * 16384 + (size_t)(32 * mt + 4 * hh) * 128 + 32 * nt0 + r;
#pragma unroll
                for (int i = 0; i < 16; ++i) { const int row = (i & 3) + 8 * (i >> 2); op[row * 128] = (bf16)f2bf(a0[i] * g128); op[row * 128 + 32] = (bf16)f2bf(a1[i] * g128); }
            }
        }
    }
    __syncthreads();
}
__device__ __forceinline__ void memk_norm(const Frame& F, bf16* memk, const float* ssqk) {
    const int gw = F.bid * NWAVES + F.wave, GW = F.G * NWAVES;
    for (int r = gw; r < MROWS; r += GW) {
#pragma unroll
        for (int i = 0; i < 2; ++i) {
            const int c = i * 512 + F.lane * 8, h = c >> 8;
            const f32x4 pq = *(const f32x4*)(ssqk + (size_t)r * 16 + h * 4);
            const float sc = rsqrtf(((pq[0] + pq[1]) + (pq[2] + pq[3])) * (1.f / 256.f) + EPS);
            const u32x4 v = *(const u32x4*)(memk + (size_t)r * DM + c);
            const f32x4 g0 = *(const f32x4*)(F.xk_g + c), g1 = *(const f32x4*)(F.xk_g + c + 4);
            u32x4 w;
            w[0] = pk2(bflo(v[0]) * sc * g0[0], bfhi(v[0]) * sc * g0[1]); w[1] = pk2(bflo(v[1]) * sc * g0[2], bfhi(v[1]) * sc * g0[3]);
            w[2] = pk2(bflo(v[2]) * sc * g1[0], bfhi(v[2]) * sc * g1[1]); w[3] = pk2(bflo(v[3]) * sc * g1[2], bfhi(v[3]) * sc * g1[3]);
            *(u32x4*)(memk + (size_t)r * DM + c) = w;
        }
    }
}
__device__ __forceinline__ void ret_scan(const Frame& F, bf16* KVs, int wb, int nwb) {
    for (int it = (F.bid - wb) * NTHR + F.tid; it < 16 * 8192; it += nwb * NTHR) {
        const int bh = it >> 13, e2 = (it & 8191) * 2;
        const float g128 = __builtin_amdgcn_exp2f(128.f * lg2gamma(bh & 3));
        bf16* p = KVs + (size_t)bh * 32 * 16384 + e2;
        float s0 = 0.f, s1 = 0.f;
#pragma unroll 1
        for (int cb = 0; cb < 2; ++cb) {
            unsigned t[16];
#pragma unroll
            for (int c = 0; c < 16; ++c) t[c] = *(const unsigned*)(p + (size_t)(cb * 16 + c) * 16384);
#pragma unroll
            for (int c = 0; c < 16; ++c) { *(unsigned*)(p + (size_t)(cb * 16 + c) * 16384) = cvtpk(s0, s1); s0 = s0 * g128 + bflo(t[c]); s1 = s1 * g128 + bfhi(t[c]); }
        }
    }
}
constexpr int RO_ROW = 272, RO_ST = 0, RO_KT = 128 * RO_ROW, RO_VT = 2 * 128 * RO_ROW, RO_OS = 3 * 128 * RO_ROW, RO_OSW = 32 * 144, RO_SS = RO_OS + 8 * RO_OSW;
__device__ __forceinline__ void ret_out(const Frame& F, const bf16* proj, const bf16* T, const bf16* KVs, bf16* mix) {
    const int tid = F.tid, lane = F.lane, r = lane & 31, hh = lane >> 5, qg = F.wave >> 1, dh = F.wave & 1;
    const int kr = (r & ~12) | ((r & 4) << 1) | ((r & 8) >> 1);
    LAS unsigned char* L = F.lds;
    LAS float* ssx = (LAS float*)(L + RO_SS);
    for (int u = F.bid; u < BATCH * 4 * 32; u += F.G) {
        const int c = u & 31, h = (u >> 5) & 3, b = u >> 7, q0 = c * 128 + 32 * qg;
        u32x4 sst[4], skt[4], svt[4];
        {
            const bf16* sp = KVs + (size_t)u * 16384;
#pragma unroll
            for (int i = 0; i < 4; ++i) sst[i] = *(const u32x4*)(sp + (size_t)(i * NTHR + tid) * 8);
            const bf16* kp = proj + ((size_t)b * SEQ + c * 128) * NPROJ + P_RK + h * 128;
            const bf16* vp = T + ((size_t)b * NT + TC_RV + h * 128) * TS + c * 128;
#pragma unroll
            for (int i = 0; i < 4; ++i) { const int id = i * NTHR + tid, row = id >> 4, ch = id & 15; skt[i] = *(const u32x4*)(kp + (size_t)row * NPROJ + ch * 8); svt[i] = *(const u32x4*)(vp + (size_t)row * TS + ch * 8); }
        }
        bf16x8 qf[8];
        {
            const bf16* qp = proj + ((size_t)b * SEQ + q0 + r) * NPROJ + P_RQ + h * 128 + 8 * hh;
#pragma unroll
            for (int s = 0; s < 8; ++s) qf[s] = *(const bf16x8*)(qp + 16 * s);
        }
#pragma unroll
        for (int i = 0; i < 4; ++i) { const int id = i * NTHR + tid, row = id >> 4, ch = id & 15; *(LAS u32x4*)(L + RO_ST + row * RO_ROW + ch * 16) = sst[i]; }
#pragma unroll
        for (int i = 0; i < 4; ++i) { const int id = i * NTHR + tid, row = id >> 4, ch = id & 15; *(LAS u32x4*)(L + RO_KT + row * RO_ROW + ch * 16) = skt[i]; *(LAS u32x4*)(L + RO_VT + row * RO_ROW + ch * 16) = svt[i]; }
        __syncthreads();
        f32x16 o[2];
#pragma unroll
        for (int n = 0; n < 2; ++n)
#pragma unroll
            for (int i = 0; i < 16; ++i) o[n][i] = 0.f;
        {
            LAS unsigned char* sb_ = L + RO_ST + (32 * (2 * dh) + r) * RO_ROW + 16 * hh;
            bf16x8 sf[2][4];
#pragma unroll
            for (int jq = 0; jq < 4; ++jq) sf[0][jq] = *(LAS bf16x8*)(sb_ + (32 * (jq & 1)) * RO_ROW + 32 * (jq >> 1));
#pragma unroll
            for (int g = 0; g < 4; ++g) {
                if (g < 3) {
#pragma unroll
                    for (int jq = 0; jq < 4; ++jq) sf[(g + 1) & 1][jq] = *(LAS bf16x8*)(sb_ + (32 * (jq & 1)) * RO_ROW + 32 * (2 * (g + 1) + (jq >> 1)));
                }
                __builtin_amdgcn_sched_barrier(0);
#pragma unroll
                for (int jq = 0; jq < 4; ++jq) o[jq & 1] = MFMA32(qf[2 * g + (jq >> 1)], sf[g & 1][jq], o[jq & 1]);
                __builtin_amdgcn_sched_barrier(0);
            }
        }
        for (int kt = 0; kt <= qg; ++kt) {
            f32x16 x;
#pragma unroll
            for (int i = 0; i < 16; ++i) x[i] = 0.f;
            LAS unsigned char* kb = L + RO_KT + (32 * kt + kr) * RO_ROW + 16 * hh;
            LAS unsigned char* vb = L + RO_VT + (32 * (2 * dh) + r) * RO_ROW + (32 * kt + 8 * hh) * 2;
            bf16x8 kf[2][4], vf[4];
#pragma unroll
            for (int jq = 0; jq < 4; ++jq) kf[0][jq] = *(LAS bf16x8*)(kb + 32 * jq);
#pragma unroll
            for (int jq = 0; jq < 4; ++jq) kf[1][jq] = *(LAS bf16x8*)(kb + 32 * (4 + jq));
            __builtin_amdgcn_sched_barrier(0);
#pragma unroll
            for (int jq = 0; jq < 4; ++jq) x = MFMA32(kf[0][jq], qf[jq], x);
#pragma unroll
            for (int jq = 0; jq < 4; ++jq) vf[jq] = *(LAS bf16x8*)(vb + (32 * (jq & 1)) * RO_ROW + 32 * (jq >> 1));
            __builtin_amdgcn_sched_barrier(0);
#pragma unroll
            for (int jq = 0; jq < 4; ++jq) x = MFMA32(kf[1][jq], qf[4 + jq], x);
            __builtin_amdgcn_sched_barrier(0);
            if (kt == qg) {
#pragma unroll
                for (int i = 0; i < 16; ++i) { const int key = 16 * (i >> 3) + 8 * hh + (i & 7); x[i] = (key <= r) ? x[i] : 0.f; }
            }
#pragma unroll
            for (int ks = 0; ks < 2; ++ks) {
                const bf16x8 pf = pack8(x[8 * ks], x[8 * ks + 1], x[8 * ks + 2], x[8 * ks + 3], x[8 * ks + 4], x[8 * ks + 5], x[8 * ks + 6], x[8 * ks + 7]);
#pragma unroll
                for (int n = 0; n < 2; ++n) o[n] = MFMA32(pf, vf[2 * ks + n], o[n]);
            }
        }
        float ssr[16];
#pragma unroll
        for (int i = 0; i < 16; ++i) {
            float ss = o[0][i] * o[0][i] + o[1][i] * o[1][i];
            ss += __shfl_xor(ss, 1); ss += __shfl_xor(ss, 2); ss += __shfl_xor(ss, 4); ss += __shfl_xor(ss, 8); ss += __shfl_xor(ss, 16);
            ssr[i] = ss;
            if (r == 0) ssx[F.wave * 32 + (i & 3) + 8 * (i >> 2) + 4 * hh] = ss;
        }
        __syncthreads();
        LAS bf16* os = (LAS bf16*)(L + RO_OS + F.wave * RO_OSW);
#pragma unroll
        for (int i = 0; i < 16; ++i) {
            const int qr = (i & 3) + 8 * (i >> 2) + 4 * hh;
            const float inv = rsqrtf((ssr[i] + ssx[(F.wave ^ 1) * 32 + qr]) * (1.f / 128.f) + EPS);
            const size_t row = (size_t)b * SEQ + q0 + qr;
#pragma unroll
            for (int n = 0; n < 2; ++n) {
                const int dv = h * 128 + 64 * dh + 32 * n + r;
                const float g = bf2f(proj[row * NPROJ + P_RG + dv]);
                os[qr * 72 + 32 * n + r] = (bf16)f2bf(o[n][i] * inv * F.ret_gn_g[dv] * (g / (1.f + __expf(-g))));
            }
        }
        CBAR();
#pragma unroll
        for (int i = 0; i < 4; ++i) {
            const int id = i * 64 + lane, row = id >> 3, ch = id & 7;
            *(u32x4*)(mix + ((size_t)b * SEQ + q0 + row) * DM + h * 128 + 64 * dh + ch * 8) = *(LAS u32x4*)(os + row * 72 + ch * 8);
        }
    }
}

constexpr int XK_ROW = 528, XV_ROW = 80, XV_OFF = 32 * XK_ROW, XBUF = XV_OFF + 256 * XV_ROW, XOS = 2 * XBUF, XOSW = 32 * 272;
__device__ __forceinline__ void xattn_mfma(const Frame& F, const bf16* xq, const float* ssqq, const bf16* memk, const bf16* memvT, bf16* xo) {
    const int tid = F.tid, lane = F.lane, r = lane & 31, hh = lane >> 5, qg = F.wave >> 1, dh = F.wave & 1;
    const int kr = (r & ~12) | ((r & 4) << 1) | ((r & 8) >> 1);
    const int kl = (tid >> 5) * XK_ROW + (tid & 31) * 16, vl = XV_OFF + (tid >> 2) * XV_ROW + (tid & 3) * 16;
    LAS bf16* os = (LAS bf16*)(F.lds + XOS + F.wave * XOSW);
    for (int ui = 0; (ui >> 1) * F.G + F.bid < 256; ++ui) {
        int gpm, gpn;
        { const int Lw = (ui >> 1) * F.G + F.bid, wg = (Lw & 7) * 32 + (Lw >> 3), fm = (wg >> 5) * 8; gpm = fm + ((wg & 31) & 7); gpn = (wg & 31) >> 3; }
        const int qblk = (gpm & 15) * 2 + (ui & 1), h = gpn, b = gpm >> 4, q0 = qblk * 128 + 32 * qg;
        const bf16* kgu = memk + (size_t)b * MEML * DM + h * 256;
        const bf16* vgu = memvT + (size_t)(b * 4 + h) * 256 * MEML;
        const unsigned koff = (unsigned)((tid >> 5) * DM + (tid & 31) * 8), voff = (unsigned)((tid >> 2) * MEML + (tid & 3) * 8);
        u32x4 sa[4];
#define XLOAD(S, kt) do { const bf16* kg_ = kgu + (size_t)(kt) * 32 * DM; const bf16* vg_ = vgu + (kt) * 32; \
        S[0] = *(const u32x4*)(kg_ + koff); S[1] = *(const u32x4*)(kg_ + 16 * DM + koff); S[2] = *(const u32x4*)(vg_ + voff); S[3] = *(const u32x4*)(vg_ + 128 * MEML + voff); } while (0)
#define XWRITE(S, bufp) do { *(LAS u32x4*)((bufp) + kl) = S[0]; *(LAS u32x4*)((bufp) + kl + 16 * XK_ROW) = S[1]; *(LAS u32x4*)((bufp) + vl) = S[2]; *(LAS u32x4*)((bufp) + vl + 128 * XV_ROW) = S[3]; } while (0)
        XLOAD(sa, 0);
        bf16x8 qf[16];
        {
            const size_t grow = (size_t)b * SEQ + q0 + r;
            const f32x4 pq = *(const f32x4*)(ssqq + grow * 16 + h * 4);
            const bf16* qp = xq + grow * DM + h * 256 + 8 * hh;
            const float* gp = F.xq_g + h * 256 + 8 * hh;
            const float sc = rsqrtf(((pq[0] + pq[1]) + (pq[2] + pq[3])) * (1.f / 256.f) + EPS) * 0.09016844005556021f;
#pragma unroll
            for (int s = 0; s < 16; ++s) {
                const u32x4 v = *(const u32x4*)(qp + 16 * s);
                const f32x4 g0 = *(const f32x4*)(gp + 16 * s), g1 = *(const f32x4*)(gp + 16 * s + 4);
                qf[s] = pack8(bflo(v[0]) * sc * g0[0], bfhi(v[0]) * sc * g0[1], bflo(v[1]) * sc * g0[2], bfhi(v[1]) * sc * g0[3],
                              bflo(v[2]) * sc * g1[0], bfhi(v[2]) * sc * g1[1], bflo(v[3]) * sc * g1[2], bfhi(v[3]) * sc * g1[3]);
                if ((s & 3) == 3) __builtin_amdgcn_sched_barrier(0);
            }
        }
        XWRITE(sa, F.lds);
        __syncthreads();
        f32x16 o[4];
#pragma unroll
        for (int n = 0; n < 4; ++n)
#pragma unroll
            for (int i = 0; i < 16; ++i) o[n][i] = 0.f;
        float m = 0.f, l = 0.f;
#pragma unroll 1
        for (int kt = 0; kt < 8; ++kt) {
            LAS unsigned char* buf = F.lds + (kt & 1) * XBUF;
            LAS unsigned char* kb = buf + kr * XK_ROW + 16 * hh;
            LAS unsigned char* vb = buf + XV_OFF + (32 * (4 * dh) + r) * XV_ROW + 16 * hh;
            if (kt < 7) XLOAD(sa, kt + 1);
            f32x16 x;
#pragma unroll
            for (int i = 0; i < 16; ++i) x[i] = 0.f;
            bf16x8 kf[2][4], vf[2][4];
#pragma unroll
            for (int jq = 0; jq < 4; ++jq) kf[0][jq] = *(LAS bf16x8*)(kb + 32 * jq);
#pragma unroll
            for (int g = 0; g < 4; ++g) {
                if (g < 3) {
#pragma unroll
                    for (int jq = 0; jq < 4; ++jq) kf[(g + 1) & 1][jq] = *(LAS bf16x8*)(kb + 32 * (4 * (g + 1) + jq));
                } else {
#pragma unroll
                    for (int n = 0; n < 4; ++n) vf[0][n] = *(LAS bf16x8*)(vb + (32 * n) * XV_ROW);
                }
                __builtin_amdgcn_sched_barrier(0);
#pragma unroll
                for (int jq = 0; jq < 4; ++jq) x = MFMA32(kf[g & 1][jq], qf[4 * g + jq], x);
                __builtin_amdgcn_sched_barrier(0);
            }
            float tmax = x[0];
#pragma unroll
            for (int i = 1; i < 16; ++i) tmax = fmaxf(tmax, x[i]);
            tmax = max_xor32(tmax);
            if (kt == 0) m = tmax;
            else if (__any(tmax > m + 8.f)) {
                const float mn = fmaxf(m, tmax), alpha = __builtin_amdgcn_exp2f(m - mn);
                m = mn; l *= alpha;
#pragma unroll
                for (int i = 0; i < 16; ++i) {
                    const float ai = __shfl(alpha, (i & 3) + 8 * (i >> 2) + 4 * hh);
#pragma unroll
                    for (int n = 0; n < 4; ++n) o[n][i] *= ai;
                }
            }
            float ps = 0.f;
#pragma unroll
            for (int i = 0; i < 16; ++i) { x[i] = __builtin_amdgcn_exp2f(x[i] - m); ps += x[i]; }
            ps = sum_xor32(ps);
            l += ps;
#pragma unroll
            for (int n = 0; n < 4; ++n) vf[1][n] = *(LAS bf16x8*)(vb + (32 * n) * XV_ROW + 32);
            __builtin_amdgcn_sched_barrier(0);
#pragma unroll
            for (int ks = 0; ks < 2; ++ks) {
                const bf16x8 pf = pack8(x[8 * ks], x[8 * ks + 1], x[8 * ks + 2], x[8 * ks + 3], x[8 * ks + 4], x[8 * ks + 5], x[8 * ks + 6], x[8 * ks + 7]);
#pragma unroll
                for (int n = 0; n < 4; ++n) o[n] = MFMA32(pf, vf[ks][n], o[n]);
            }
            if (kt < 7) { LAS unsigned char* nb = F.lds + ((kt + 1) & 1) * XBUF; XWRITE(sa, nb); }
            __syncthreads();
        }
#undef XLOAD
#undef XWRITE
        const float linv = 1.f / l;
        CBAR();
#pragma unroll
        for (int i = 0; i < 16; ++i) {
            const int qr = (i & 3) + 8 * (i >> 2) + 4 * hh;
            const float li = __shfl(linv, qr);
#pragma unroll
            for (int n = 0; n < 4; ++n) os[qr * 136 + 32 * n + r] = (bf16)f2bf(o[n][i] * li);
        }
        CBAR();
        int lane2 = lane, wv2 = F.wave; asm volatile("" : "+v"(lane2), "+s"(wv2));
        const int q02 = qblk * 128 + 32 * (wv2 >> 1), dh2 = wv2 & 1;
#pragma unroll
        for (int i = 0; i < 8; ++i) {
            const int id = i * 64 + lane2, row = id >> 4, ch = id & 15;
            *(u32x4*)(xo + ((size_t)b * SEQ + q02 + row) * DM + h * 256 + 128 * dh2 + ch * 8) = *(LAS u32x4*)(os + row * 136 + ch * 8);
        }
        CBAR();
    }
}

__global__ void __launch_bounds__(NTHR, 2) fwd_kernel(Args args) {
    extern __shared__ __attribute__((aligned(16))) unsigned char lds_raw[];
    Frame F;
    F.lds = (LAS unsigned char*)lds_raw;
    F.tid = threadIdx.x; F.lane = F.tid & 63; F.wave = __builtin_amdgcn_readfirstlane(F.tid >> 6);
    F.G = gridDim.x; F.bid = blockIdx.x;
    F.x = (const float*)args.in[0]; F.mem = (const float*)args.in[1]; F.pos = (const int*)args.in[2];
    F.g_mix = (const float*)args.in[3]; F.w_in = (const float*)args.in[4]; F.ret_gn_g = (const float*)args.in[5];
    F.sb_q_g = (const float*)args.in[6]; F.sb_k_g = (const float*)args.in[7]; F.w_out = (const float*)args.in[8];
    F.g_xattn = (const float*)args.in[9]; F.g_mem = (const float*)args.in[10]; F.w_xq = (const float*)args.in[11];
    F.w_xkv = (const float*)args.in[12]; F.xq_g = (const float*)args.in[13]; F.xk_g = (const float*)args.in[14];
    F.w_xo = (const float*)args.in[15]; F.g_mlp = (const float*)args.in[16]; F.w_up = (const float*)args.in[17]; F.w_down = (const float*)args.in[18];
    F.out = args.out; F.ws = args.ws;
    unsigned char* ws = args.ws;
    volatile LAS unsigned* MISC = (volatile LAS unsigned*)(F.lds + MISC_OFF);
    if (F.tid < 64) MISC[F.tid] = 0u;
    __syncthreads();
    XcdBarrier bar; bar.bar = (unsigned*)(ws + WS_CTL) + 1024 + args.li * 4096; bar.x = 0; bar.st = nullptr;
    if (MK_N_LAUNCHES != NPHASE) bar = xcd_barrier_post(bar.bar, MISC + 8);
#define GRID_BAR() do { if (MK_N_LAUNCHES != NPHASE) xcd_barrier(bar); } while (0)
    const int lo = args.ph_lo, hi = args.ph_hi;
#define IN(k) (lo <= (k) && (k) < hi)
#define BOTH(k) (IN(k) && IN((k) + 1))
#define STAMP(k) STAMPF(F, k)

    bf16* Wt_in = (bf16*)(ws + WS_WIN); bf16* Wt_out = (bf16*)(ws + WS_WOUT); bf16* Wt_xq = (bf16*)(ws + WS_WXQ); bf16* Wt_xkv = (bf16*)(ws + WS_WXKV);
    bf16* Wt_xo = (bf16*)(ws + WS_WXO); bf16* Wt_up = (bf16*)(ws + WS_WUP); bf16* Wt_dn = (bf16*)(ws + WS_WDN);
    float* rinv1 = (float*)(ws + WS_RINV1); float* rinvm = (float*)(ws + WS_RINVM); float* ssq2 = (float*)(ws + WS_SSQ2); float* ssq3 = (float*)(ws + WS_SSQ3); float* ssqq = (float*)(ws + WS_SSQQ); float* ssqk = (float*)(ws + WS_SSQK);
    bf16* memb = (bf16*)(ws + WS_MEMB); bf16* memk = (bf16*)(ws + WS_MEMK); bf16* memvT = (bf16*)(ws + WS_MEMV);
    float2* cs = (float2*)(ws + WS_ROPE);
    bf16* xb = (bf16*)F.out; bf16* mix = (bf16*)(ws + WS_MIX);     bf16* proj = (bf16*)(ws + WS_PROJ);
    bf16* x1b = (bf16*)(ws + WS_X1B); bf16* xq = (bf16*)(ws + WS_XQ); bf16* xo = (bf16*)(ws + WS_XO); bf16* x2b = (bf16*)(ws + WS_X2B); bf16* hid = (bf16*)(ws + WS_HID); bf16* T = (bf16*)(ws + WS_T); bf16* KVs = (bf16*)(ws + WS_KVS);

    STAMP(0); F.tid = opaque_tid(); F.lane = F.tid & 63;
    if (IN(0)) {
#pragma nounroll
        for (int rep = 0; rep < (((PROBE_MASK >> 0) & 1) ? 2 : 1); ++rep) {
            if (rep) GRID_BAR();
            if (F.G == 256) p0_fused(F, Wt_in, Wt_out, Wt_xq, Wt_xkv, Wt_xo, Wt_up, Wt_dn, xb, rinv1, memb, rinvm, cs);
            else {
                conv_weights(F, Wt_in, Wt_out, Wt_xq, Wt_xkv, Wt_xo, Wt_up, Wt_dn);
                rows_prep(F, F.x, xb, rinv1, M);
                rows_prep(F, F.mem, memb, rinvm, MROWS);
                rope_table(F, cs);
            }
        }
        if (BOTH(0)) GRID_BAR();
    }
    STAMP(1); F.tid = opaque_tid(); F.lane = F.tid & 63;
    if (IN(1)) {
#pragma nounroll
        for (int rep = 0; rep < (((PROBE_MASK >> 1) & 1) ? 2 : 1); ++rep) {
            if (rep) GRID_BAR();
            LAS float* rtab = (LAS float*)(F.lds + 131072);
            pg8::Gemm g{xb, Wt_in, M, NIN, DM, memb, Wt_xkv}; pg8::TwoOrder S; S.init(M, NIN, MROWS, 2 * DM, F.G, F.bid);
            LAS int* ptab = (LAS int*)(F.lds + 131072 + 8192);
            LAS float* ftab = (LAS float*)(F.lds + 131072 + 16384);
            if (F.tid < 64) { const double fd = INVF[F.tid] * 0.15915494309189535; const float fhi = __uint_as_float(__float_as_uint((float)fd) & 0xffffe000u); ftab[2 * F.tid] = fhi; ftab[2 * F.tid + 1] = (float)(fd - (double)fhi); }
            { pg8::Unit uu; for (int i = 0; i < 8 && S.next(i, uu); ++i) if (F.tid < 256) { rtab[i * 256 + F.tid] = (uu.prob ? rinvm : rinv1)[uu.pm * 256 + F.tid]; ptab[i * 256 + F.tid] = uu.prob ? 0 : F.pos[uu.pm * 256 + F.tid]; }
              __syncthreads(); }
            EpiInProj E{proj, rtab, ptab, ftab, F.sb_q_g, F.sb_k_g, T, memk, memvT, ssqk};
            pg8::gemm_phase<EpiInProj, pg8::TwoOrder, true, true>(F.lds, g, S, E);
        }
        if (BOTH(1)) GRID_BAR();
    }
    STAMP(2); F.tid = opaque_tid(); F.lane = F.tid & 63;
    if (IN(2)) {
#pragma nounroll
        for (int rep = 0; rep < (((PROBE_MASK >> 2) & 1) ? 2 : 1); ++rep) {
            if (rep) GRID_BAR();
            ret_kv(F, T, KVs);
            if (rep == 0) memk_norm(F, memk, ssqk);
        }
        if (BOTH(2)) GRID_BAR();
    }
    STAMP(3); F.tid = opaque_tid(); F.lane = F.tid & 63;
    if (IN(3)) {
#pragma nounroll
        for (int rep = 0; rep < (((PROBE_MASK >> 3) & 1) ? 2 : 1); ++rep) {
            if (rep) GRID_BAR();
            if (rep == 0) ret_scan(F, KVs, 0, F.G);
            STAMPF(F, 31);
            sb_mfma(F, proj, T, mix);
        }
        if (BOTH(3)) GRID_BAR();
    }
    STAMP(4); F.tid = opaque_tid(); F.lane = F.tid & 63;
    if (IN(4)) {
#pragma nounroll
        for (int rep = 0; rep < (((PROBE_MASK >> 4) & 1) ? 2 : 1); ++rep) {
            if (rep) GRID_BAR();
            ret_out(F, proj, T, KVs, mix);
        }
        if (BOTH(4)) GRID_BAR();
    }
    STAMP(5); F.tid = opaque_tid(); F.lane = F.tid & 63;
    if (IN(5)) {
#pragma nounroll
        for (int rep = 0; rep < (((PROBE_MASK >> 5) & 1) ? 2 : 1); ++rep) {
            if (rep) GRID_BAR();
            EpiResid<true> E{xb, x1b, ssq2}; gemm_big(F, mix, Wt_out, DM, DM, E);
        }
        if (BOTH(5)) GRID_BAR();
    }
    STAMP(6); F.tid = opaque_tid(); F.lane = F.tid & 63;
    if (IN(6)) {
#pragma nounroll
        for (int rep = 0; rep < (((PROBE_MASK >> 6) & 1) ? 2 : 1); ++rep) {
            if (rep) GRID_BAR();
            { LAS float* rtab = (LAS float*)(F.lds + 131072);
              { pg8::StaticOrder S6; S6.init(M, DM, F.G, F.bid); pg8::Unit uu;
                for (int i = 0; i < 8 && S6.next(i, uu); ++i) if (F.tid < 256) rtab[i * 256 + F.tid] = rsqrtf(sum16(ssq2 + (size_t)(uu.pm * 256 + F.tid) * 16) * (1.f / DM) + EPS);
                __syncthreads(); }
              EpiXQ E{xq, rtab, ssqq}; gemm_big(F, x1b, Wt_xq, DM, DM, E); }
            asm volatile("s_waitcnt vmcnt(0)" ::: "memory");
            __syncthreads();
            STAMPF(F, 30);
            xattn_mfma(F, xq, ssqq, memk, memvT, xo);
        }
        if (BOTH(6)) GRID_BAR();
    }
    STAMP(7); F.tid = opaque_tid(); F.lane = F.tid & 63;
    STAMP(8); F.tid = opaque_tid(); F.lane = F.tid & 63;
    if (IN(8)) {
#pragma nounroll
        for (int rep = 0; rep < (((PROBE_MASK >> 8) & 1) ? 2 : 1); ++rep) {
            if (rep) GRID_BAR();
            EpiResid<true> E{x1b, x2b, ssq3}; gemm_big(F, xo, Wt_xo, DM, DM, E);
        }
        if (BOTH(8)) GRID_BAR();
    }
    STAMP(9); F.tid = opaque_tid(); F.lane = F.tid & 63;
    if (IN(9)) {
#pragma nounroll
        for (int rep = 0; rep < (((PROBE_MASK >> 9) & 1) ? 2 : 1); ++rep) {
            if (rep) GRID_BAR();
            LAS float* rtab = (LAS float*)(F.lds + 131072);
            { pg8::StaticOrder S9; S9.init(M, FF, F.G, F.bid); pg8::Unit uu;
              for (int i = 0; i < 8 && S9.next(i, uu); ++i) if (F.tid < 256) rtab[i * 256 + F.tid] = rsqrtf(sum16(ssq3 + (size_t)(uu.pm * 256 + F.tid) * 16) * (1.f / DM) + EPS);
              __syncthreads(); }
            EpiUp E{hid, rtab}; gemm_big(F, x2b, Wt_up, FF, DM, E);
        }
        if (BOTH(9)) GRID_BAR();
    }
    STAMP(10); F.tid = opaque_tid(); F.lane = F.tid & 63;
    if (IN(10)) {
#pragma nounroll
        for (int rep = 0; rep < (((PROBE_MASK >> 10) & 1) ? 2 : 1); ++rep) {
            if (rep) GRID_BAR();
            EpiDown E{x2b, F.out}; gemm_big(F, hid, Wt_dn, DM, FF, E);
        }
    }
    STAMP(11);
    if (PROBE_A >= 0 && F.bid == 0 && threadIdx.x == 0) {
        const unsigned long long t0 = ((unsigned long long)MISC[17] << 32) | MISC[16], t1 = ((unsigned long long)MISC[19] << 32) | MISC[18], d = 4ull * (t1 - t0);
        const unsigned long long w0 = __builtin_amdgcn_s_memrealtime();
        while (__builtin_amdgcn_s_memrealtime() - w0 < d) __builtin_amdgcn_s_sleep(8);
    }
#undef IN
#undef BOTH
}

extern "C" void kernel_launch(void* const* d_in, const int* in_sizes, int n_in, void* d_out, int out_size, void* d_ws, size_t ws_size, hipStream_t stream) {
    static int grid = 0;
    if (grid == 0) {
        if (n_in != 19 || in_sizes[0] != M * DM || out_size != M * DM || ws_size < WS_END) { fprintf(stderr, "kernel_launch: unexpected shapes (n_in %d, in0 %d, out %d, ws %zu); nothing launched\n", n_in, n_in > 0 ? in_sizes[0] : -1, out_size, ws_size); grid = -1; return; }
        int dev = 0, cus = 0, per_cu = 0;
        if (hipGetDevice(&dev) != hipSuccess || hipDeviceGetAttribute(&cus, hipDeviceAttributeMultiprocessorCount, dev) != hipSuccess) { grid = -1; return; }
        if (hipFuncSetAttribute((const void*)fwd_kernel, hipFuncAttributeMaxDynamicSharedMemorySize, LDS_BYTES) != hipSuccess) { fprintf(stderr, "kernel_launch: hipFuncSetAttribute failed\n"); grid = -1; return; }
        if (hipOccupancyMaxActiveBlocksPerMultiprocessor(&per_cu, (const void*)fwd_kernel, NTHR, LDS_BYTES) != hipSuccess || per_cu < 1) fprintf(stderr, "kernel_launch: occupancy query reports %d per CU\n", per_cu);
        (void)hipGetLastError();
        grid = cus;
    }
    if (grid < 0) return;
    (void)hipMemsetAsync((char*)d_ws + WS_CTL, 0, CTL_ZERO_BYTES, stream);
    Args a{};
    for (int i = 0; i < 19; ++i) a.in[i] = d_in[i];
    a.out = (float*)d_out; a.ws = (unsigned char*)d_ws;
    for (int li = 0; li < MK_N_LAUNCHES; ++li) {
        a.ph_lo = (MK_N_LAUNCHES == NPHASE) ? li : 0; a.ph_hi = (MK_N_LAUNCHES == NPHASE) ? li + 1 : NPHASE; a.li = li; a.pad = 0;
        hipLaunchKernelGGL(fwd_kernel, dim3(grid), dim3(NTHR), LDS_BYTES, stream, a);
    }
}
```

```cpp
#include <hip/hip_runtime.h>
#include <stdint.h>
#include <cstdio>

#define LAS __attribute__((address_space(3)))
#define GAS __attribute__((address_space(1)))
typedef unsigned short bf16;
typedef short bf16x8 __attribute__((ext_vector_type(8)));
typedef float f32x4 __attribute__((ext_vector_type(4)));
typedef unsigned u32x4 __attribute__((ext_vector_type(4)));
typedef unsigned u32x2 __attribute__((ext_vector_type(2)));
typedef GAS unsigned gu32;

#ifndef MK_N_LAUNCHES
#define MK_N_LAUNCHES 1
#endif
constexpr int NPHASE = 11;
#ifndef PROBE_MASK
#define PROBE_MASK 0
#endif
#ifndef PROBE_SPIN
#define PROBE_SPIN -1
#endif
#ifndef PROBE_A
#define PROBE_A (PROBE_SPIN)
#endif
#ifndef PROBE_B
#define PROBE_B (PROBE_SPIN + 1)
#endif
constexpr int NWAVES = 8, NTHR = 512;

constexpr int BATCH = 4, SEQ = 4096, DM = 1024, M = BATCH * SEQ;
constexpr int NIN = 3584, FF = 4096, MEML = 256, MROWS = BATCH * MEML;
constexpr int NPROJ = 2560, P_RQ = 0, P_RK = 512, P_RG = 1024, P_SQ = 1536, P_SK = 2048;
constexpr int NT = 1536, TC_RK = 0, TC_RV = 512, TC_SV = 1024, TS = 4160;
constexpr float EPS = 1e-6f;

constexpr size_t MiB = 1u << 20;
constexpr size_t WS_CTL = 0, CTL_ZERO_BYTES = 64 * 1024;
constexpr size_t WS_WIN = 1 * MiB, WS_WOUT = 8 * MiB, WS_WXQ = 10 * MiB, WS_WXKV = 12 * MiB, WS_WXO = 16 * MiB, WS_WUP = 18 * MiB, WS_WDN = 26 * MiB;
constexpr size_t WS_RINV1 = 34 * MiB, WS_RINVM = 34 * MiB + 64 * 1024;
constexpr size_t WS_SSQ2 = 242 * MiB, WS_SSQ3 = 243 * MiB, WS_SSQQ = 244 * MiB;
constexpr size_t WS_MEMB = 35 * MiB, WS_MEMK = 37 * MiB, WS_MEMV = 39 * MiB;
constexpr size_t WS_ROPE = 41 * MiB;
constexpr size_t WS_XB = 49 * MiB, WS_MIX = 49 * MiB;
constexpr size_t WS_PROJ = 81 * MiB;
constexpr size_t WS_T = 161 * MiB;
constexpr size_t WS_KVS = 210 * MiB;
constexpr size_t WS_X1B = 81 * MiB, WS_XQ = 113 * MiB, WS_XO = 145 * MiB;
constexpr size_t WS_X2B = 193 * MiB;
constexpr size_t WS_HID = 49 * MiB;
constexpr size_t WS_SSQK = 245 * MiB;
constexpr size_t WS_END = 246 * MiB;

constexpr int LDS_BYTES = 159744;
constexpr int MISC_OFF = LDS_BYTES - 256;

__device__ const double INVF[64] = {1.0, 0.8659643233600653, 0.7498942093324559, 0.6493816315762113, 0.5623413251903491, 0.4869675251658631, 0.4216965034285822, 0.3651741272548377, 0.31622776601683794, 0.27384196342643613, 0.23713737056616552, 0.2053525026457146, 0.1778279410038923, 0.1539926526059492, 0.1333521432163324, 0.11547819846894582, 0.1, 0.08659643233600653, 0.07498942093324558, 0.06493816315762113, 0.05623413251903491, 0.04869675251658631, 0.042169650342858224, 0.03651741272548377, 0.03162277660168379, 0.027384196342643614, 0.023713737056616554, 0.02053525026457146, 0.01778279410038923, 0.01539926526059492, 0.01333521432163324, 0.011547819846894581, 0.01, 0.008659643233600654, 0.007498942093324558, 0.006493816315762113, 0.005623413251903491, 0.004869675251658631, 0.004216965034285823, 0.003651741272548377, 0.0031622776601683794, 0.0027384196342643613, 0.0023713737056616554, 0.002053525026457146, 0.0017782794100389228, 0.001539926526059492, 0.001333521432163324, 0.0011547819846894581, 0.001, 0.0008659643233600654, 0.0007498942093324559, 0.0006493816315762113, 0.0005623413251903491, 0.0004869675251658631, 0.00042169650342858224, 0.0003651741272548377, 0.00031622776601683794, 0.0002738419634264361, 0.00023713737056616554, 0.0002053525026457146, 0.00017782794100389227, 0.0001539926526059492, 0.0001333521432163324, 0.00011547819846894582};

__device__ __forceinline__ float bflo(unsigned u) { return __uint_as_float(u << 16); }
__device__ __forceinline__ float bfhi(unsigned u) { return __uint_as_float(u & 0xffff0000u); }
__device__ __forceinline__ float bf2f(bf16 v) { return __uint_as_float(((unsigned)v) << 16); }
__device__ __forceinline__ unsigned f2bf(float f) { unsigned u = __float_as_uint(f); return (u + 0x7fffu + ((u >> 16) & 1u)) >> 16; }
__device__ __forceinline__ unsigned cvtpk(float lo, float hi);
__device__ __forceinline__ unsigned pk2(float lo, float hi) { return cvtpk(lo, hi); }
typedef float f32x2_t __attribute__((ext_vector_type(2)));
typedef __bf16 bf16x2_t __attribute__((ext_vector_type(2)));
__device__ __forceinline__ unsigned cvtpk(float lo, float hi) { const f32x2_t v = {lo, hi}; return __builtin_bit_cast(unsigned, __builtin_convertvector(v, bf16x2_t)); }
__device__ __forceinline__ float wave_sum(float v) {
#pragma unroll
    for (int o = 1; o < 64; o <<= 1) v += __shfl_xor(v, o);
    return v;
}
__device__ __forceinline__ float wave_max(float v) {
#pragma unroll
    for (int o = 1; o < 64; o <<= 1) v = fmaxf(v, __shfl_xor(v, o));
    return v;
}
#define CBAR() asm volatile("" ::: "memory")
__device__ __forceinline__ int opaque_tid() { int t = threadIdx.x; asm volatile("" : "+v"(t)); return t; }
__device__ __forceinline__ float lg2gamma(int h) { return h == 0 ? -0.04580368961312479f : h == 1 ? -0.02272007650008353f : h == 2 ? -0.011315313227834146f : -0.005646563141142063f; }

#define XB_TMO      128
#define XB_XCNT(j)  (256  + 64 * (j))
#define XB_XSUB(j)  (1280 + 64 * (j))
#define XB_XGEN(j)  (2304 + 64 * (j))
#define XB_TOP      3328
#define XB_TOPGEN   3392
#define XCD_BAR_WORDS 3456
#define XB_SPIN_CAP (1u << 22)
__device__ __forceinline__ unsigned xb_ld(unsigned* p)              { return __hip_atomic_load(p, __ATOMIC_RELAXED, __HIP_MEMORY_SCOPE_AGENT); }
__device__ __forceinline__ unsigned xb_add(unsigned* p, unsigned v) { return __hip_atomic_fetch_add(p, v, __ATOMIC_RELAXED, __HIP_MEMORY_SCOPE_AGENT); }
__device__ __forceinline__ unsigned xb_xcc_id() { return (unsigned)__builtin_amdgcn_s_getreg((3 << 11) | 20) & 0xFu; }
#define XB_SPIN(cond, bar) do { unsigned _sp = 0; while (cond) { __builtin_amdgcn_s_sleep(1); \
    if ((++_sp & 255u) == 0u) { if (xb_ld(&(bar)[XB_TMO])) break; if (_sp > XB_SPIN_CAP) { atomicAdd(&(bar)[XB_TMO], 1u); break; } } } } while (0)
struct XcdBarrier { unsigned* bar; unsigned x; volatile LAS unsigned* st; };
__device__ __forceinline__ XcdBarrier xcd_barrier_post(unsigned* bar, volatile LAS unsigned* st) {
    XcdBarrier b; b.bar = bar; b.x = xb_xcc_id(); b.st = st;
    if (threadIdx.x == 0) (void)xb_add(&bar[XB_XCNT(b.x)], 1u);
    return b;
}
__device__ __forceinline__ void xcd_barrier_complete(unsigned* bar, unsigned x, unsigned& nloc, unsigned& nx) {
    const unsigned G = gridDim.x * gridDim.y * gridDim.z;
    unsigned sum, cnt, mine, sp = 0u;
    for (;;) {
        sum = 0u; cnt = 0u; mine = 0u;
#pragma unroll
        for (unsigned j = 0; j < 16; ++j) { const unsigned c = xb_ld(&bar[XB_XCNT(j)]); sum += c; cnt += (c > 0u) ? 1u : 0u; mine = (j == x) ? c : mine; }
        if (sum == G) break;
        __builtin_amdgcn_s_sleep(1);
        if ((++sp & 255u) == 0u) { if (xb_ld(&bar[XB_TMO])) break; if (sp > XB_SPIN_CAP) { atomicAdd(&bar[XB_TMO], 1u); break; } }
    }
    nloc = mine > 0u ? mine : 1u; nx = cnt > 0u ? cnt : 1u;
}
__device__ __forceinline__ void xcd_barrier(const XcdBarrier& b) {
    asm volatile("s_waitcnt vmcnt(0)" ::: "memory");
    __syncthreads();
    if (threadIdx.x == 0) {
        unsigned* bar = b.bar;
        __builtin_amdgcn_s_waitcnt(0);
        unsigned nloc = b.st[0], nx = b.st[1];
        if (nloc == 0u) { xcd_barrier_complete(bar, b.x, nloc, nx); b.st[0] = nloc; b.st[1] = nx; }
        const unsigned old = xb_add(&bar[XB_XSUB(b.x)], 1u);
        const unsigned gen = old / nloc;
        if (old + 1u == (gen + 1u) * nloc) {
            __builtin_amdgcn_fence(__ATOMIC_RELEASE, "agent");
            asm volatile("s_waitcnt vmcnt(0)" ::: "memory");
            const unsigned og = xb_add(&bar[XB_TOP], 1u);
            const unsigned tg = og / nx;
            if (og + 1u == (tg + 1u) * nx) xb_add(&bar[XB_TOPGEN], 1u);
            else XB_SPIN(xb_ld(&bar[XB_TOPGEN]) == tg, bar);
            __builtin_amdgcn_fence(__ATOMIC_ACQUIRE, "agent");
            xb_add(&bar[XB_XGEN(b.x)], 1u);
            asm volatile("s_waitcnt vmcnt(0)" ::: "memory");
        } else {
            XB_SPIN(xb_ld(&bar[XB_XGEN(b.x)]) == gen, bar);
            __builtin_amdgcn_fence(__ATOMIC_ACQUIRE, "agent");
            asm volatile("s_waitcnt vmcnt(0)" ::: "memory");
        }
    }
    __syncthreads();
}

struct Args { const void* in[19]; float* out; unsigned char* ws; int ph_lo, ph_hi, li, pad; };
struct Frame {
    LAS unsigned char* lds;
    int tid, lane, wave, G, bid;
    const float *x, *mem; const int* pos;
    const float *g_mix, *w_in, *ret_gn_g, *sb_q_g, *sb_k_g, *w_out, *g_xattn, *g_mem, *w_xq, *w_xkv, *xq_g, *xk_g, *w_xo, *g_mlp, *w_up, *w_down;
    float* out; unsigned char* ws;
};
#define STAMPF(Fr, k) do { if (PROBE_A >= 0 && (Fr).bid == 0 && threadIdx.x == 0 && ((k) == PROBE_A || (k) == PROBE_B)) { const unsigned long long t_ = __builtin_amdgcn_s_memrealtime(); \
        volatile LAS unsigned* M_ = (volatile LAS unsigned*)((Fr).lds + MISC_OFF); M_[16 + 2 * ((k) == PROBE_B ? 1 : 0)] = (unsigned)t_; M_[17 + 2 * ((k) == PROBE_B ? 1 : 0)] = (unsigned)(t_ >> 32); } } while (0)

__device__ __forceinline__ int inproj_src_col(int np) {
    const int pn = np >> 8, p = np & 255, seg = pn >> 1, half = pn & 1, bj = p >> 7, wc = (p >> 5) & 3, i = p & 31;
    if (seg <= 1) { const int h = 2 * half + bj, g = 4 * wc + (i >> 3), e = i & 7; return seg * 512 + h * 128 + (e < 4 ? 4 * g + e : 64 + 4 * g + e - 4); }
    if (seg == 4 || seg == 5) { const int head = 4 * half + wc; return seg * 512 + head * 64 + 32 * bj + i; }
    return np;
}
struct WD { const float* W; const float* g; bf16* Wt; int K, N; bool perm; };
__device__ __forceinline__ void conv_batch4(const Frame& F, const WD& d0, int t0, const WD& d1, int t1, const WD& d2, int t2, const WD& d3, int t3) {
    LAS float* T = (LAS float*)F.lds;
    const int r0 = F.tid >> 4, c = (F.tid & 15) * 4;
    f32x4 v[4][2]; int k0[4], n0[4];
#define CW_LOAD(j, d, t) do { if ((t) >= 0) { const int tn = (d).N >> 6; k0[j] = ((t) / tn) * 64; n0[j] = ((t) % tn) * 64; const int sc = (d).perm ? inproj_src_col(n0[j] + c) : n0[j] + c; \
        _Pragma("unroll") for (int i = 0; i < 2; ++i) { const int r = r0 + 32 * i; v[j][i] = *(const f32x4*)((d).W + (size_t)(k0[j] + r) * (d).N + sc); if ((d).g) v[j][i] = v[j][i] * (d).g[k0[j] + r]; } } } while (0)
    CW_LOAD(0, d0, t0); CW_LOAD(1, d1, t1); CW_LOAD(2, d2, t2); CW_LOAD(3, d3, t3);
    __syncthreads();
#define CW_LDSW(j, t) do { if ((t) >= 0) { _Pragma("unroll") for (int i = 0; i < 2; ++i) { LAS float* Tj = T + (j) * (64 * 65) + (r0 + 32 * i) * 65 + c; Tj[0] = v[j][i][0]; Tj[1] = v[j][i][1]; Tj[2] = v[j][i][2]; Tj[3] = v[j][i][3]; } } } while (0)
    CW_LDSW(0, t0); CW_LDSW(1, t1); CW_LDSW(2, t2); CW_LDSW(3, t3);
    __syncthreads();
#define CW_STORE(j, d, t) do { if ((t) >= 0) { const LAS float* Tj = T + (j) * (64 * 65); _Pragma("unroll") for (int i = 0; i < 2; ++i) { const int n = r0 + 32 * i; \
        u32x2 o; o[0] = pk2(Tj[(c + 0) * 65 + n], Tj[(c + 1) * 65 + n]); o[1] = pk2(Tj[(c + 2) * 65 + n], Tj[(c + 3) * 65 + n]); *(u32x2*)((d).Wt + (size_t)(n0[j] + n) * (d).K + k0[j] + c) = o; } } } while (0)
    CW_STORE(0, d0, t0); CW_STORE(1, d1, t1); CW_STORE(2, d2, t2); CW_STORE(3, d3, t3);
#undef CW_LOAD
#undef CW_LDSW
#undef CW_STORE
}
__device__ __forceinline__ void conv_weights(const Frame& F, bf16* Wt_in, bf16* Wt_out, bf16* Wt_xq, bf16* Wt_xkv, bf16* Wt_xo, bf16* Wt_up, bf16* Wt_dn) {
    const WD win{F.w_in, F.g_mix, Wt_in, DM, NIN, true}, wout{F.w_out, nullptr, Wt_out, DM, DM, false}, wxq{F.w_xq, F.g_xattn, Wt_xq, DM, DM, false}, wxkv{F.w_xkv, F.g_mem, Wt_xkv, DM, 2 * DM, false},
             wxo{F.w_xo, nullptr, Wt_xo, DM, DM, false}, wup{F.w_up, F.g_mlp, Wt_up, DM, FF, false}, wdn{F.w_down, nullptr, Wt_dn, FF, DM, false};
    for (int c = F.bid; c < 256; c += F.G) {
        conv_batch4(F, win, c, win, c + 256, win, c + 512, win, (c + 768 < 896) ? c + 768 : -1);
        conv_batch4(F, wout, c, wxq, c, wxo, c, wxkv, c);
        conv_batch4(F, wxkv, c + 256, wup, c, wup, c + 256, wup, c + 512);
        conv_batch4(F, wup, c + 768, wdn, c, wdn, c + 256, wdn, c + 512);
        conv_batch4(F, wdn, c + 768, wdn, -1, wdn, -1, wdn, -1);
    }
    __syncthreads();
}
__device__ __forceinline__ void rows_prep(const Frame& F, const float* X, bf16* Xb, float* rinv, int rows) {
    const int gw = F.bid * NWAVES + F.wave, GW = F.G * NWAVES;
    for (int rb = gw; rb < rows; rb += 4 * GW) {
        f32x4 v[4][4];
#pragma unroll
        for (int j = 0; j < 4; ++j) {
            const int r = min(rb + j * GW, rows - 1);
#pragma unroll
            for (int i = 0; i < 4; ++i) v[j][i] = *(const f32x4*)(X + (size_t)r * DM + i * 256 + F.lane * 4);
        }
#pragma unroll
        for (int j = 0; j < 4; ++j) {
            const int r = rb + j * GW;
            if (r < rows) {
                float ss = 0.f;
#pragma unroll
                for (int i = 0; i < 4; ++i) {
                    const f32x4 t = v[j][i] * v[j][i]; ss += (t[0] + t[1]) + (t[2] + t[3]);
                    u32x2 o; o[0] = pk2(v[j][i][0], v[j][i][1]); o[1] = pk2(v[j][i][2], v[j][i][3]);
                    *(u32x2*)(Xb + (size_t)r * DM + i * 256 + F.lane * 4) = o;
                }
                ss = wave_sum(ss);
                if (F.lane == 0) rinv[r] = rsqrtf(ss * (1.f / DM) + EPS);
            }
        }
    }
}
__device__ __forceinline__ void rope_table(const Frame& F, float2* cs) {
    const int total = M * 64;
    for (int e = F.bid * NTHR + F.tid; e < total; e += F.G * NTHR) {
        const int row = e >> 6, j = e & 63;
        const double ang = (double)F.pos[row] * INVF[j];
        const double rev = ang * 0.15915494309189535;
        const float fr = (float)(rev - floor(rev));
        float2 o; o.x = __builtin_amdgcn_cosf(fr); o.y = __builtin_amdgcn_sinf(fr);
        cs[e] = o;
    }
}

__device__ __forceinline__ void p0_fused(const Frame& F, bf16* Wt_in, bf16* Wt_out, bf16* Wt_xq, bf16* Wt_xkv, bf16* Wt_xo, bf16* Wt_up, bf16* Wt_dn,
                                         bf16* xb, float* rinv1, bf16* memb, float* rinvm, float2* cs) {
    const WD win{F.w_in, F.g_mix, Wt_in, DM, NIN, true}, wout{F.w_out, nullptr, Wt_out, DM, DM, false}, wxq{F.w_xq, F.g_xattn, Wt_xq, DM, DM, false}, wxkv{F.w_xkv, F.g_mem, Wt_xkv, DM, 2 * DM, false},
             wxo{F.w_xo, nullptr, Wt_xo, DM, DM, false}, wup{F.w_up, F.g_mlp, Wt_up, DM, FF, false}, wdn{F.w_down, nullptr, Wt_dn, FF, DM, false};
    LAS float* T = (LAS float*)F.lds;
    const int r0 = F.tid >> 4, c = (F.tid & 15) * 4, lane = F.lane;
    const int gw = F.bid * NWAVES + F.wave, GW = F.G * NWAVES;
    f32x4 vA[4][2], vB[4][2]; int k0A[4], n0A[4], k0B[4], n0B[4];
    f32x4 rv[4][4];
#define CW_LOAD(V, K0, N0, j, d, t) do { if ((t) >= 0) { const int tn = (d).N >> 6; K0[j] = ((t) / tn) * 64; N0[j] = ((t) % tn) * 64; const int sc = (d).perm ? inproj_src_col(N0[j] + c) : N0[j] + c; \
        _Pragma("unroll") for (int i = 0; i < 2; ++i) { const int r = r0 + 32 * i; V[j][i] = __builtin_nontemporal_load((const f32x4*)((d).W + (size_t)(K0[j] + r) * (d).N + sc)); if ((d).g) V[j][i] = V[j][i] * (d).g[K0[j] + r]; } } } while (0)
#define CW_LDSW(V, j, t) do { if ((t) >= 0) { _Pragma("unroll") for (int i = 0; i < 2; ++i) { LAS float* Tj = T + (j) * (64 * 65) + (r0 + 32 * i) * 65 + c; Tj[0] = V[j][i][0]; Tj[1] = V[j][i][1]; Tj[2] = V[j][i][2]; Tj[3] = V[j][i][3]; } } } while (0)
#define CW_STORE(K0, N0, j, d, t) do { if ((t) >= 0) { const LAS float* Tj = T + (j) * (64 * 65); _Pragma("unroll") for (int i = 0; i < 2; ++i) { const int n = r0 + 32 * i; \
        u32x2 o; o[0] = pk2(Tj[(c + 0) * 65 + n], Tj[(c + 1) * 65 + n]); o[1] = pk2(Tj[(c + 2) * 65 + n], Tj[(c + 3) * 65 + n]); *(u32x2*)((d).Wt + (size_t)(N0[j] + n) * (d).K + K0[j] + c) = o; } } } while (0)
#define CW_ISSUE(S, d0, t0, d1, t1, d2, t2, d3, t3) do { CW_LOAD(v##S, k0##S, n0##S, 0, d0, t0); CW_LOAD(v##S, k0##S, n0##S, 1, d1, t1); CW_LOAD(v##S, k0##S, n0##S, 2, d2, t2); CW_LOAD(v##S, k0##S, n0##S, 3, d3, t3); __builtin_amdgcn_sched_barrier(0); } while (0)
#define CW_FINISH(S, d0, t0, d1, t1, d2, t2, d3, t3) do { __syncthreads(); CW_LDSW(v##S, 0, t0); CW_LDSW(v##S, 1, t1); CW_LDSW(v##S, 2, t2); CW_LDSW(v##S, 3, t3); __syncthreads(); \
        CW_STORE(k0##S, n0##S, 0, d0, t0); CW_STORE(k0##S, n0##S, 1, d1, t1); CW_STORE(k0##S, n0##S, 2, d2, t2); CW_STORE(k0##S, n0##S, 3, d3, t3); __builtin_amdgcn_sched_barrier(0); } while (0)
#define ROW_ISSUE(X, rows, jb) do { _Pragma("unroll") for (int j = 0; j < 4; ++j) { const int r = min(gw + ((jb) + j) * GW, (rows) - 1); \
        _Pragma("unroll") for (int i = 0; i < 4; ++i) rv[j][i] = __builtin_nontemporal_load((const f32x4*)((X) + (size_t)r * DM + i * 256 + lane * 4)); } __builtin_amdgcn_sched_barrier(0); } while (0)
#define ROW_FINISH(Xb, rinv, rows, jb, nj) do { _Pragma("unroll") for (int j = 0; j < (nj); ++j) { const int r = gw + ((jb) + j) * GW; if (r < (rows)) { float ss = 0.f; \
        _Pragma("unroll") for (int i = 0; i < 4; ++i) { const f32x4 t = rv[j][i] * rv[j][i]; ss += (t[0] + t[1]) + (t[2] + t[3]); u32x2 o; o[0] = pk2(rv[j][i][0], rv[j][i][1]); o[1] = pk2(rv[j][i][2], rv[j][i][3]); \
            *(u32x2*)((Xb) + (size_t)r * DM + i * 256 + lane * 4) = o; } \
        ss = wave_sum(ss); if (lane == 0) (rinv)[r] = rsqrtf(ss * (1.f / DM) + EPS); } } __builtin_amdgcn_sched_barrier(0); } while (0)
    const int cb = F.bid;
    const int t3a = (cb + 768 < 896) ? cb + 768 : -1;
    ROW_ISSUE(F.x, M, 0);
    CW_ISSUE(A, win, cb, win, cb + 256, win, cb + 512, win, t3a);
    ROW_FINISH(xb, rinv1, M, 0, 4);
    STAMPF(F, 20);
    ROW_ISSUE(F.x, M, 4);
    CW_ISSUE(B, wout, cb, wxq, cb, wxo, cb, wxkv, cb);
    CW_FINISH(A, win, cb, win, cb + 256, win, cb + 512, win, t3a);
    STAMPF(F, 21);
    ROW_FINISH(xb, rinv1, M, 4, 4);
    STAMPF(F, 22);
    ROW_ISSUE(F.mem, MROWS, 0);
    CW_ISSUE(A, wxkv, cb + 256, wup, cb, wup, cb + 256, wup, cb + 512);
    CW_FINISH(B, wout, cb, wxq, cb, wxo, cb, wxkv, cb);
    STAMPF(F, 23);
    ROW_FINISH(memb, rinvm, MROWS, 0, 1);
    CW_ISSUE(B, wup, cb + 768, wdn, cb, wdn, cb + 256, wdn, cb + 512);
    CW_FINISH(A, wxkv, cb + 256, wup, cb, wup, cb + 256, wup, cb + 512);
    STAMPF(F, 24);
    CW_ISSUE(A, wdn, cb + 768, wdn, -1, wdn, -1, wdn, -1);
    CW_FINISH(B, wup, cb + 768, wdn, cb, wdn, cb + 256, wdn, cb + 512);
    STAMPF(F, 25);
    CW_FINISH(A, wdn, cb + 768, wdn, -1, wdn, -1, wdn, -1);
    STAMPF(F, 26);
#undef CW_LOAD
#undef CW_LDSW
#undef CW_STORE
#undef CW_ISSUE
#undef CW_FINISH
#undef ROW_ISSUE
#undef ROW_FINISH
    __syncthreads();
}

namespace pg8 {
#define PG8_LAS __attribute__((address_space(3)))
typedef unsigned short bf16_t;
typedef short bf16x8 __attribute__((ext_vector_type(8)));
typedef float f32x4 __attribute__((ext_vector_type(4)));
typedef unsigned u32x4 __attribute__((ext_vector_type(4)));
constexpr int BM = 256, BK = 64, HALF = 128, HTB = HALF * BK * 2  , STAGE_BYTES = 8 * HTB, NXCD = 8, WGM = 8;

__host__ __device__ __forceinline__ int lds_byte(int r, int c) { const int st = (r >> 4) * 2 + (c >> 5), rr = r & 15, cc = c & 31, ob = rr * 64 + cc * 2; return st * 1024 + (ob ^ (((ob >> 9) & 1) << 5)); }
__host__ __device__ __forceinline__ void stage_rc(int b, int& R, int& C) { const int st = b / 1024, sb = b % 1024, swz = sb ^ (((sb >> 9) & 1) << 5); R = (st >> 1) * 16 + swz / 64; C = (st & 1) * 32 + (swz % 64) / 2; }
__host__ __device__ __forceinline__ int perm32(int rho) { const int n = rho >> 4, i = rho & 15; return 8 * (i >> 2) + 4 * n + (i & 3); }

struct Unit { int pm, pn, prob, idx; };
struct Gemm { const bf16_t* A; const bf16_t* Bt; int M, N, K; const bf16_t* A2; const bf16_t* Bt2; };

struct StaticOrder {
    int nM, nN, nwg, G, c;
    __host__ __device__ __forceinline__ void init(int M, int N, int G_, int c_) { nM = M / BM; nN = N / BM; nwg = nM * nN; G = G_; c = c_; }
    __host__ __device__ __forceinline__ bool next(int i, Unit& u) const {
        const long L = (long)i * G + c; if (L >= nwg) return false;
        int wgid = (int)L; { const int q = nwg / NXCD, r = nwg % NXCD, xcd = wgid % NXCD, off = wgid / NXCD; wgid = (xcd < r ? xcd * (q + 1) : r * (q + 1) + (xcd - r) * q) + off; }
        const int nig = WGM * nN, gid = wgid / nig, fm = gid * WGM, gsz = (nM - fm) < WGM ? (nM - fm) : WGM;
        u.pm = fm + ((wgid % nig) % gsz); u.pn = (wgid % nig) / gsz; u.prob = 0; u.idx = i; return true;
    }
    __device__ __forceinline__ void a_ready(const Unit&) const {}
    __device__ __forceinline__ void done(const Unit&) const {}
};

__device__ __forceinline__ unsigned cvt_pk_bf16(float lo, float hi) { unsigned r; asm volatile("v_cvt_pk_bf16_f32 %0, %1, %2" : "=v"(r) : "v"(lo), "v"(hi)); return r; }
struct TwoOrder {
    StaticOrder S1; int nM2, nwg2;
    __host__ __device__ __forceinline__ void init(int M, int N, int M2, int N2, int G_, int c_) { S1.init(M, N, G_, c_); nM2 = M2 / BM; nwg2 = nM2 * (N2 / BM); }
    __host__ __device__ __forceinline__ bool next(int i, Unit& u) const {
        const long L = (long)i * S1.G + S1.c;
        if (L < S1.nwg) return S1.next(i, u);
        const int l2 = (int)(L - S1.nwg); if (l2 >= nwg2) return false;
        u.pm = l2 % nM2; u.pn = l2 / nM2; u.prob = 1; u.idx = i; return true;
    }
    __device__ __forceinline__ void a_ready(const Unit&) const {}
    __device__ __forceinline__ void done(const Unit&) const {}
};

template <class Epi, class Sched, bool ALIGN_EPI = false, bool SP2 = false>
__device__ __forceinline__ void gemm_phase(PG8_LAS unsigned char* lds, const Gemm g, const Sched& S, const Epi& E) {
    int tid_ = threadIdx.x; asm volatile("" : "+v"(tid_));
    const int tid = tid_, wid = __builtin_amdgcn_readfirstlane(tid >> 6), lane = tid & 63, wr = wid >> 2, wc = wid & 3, fr = lane & 15, fq = lane >> 4;
    const int K = g.K, nt = K / BK;
    unsigned voffA[2], voffB[2];
#pragma unroll
    for (int i = 0; i < 2; ++i) { int R, C; stage_rc(tid * 16 + i * 8192, R, C); const int Rb = Epi::PERM ? ((R & ~31) + perm32(R & 31)) : R;
        voffA[i] = (unsigned)(R * K + C) * 2u; voffB[i] = (unsigned)(Rb * K + C) * 2u; }
    const size_t kstep = (size_t)(BK * 2);
    const size_t hstep = (size_t)HALF * K * 2;
    const size_t tstep = 2 * hstep;
    const unsigned ldsw = (unsigned)wid * 1024u;
    const int aoff = lds_byte(wr * 64 + fr, fq * 8), boff = lds_byte(wc * 32 + fr, fq * 8);
#define PG8_SA(b, h) (((b) * 2 + (h)) * HTB)
#define PG8_SB(b, h) ((4 + (b) * 2 + (h)) * HTB)
#define PG8_STAGE(bufoff, gbase, voff) do { _Pragma("unroll") for (int _i = 0; _i < 2; ++_i) \
        __builtin_amdgcn_global_load_lds((const unsigned*)((const char*)(gbase) + (voff)[_i]), (PG8_LAS unsigned*)(lds + (bufoff) + ldsw + _i * 8192), 16, 0, 0); } while (0)
#define PG8_LDA(dst, b, h) do { _Pragma("unroll") for (int m = 0; m < 4; ++m) _Pragma("unroll") for (int k = 0; k < 2; ++k) dst[m][k] = *(const PG8_LAS bf16x8*)(lds + PG8_SA(b, h) + aoff + m * 2048 + k * 1024); } while (0)
#define PG8_LDB(dst, b, h) do { _Pragma("unroll") for (int n = 0; n < 2; ++n) _Pragma("unroll") for (int k = 0; k < 2; ++k) dst[n][k] = *(const PG8_LAS bf16x8*)(lds + PG8_SB(b, h) + boff + n * 2048 + k * 1024); } while (0)
#define PG8_MMA(ai, bj, At, Bt) do { __builtin_amdgcn_s_setprio(1); _Pragma("unroll") for (int m = 0; m < 4; ++m) _Pragma("unroll") for (int n = 0; n < 2; ++n) _Pragma("unroll") for (int k = 0; k < 2; ++k) \
        acc[ai][bj][m][n] = __builtin_amdgcn_mfma_f32_16x16x32_bf16(Bt[n][k], At[m][k], acc[ai][bj][m][n], 0, 0, 0); __builtin_amdgcn_s_setprio(0); } while (0)
#define PG8_WAIT_V(n) asm volatile("s_waitcnt vmcnt(" #n ")" ::: "memory")
#define PG8_WAIT_L(n) asm volatile("s_waitcnt lgkmcnt(" #n ")" ::: "memory")
#define PG8_BAR __builtin_amdgcn_s_barrier()
#define PG8_SCHED __builtin_amdgcn_sched_barrier(0)
    Unit cur, nxt; int ui = 0;
    if (!S.next(0, cur)) return;
    f32x4 acc[2][2][4][2];
#pragma unroll
    for (int a = 0; a < 2; ++a)
#pragma unroll
        for (int b = 0; b < 2; ++b)
#pragma unroll
            for (int m = 0; m < 4; ++m)
#pragma unroll
                for (int n = 0; n < 2; ++n) acc[a][b][m][n] = (f32x4){0.f, 0.f, 0.f, 0.f};
    bf16x8 At[4][2], B0[2][2], B1[2][2];
    const char* cA = (const char*)(cur.prob ? g.A2 : g.A) + (size_t)cur.pm * tstep; const char* cB = (const char*)(cur.prob ? g.Bt2 : g.Bt) + (size_t)cur.pn * tstep;
    S.a_ready(cur);
    if constexpr (SP2) {
        PG8_STAGE(PG8_SB(0, 0), cB, voffB); PG8_STAGE(PG8_SB(0, 1), cB + hstep, voffB); PG8_STAGE(PG8_SA(0, 0), cA, voffA); PG8_STAGE(PG8_SA(0, 1), cA + hstep, voffA);
        if (wr == 1) PG8_BAR;
        PG8_WAIT_V(2); PG8_BAR;
        PG8_STAGE(PG8_SB(1, 0), cB + kstep, voffB); PG8_STAGE(PG8_SA(1, 0), cA + kstep, voffA); PG8_STAGE(PG8_SB(1, 1), cB + hstep + kstep, voffB);
        PG8_WAIT_V(6); PG8_BAR;
    } else {
        PG8_STAGE(PG8_SB(0, 0), cB, voffB); PG8_STAGE(PG8_SA(0, 0), cA, voffA); PG8_STAGE(PG8_SB(0, 1), cB + hstep, voffB); PG8_STAGE(PG8_SA(0, 1), cA + hstep, voffA);
        if (wr == 1) PG8_BAR;
        PG8_WAIT_V(4); PG8_BAR;
        PG8_STAGE(PG8_SB(1, 0), cB + kstep, voffB); PG8_STAGE(PG8_SA(1, 0), cA + kstep, voffA); PG8_STAGE(PG8_SB(1, 1), cB + hstep + kstep, voffB);
        PG8_WAIT_V(6); PG8_BAR;
    }
    for (;;) {
        const bool has_next = S.next(ui + 1, nxt);
        const char* nA = has_next ? (const char*)(nxt.prob ? g.A2 : g.A) + (size_t)nxt.pm * tstep : cA; const char* nB = has_next ? (const char*)(nxt.prob ? g.Bt2 : g.Bt) + (size_t)nxt.pn * tstep : cB;
#define PG8_STAMP(id) do { if (PROBE_A >= 0 && blockIdx.x == 0 && threadIdx.x == 0 && ui == 1 && (Epi::STAMP_BASE + (id) == PROBE_A || Epi::STAMP_BASE + (id) == PROBE_B)) { const unsigned long long t_ = __builtin_amdgcn_s_memrealtime(); \
            volatile PG8_LAS unsigned* M_ = (volatile PG8_LAS unsigned*)(lds + MISC_OFF); const int o_ = (Epi::STAMP_BASE + (id) == PROBE_B) ? 2 : 0; M_[16 + o_] = (unsigned)t_; M_[17 + o_] = (unsigned)(t_ >> 32); } } while (0)
        PG8_STAMP(0);
        for (int t = 0; t < nt; t += 2) {
            const bool last = (t == nt - 2);
            const char* a1 = cA + (size_t)(t + 1) * kstep;
            const char* a2 = last ? nA : cA + (size_t)(t + 2) * kstep; const char* b2 = last ? nB : cB + (size_t)(t + 2) * kstep;
            const char* a3 = a2 + kstep; const char* b3 = b2 + kstep;
            if (last && has_next) S.a_ready(nxt);
            if constexpr (SP2) {
            PG8_LDB(B0, 0, 0); PG8_LDB(B1, 0, 1); PG8_SCHED; PG8_LDA(At, 0, 0); PG8_STAGE(PG8_SA(1, 1), a1 + hstep, voffA);
            PG8_WAIT_V(8); PG8_WAIT_L(0); PG8_BAR; PG8_MMA(0, 0, At, B0); PG8_MMA(0, 1, At, B1); PG8_BAR; PG8_SCHED;
            PG8_LDA(At, 0, 1); PG8_STAGE(PG8_SB(0, 0), b2, voffB); PG8_STAGE(PG8_SB(0, 1), b2 + hstep, voffB); PG8_STAGE(PG8_SA(0, 0), a2, voffA);
            PG8_WAIT_V(8); PG8_WAIT_L(0); PG8_BAR; PG8_MMA(1, 0, At, B0); PG8_MMA(1, 1, At, B1); PG8_BAR; PG8_SCHED;
            PG8_LDB(B0, 1, 0); PG8_LDB(B1, 1, 1); PG8_SCHED; PG8_LDA(At, 1, 0); PG8_STAGE(PG8_SA(0, 1), a2 + hstep, voffA);
            PG8_WAIT_V(8); PG8_WAIT_L(0); PG8_BAR; PG8_MMA(0, 0, At, B0); PG8_MMA(0, 1, At, B1); PG8_BAR; PG8_SCHED;
            PG8_LDA(At, 1, 1); PG8_STAGE(PG8_SB(1, 0), b3, voffB); PG8_STAGE(PG8_SB(1, 1), b3 + hstep, voffB); PG8_STAGE(PG8_SA(1, 0), a3, voffA);
            PG8_WAIT_V(8); PG8_WAIT_L(0); PG8_BAR; PG8_MMA(1, 0, At, B0); PG8_MMA(1, 1, At, B1); PG8_BAR; PG8_SCHED;
            } else {
            PG8_LDB(B0, 0, 0); PG8_SCHED; PG8_LDA(At, 0, 0); PG8_STAGE(PG8_SA(1, 1), a1 + hstep, voffA);
            PG8_WAIT_L(8); PG8_BAR; PG8_WAIT_L(0); PG8_MMA(0, 0, At, B0); PG8_BAR; PG8_SCHED;
            PG8_LDB(B1, 0, 1); PG8_STAGE(PG8_SB(0, 0), b2, voffB);
            PG8_BAR; PG8_WAIT_L(0); PG8_MMA(0, 1, At, B1); PG8_BAR;
            PG8_LDA(At, 0, 1); PG8_STAGE(PG8_SA(0, 0), a2, voffA);
            PG8_BAR; PG8_WAIT_L(0); PG8_MMA(1, 0, At, B0); PG8_BAR; PG8_SCHED;
            PG8_STAGE(PG8_SB(0, 1), b2 + hstep, voffB);
            PG8_WAIT_V(6); PG8_BAR; PG8_MMA(1, 1, At, B1); PG8_BAR;
            PG8_LDB(B0, 1, 0); PG8_SCHED; PG8_LDA(At, 1, 0); PG8_STAGE(PG8_SA(0, 1), a2 + hstep, voffA);
            PG8_WAIT_L(8); PG8_BAR; PG8_WAIT_L(0); PG8_MMA(0, 0, At, B0); PG8_BAR; PG8_SCHED;
            PG8_LDB(B1, 1, 1); PG8_STAGE(PG8_SB(1, 0), b3, voffB);
            PG8_BAR; PG8_WAIT_L(0); PG8_MMA(0, 1, At, B1); PG8_BAR;
            PG8_LDA(At, 1, 1); PG8_STAGE(PG8_SA(1, 0), a3, voffA);
            PG8_BAR; PG8_WAIT_L(0); PG8_MMA(1, 0, At, B0); PG8_BAR; PG8_SCHED;
            PG8_STAGE(PG8_SB(1, 1), b3 + hstep, voffB);
            PG8_WAIT_V(6); PG8_BAR; PG8_MMA(1, 1, At, B1); PG8_BAR;
            }
        }
        PG8_STAMP(1);
        if constexpr (ALIGN_EPI) { if (wr == 0) PG8_BAR; }
        PG8_STAMP(2);
        if constexpr (!Epi::AFTER_DRAIN) { E(acc, cur, wr, wc, fr, fq); S.done(cur); }
        PG8_STAMP(3);
        if (!has_next) break;
#pragma unroll
        for (int a = 0; a < 2; ++a)
#pragma unroll
            for (int b = 0; b < 2; ++b)
#pragma unroll
                for (int m = 0; m < 4; ++m)
#pragma unroll
                    for (int n = 0; n < 2; ++n) acc[a][b][m][n] = (f32x4){0.f, 0.f, 0.f, 0.f};
        cur = nxt; cA = nA; cB = nB; ++ui;
        if constexpr (ALIGN_EPI) { if (wr == 1) PG8_BAR; }
    }
    PG8_WAIT_V(0);
    if constexpr (!ALIGN_EPI) { if (wr == 0) PG8_BAR; }
    PG8_BAR;
    if constexpr (Epi::AFTER_DRAIN) { E.fused(acc, cur, wr, wc, fr, fq, lds, wid, lane); S.done(cur); }
#undef PG8_SA
#undef PG8_SB
#undef PG8_STAGE
#undef PG8_LDA
#undef PG8_LDB
#undef PG8_MMA
#undef PG8_WAIT_V
#undef PG8_WAIT_L
#undef PG8_BAR
#undef PG8_SCHED
}
}

__device__ __forceinline__ float sum16(const float* p) { const f32x4 a = *(const f32x4*)p, b = *(const f32x4*)(p + 4), c = *(const f32x4*)(p + 8), d = *(const f32x4*)(p + 12); const f32x4 t = (a + b) + (c + d); return (t[0] + t[1]) + (t[2] + t[3]); }
__device__ __forceinline__ u32x4 pack8u(const f32x4& a, const f32x4& b) { u32x4 w; w[0] = cvtpk(a[0], a[1]); w[1] = cvtpk(a[2], a[3]); w[2] = cvtpk(b[0], b[1]); w[3] = cvtpk(b[2], b[3]); return w; }
template <int STRIDE>
__device__ __forceinline__ void store_T8s(bf16* t, const u32x4& w) {
#pragma unroll
    for (int e = 0; e < 4; ++e) { t[(size_t)(2 * e) * STRIDE] = (bf16)(w[e] & 0xffffu); t[(size_t)(2 * e + 1) * STRIDE] = (bf16)(w[e] >> 16); }
}
__device__ __forceinline__ void store_T8(bf16* T, size_t chan0, int sq, const u32x4& w) { store_T8s<TS>(T + chan0 * TS + sq, w); }
struct EpiInProj {
    static constexpr bool PERM = true, AFTER_DRAIN = false; static constexpr int STAMP_BASE = -1000;
    bf16* proj; const LAS float* rtab; const LAS int* ptab; const LAS float* ftab; const float* sb_q_g; const float* sb_k_g; bf16* T;
    bf16* memk; bf16* memvT; float* ssqk;
    __device__ __forceinline__ void memkv(const f32x4 (&acc)[2][2][4][2], const pg8::Unit& u, int wr, int wc, int fr_, int fq_) const {
        int fr = fr_, fq = fq_; asm volatile("" : "+v"(fr), "+v"(fq));
#pragma unroll
        for (int ai = 0; ai < 2; ++ai)
#pragma unroll
            for (int m = 0; m < 4; ++m) {
                const int lr = ai * 128 + wr * 64 + m * 16 + fr, gr = u.pm * 256 + lr;
                const float s = rtab[u.idx * 256 + lr];
                if (u.pn < 4) {
                    float ss = 0.f;
#pragma unroll
                    for (int bj = 0; bj < 2; ++bj) {
                        const f32x4 v0 = acc[ai][bj][m][0] * s, v1 = acc[ai][bj][m][1] * s;
                        *(u32x4*)(memk + (size_t)gr * DM + u.pn * 256 + 128 * bj + 32 * wc + 8 * fq) = pack8u(v0, v1);
                        const f32x4 t = v0 * v0 + v1 * v1; ss += (t[0] + t[1]) + (t[2] + t[3]);
                    }
                    ss += __shfl_xor(ss, 16); ss += __shfl_xor(ss, 32);
                    if (fq == 0) ssqk[(size_t)gr * 16 + u.pn * 4 + wc] = ss;
                } else {
                    const int b = gr >> 8, key = gr & (MEML - 1);
#pragma unroll
                    for (int bj = 0; bj < 2; ++bj)
                        store_T8s<MEML>(memvT + ((size_t)(b * 4 + u.pn - 4) * 256 + 128 * bj + 32 * wc + 8 * fq) * MEML + key, pack8u(acc[ai][bj][m][0] * s, acc[ai][bj][m][1] * s));
                }
            }
    }
    __device__ __forceinline__ void operator()(const f32x4 (&acc)[2][2][4][2], const pg8::Unit& u, int wr, int wc, int fr_, int fq_) const {
        int fr = fr_, fq = fq_; asm volatile("" : "+v"(fr), "+v"(fq));
        if (u.prob) { memkv(acc, u, wr, wc, fr, fq); return; }
        const int pn = u.pn, seg = pn >> 1, half = pn & 1;
#pragma unroll
        for (int ai = 0; ai < 2; ++ai)
#pragma unroll
            for (int m = 0; m < 4; ++m) {
                const int lr = ai * 128 + wr * 64 + m * 16 + fr, gr = u.pm * 256 + lr, b = gr >> 12, sq = gr & (SEQ - 1);
                const float s = rtab[u.idx * 256 + lr];
                f32x4 a[2][2];
#pragma unroll
                for (int bj = 0; bj < 2; ++bj) { a[bj][0] = acc[ai][bj][m][0] * s; a[bj][1] = acc[ai][bj][m][1] * s; }
                if (seg <= 1) {
                    const int g = 4 * wc + fq;
                    const float posf = (float)ptab[u.idx * 256 + lr];
                    f32x4 cosv, sinv;
#pragma unroll
                    for (int e4 = 0; e4 < 4; ++e4) {
                        const float fhi = ftab[2 * (4 * g + e4)], flo = ftab[2 * (4 * g + e4) + 1];
                        const float ph = posf * fhi, rev = (ph - floorf(ph)) + posf * flo;
                        cosv[e4] = __builtin_amdgcn_cosf(rev); sinv[e4] = __builtin_amdgcn_sinf(rev);
                    }
                    const float eidx = (float)((gr & 127) + 1);
#pragma unroll
                    for (int bj = 0; bj < 2; ++bj) {
                        const int h = 2 * half + bj;
                        const float e = eidx * lg2gamma(h);
                        const float sc = (seg == 0) ? __builtin_amdgcn_exp2f(e) : 0.08838834764831845f * __builtin_amdgcn_exp2f(-e);
                        const f32x4 x = a[bj][0], y = a[bj][1];
                        const f32x4 o1 = (x * cosv - y * sinv) * sc, o2 = (y * cosv + x * sinv) * sc;
                        const u32x4 w = pack8u(o1, o2);
                        *(u32x4*)(proj + (size_t)gr * NPROJ + (seg == 0 ? P_RQ : P_RK) + h * 128 + 8 * g) = w;
                        if (seg == 1) store_T8(T, (size_t)b * NT + TC_RK + h * 128 + 8 * g, sq, w);
                    }
                } else if (seg == 4 || seg == 5) {
                    float ss = 0.f;
#pragma unroll
                    for (int bj = 0; bj < 2; ++bj)
#pragma unroll
                        for (int n = 0; n < 2; ++n) { const f32x4 t = a[bj][n] * a[bj][n]; ss += (t[0] + t[1]) + (t[2] + t[3]); }
                    ss += __shfl_xor(ss, 16); ss += __shfl_xor(ss, 32);
                    const float inv = rsqrtf(ss * (1.f / 64.f) + EPS);
                    const int head = 4 * half + wc;
                    const float* gp = (seg == 4 ? sb_q_g : sb_k_g) + head * 64 + 8 * fq;
#pragma unroll
                    for (int bj = 0; bj < 2; ++bj) {
                        const f32x4 g0 = *(const f32x4*)(gp + 32 * bj), g1 = *(const f32x4*)(gp + 32 * bj + 4);
                        const float sc4 = (seg == 4) ? inv * 0.18033688011112042f : inv;
                        const u32x4 w = pack8u(a[bj][0] * g0 * sc4, a[bj][1] * g1 * sc4);
                        *(u32x4*)(proj + (size_t)gr * NPROJ + (seg == 4 ? P_SQ : P_SK) + head * 64 + 32 * bj + 8 * fq) = w;
                    }
                } else if (seg == 3) {
#pragma unroll
                    for (int bj = 0; bj < 2; ++bj) *(u32x4*)(proj + (size_t)gr * NPROJ + P_RG + half * 256 + 128 * bj + 32 * wc + 8 * fq) = pack8u(a[bj][0], a[bj][1]);
                } else {
                    const int chb = (seg == 2 ? TC_RV : TC_SV) + half * 256 + 32 * wc + 8 * fq;
#pragma unroll
                    for (int bj = 0; bj < 2; ++bj) store_T8(T, (size_t)b * NT + chb + 128 * bj, sq, pack8u(a[bj][0], a[bj][1]));
                }
            }
    }
};
template <bool RES_BF16>
struct EpiResid {
    static constexpr bool PERM = true, AFTER_DRAIN = false; static constexpr int STAMP_BASE = -1000;
    const void* resid; bf16* xb; float* ssq;
    __device__ __forceinline__ void operator()(const f32x4 (&acc)[2][2][4][2], const pg8::Unit& u, int wr, int wc, int fr_, int fq_) const {
        int fr = fr_, fq = fq_; asm volatile("" : "+v"(fr), "+v"(fq));
#pragma unroll
        for (int ai = 0; ai < 2; ++ai)
#pragma unroll
            for (int m = 0; m < 4; ++m) {
                const int gr = u.pm * 256 + ai * 128 + wr * 64 + m * 16 + fr;
                float ss = 0.f;
#pragma unroll
                for (int bj = 0; bj < 2; ++bj) {
                    const size_t o = (size_t)gr * DM + u.pn * 256 + 128 * bj + 32 * wc + 8 * fq;
                    f32x4 r0, r1;
                    if (RES_BF16) { const u32x4 rw = *(const u32x4*)((const bf16*)resid + o); r0 = (f32x4){bflo(rw[0]), bfhi(rw[0]), bflo(rw[1]), bfhi(rw[1])}; r1 = (f32x4){bflo(rw[2]), bfhi(rw[2]), bflo(rw[3]), bfhi(rw[3])}; }
                    else { r0 = *(const f32x4*)((const float*)resid + o); r1 = *(const f32x4*)((const float*)resid + o + 4); }
                    const f32x4 v0 = acc[ai][bj][m][0] + r0, v1 = acc[ai][bj][m][1] + r1;
                    *(u32x4*)(xb + o) = pack8u(v0, v1);
                    const f32x4 t = v0 * v0 + v1 * v1; ss += (t[0] + t[1]) + (t[2] + t[3]);
                }
                ss += __shfl_xor(ss, 16); ss += __shfl_xor(ss, 32);
                if (fq == 0) ssq[(size_t)gr * 16 + u.pn * 4 + wc] = ss;
            }
    }
};
struct EpiXQ {
    static constexpr bool PERM = true, AFTER_DRAIN = false; static constexpr int STAMP_BASE = -1000;
    bf16* xq; const LAS float* rtab; float* ssqq;
    __device__ __forceinline__ void operator()(const f32x4 (&acc)[2][2][4][2], const pg8::Unit& u, int wr, int wc, int fr_, int fq_) const {
        int fr = fr_, fq = fq_; asm volatile("" : "+v"(fr), "+v"(fq));
#pragma unroll
        for (int ai = 0; ai < 2; ++ai)
#pragma unroll
            for (int m = 0; m < 4; ++m) {
                const int lr = ai * 128 + wr * 64 + m * 16 + fr, gr = u.pm * 256 + lr;
                const float rinv = rtab[u.idx * 256 + lr];
                float ss = 0.f;
#pragma unroll
                for (int bj = 0; bj < 2; ++bj) {
                    const f32x4 v0 = acc[ai][bj][m][0] * rinv, v1 = acc[ai][bj][m][1] * rinv;
                    *(u32x4*)(xq + (size_t)gr * DM + u.pn * 256 + 128 * bj + 32 * wc + 8 * fq) = pack8u(v0, v1);
                    const f32x4 t = v0 * v0 + v1 * v1; ss += (t[0] + t[1]) + (t[2] + t[3]);
                }
                ss += __shfl_xor(ss, 16); ss += __shfl_xor(ss, 32);
                if (fq == 0) ssqq[(size_t)gr * 16 + u.pn * 4 + wc] = ss;
            }
    }
};
struct EpiUp {
    static constexpr bool PERM = true, AFTER_DRAIN = false; static constexpr int STAMP_BASE = 40;
    bf16* hid; const LAS float* rtab;
    __device__ __forceinline__ void operator()(const f32x4 (&acc)[2][2][4][2], const pg8::Unit& u, int wr, int wc, int fr_, int fq_) const {
        int fr = fr_, fq = fq_; asm volatile("" : "+v"(fr), "+v"(fq));
#pragma unroll
        for (int ai = 0; ai < 2; ++ai)
#pragma unroll
            for (int m = 0; m < 4; ++m) {
                const int lr = ai * 128 + wr * 64 + m * 16 + fr, gr = u.pm * 256 + lr;
                const float rinv = rtab[u.idx * 256 + lr];
#pragma unroll
                for (int bj = 0; bj < 2; ++bj) {
                    f32x4 v0 = acc[ai][bj][m][0] * rinv, v1 = acc[ai][bj][m][1] * rinv;
#pragma unroll
                    for (int e = 0; e < 4; ++e) { const float t0 = fmaxf(v0[e], 0.f), t1 = fmaxf(v1[e], 0.f); v0[e] = t0 * t0; v1[e] = t1 * t1; }
                    *(u32x4*)(hid + (size_t)gr * FF + u.pn * 256 + 128 * bj + 32 * wc + 8 * fq) = pack8u(v0, v1);
                }
            }
    }
};
struct EpiDown {
    static constexpr bool PERM = true, AFTER_DRAIN = false; static constexpr int STAMP_BASE = -1000;
    const bf16* resid; float* out;
    __device__ __forceinline__ void operator()(const f32x4 (&acc)[2][2][4][2], const pg8::Unit& u, int wr, int wc, int fr_, int fq_) const {
        int fr = fr_, fq = fq_; asm volatile("" : "+v"(fr), "+v"(fq));
#pragma unroll
        for (int ai = 0; ai < 2; ++ai)
#pragma unroll
            for (int m = 0; m < 4; ++m) {
                const int gr = u.pm * 256 + ai * 128 + wr * 64 + m * 16 + fr;
#pragma unroll
                for (int bj = 0; bj < 2; ++bj) {
                    const size_t o = (size_t)gr * DM + u.pn * 256 + 128 * bj + 32 * wc + 8 * fq;
                    const u32x4 rw = *(const u32x4*)(resid + o);
                    const f32x4 r0 = (f32x4){bflo(rw[0]), bfhi(rw[0]), bflo(rw[1]), bfhi(rw[1])}, r1 = (f32x4){bflo(rw[2]), bfhi(rw[2]), bflo(rw[3]), bfhi(rw[3])};
                    __builtin_nontemporal_store(acc[ai][bj][m][0] + r0, (f32x4*)(out + o)); __builtin_nontemporal_store(acc[ai][bj][m][1] + r1, (f32x4*)(out + o + 4));
                }
            }
    }
};
template <class Epi>
__device__ __forceinline__ void gemm_big(const Frame& F, const bf16* A, const bf16* Bt, int N, int K, const Epi& E) {
    pg8::Gemm g{A, Bt, M, N, K, nullptr, nullptr}; pg8::StaticOrder S; S.init(M, N, F.G, F.bid);
    pg8::gemm_phase<Epi, pg8::StaticOrder, true, true>(F.lds, g, S, E);
}

typedef float f32x16 __attribute__((ext_vector_type(16)));
#define MFMA32(a, b, c) __builtin_amdgcn_mfma_f32_32x32x16_bf16((a), (b), (c), 0, 0, 0)
__device__ __forceinline__ bf16x8 pack8(float a0, float a1, float a2, float a3, float a4, float a5, float a6, float a7) {
    u32x4 p; p[0] = cvtpk(a0, a1); p[1] = cvtpk(a2, a3); p[2] = cvtpk(a4, a5); p[3] = cvtpk(a6, a7);
    return __builtin_bit_cast(bf16x8, p);
}
constexpr int SBK_SLOT = 32 * 144, SBV_ROW = 17 * 64 + 16, SBV_OFF = 17 * SBK_SLOT;
__device__ __forceinline__ int ret_unit(const Frame& F, int u) {
    if (F.G != 256) return u;
    const int wg = u & 255, k = u >> 8, x = wg & 7, l = (wg >> 3) + 32 * k;
    return ((x >> 1) << 7) | ((l & 3) << 5) | (16 * (x & 1) + (l >> 2));
}
__device__ __forceinline__ void sb_mfma(const Frame& F, const bf16* proj, const bf16* T, bf16* mix) {
    const int tid = opaque_tid(), lane = tid & 63, r = lane & 31, hh = lane >> 5, w = F.wave;
    const int kr = (r & ~12) | ((r & 4) << 1) | ((r & 8) >> 1);
    const float c1 = 0.18033688011112042f;
    LAS unsigned char* L = F.lds;
    for (int u = F.bid; u < BATCH * 8 * 8; u += F.G) {
        int qblk = 7 - (u & 7), hd = (u >> 3) & 7, b = u >> 6;
        if (F.G == 256) { const int x = u & 7, l = u >> 3; b = x >> 1; hd = l & 7; qblk = 4 * (x & 1) + (l >> 3); }
        const int q0g = qblk * 512, tg = q0g >> 5;
        const float gq = wave_max(fabsf(F.sb_q_g[hd * 64 + lane])), gk = wave_max(fabsf(F.sb_k_g[hd * 64 + lane]));
        const float thresh = 152.f + c1 * 64.f * gq * gk * 1.02f;
        const bf16* kgu = proj + (size_t)b * SEQ * NPROJ + P_SK + hd * 64;
        const bf16* vgu = T + ((size_t)b * NT + TC_SV + hd * 64) * TS;
        const int ldrow = (tid & 255) >> (tid < 256 ? 3 : 2), ldch = (tid & 255) & (tid < 256 ? 7 : 3);
#define SB_TLOAD(ti) ((tid < 256) ? *(const u32x4*)(kgu + (size_t)((ti) * 32 + ldrow) * NPROJ + ldch * 8) : *(const u32x4*)(vgu + (size_t)ldrow * TS + (ti) * 32 + ldch * 8))
#define SB_TWRITE(ti, val) do { const int sl_ = (ti) % 17; if (tid < 256) *(LAS u32x4*)(L + sl_ * SBK_SLOT + ldrow * 144 + ldch * 16) = (val); \
                                else *(LAS u32x4*)(L + SBV_OFF + ldrow * SBV_ROW + sl_ * 64 + ldch * 16) = (val); } while (0)
        {
            u32x4 pv[16];
#pragma unroll
            for (int i = 0; i < 16; ++i) pv[i] = SB_TLOAD(tg + i);
#pragma unroll
            for (int i = 0; i < 16; ++i) SB_TWRITE(tg + i, pv[i]);
        }
        bf16x8 qf[2][4];
#pragma unroll
        for (int g = 0; g < 2; ++g) {
            const bf16* qp = proj + ((size_t)b * SEQ + q0g + 64 * w + 32 * g + r) * NPROJ + P_SQ + hd * 64 + 8 * hh;
#pragma unroll
            for (int s = 0; s < 4; ++s) qf[g][s] = *(const bf16x8*)(qp + 16 * s);
        }
        __syncthreads();
        f32x16 o[2][2];
#pragma unroll
        for (int g = 0; g < 2; ++g)
#pragma unroll
            for (int n = 0; n < 2; ++n)
#pragma unroll
                for (int i = 0; i < 16; ++i) o[g][n][i] = 0.f;
        float carry[2] = {0.f, 0.f}, cprod[2] = {1.f, 1.f};
        bool done0 = false, done1 = false;
        for (int st = 0;; ++st) {
            const int tnew = tg - st - 1;
            const bool more = tnew >= 0;
            u32x4 nv;
            if (more) nv = SB_TLOAD(tnew);
#pragma unroll
            for (int g = 0; g < 2; ++g) {
                const int ti = tg + 2 * w + g - st;
                bool& done = g ? done1 : done0;
                if (!done && ti >= 0) {
                    const int sl = ti % 17;
                    LAS unsigned char* kb = L + sl * SBK_SLOT + kr * 144 + 16 * hh;
                    LAS unsigned char* vb = L + SBV_OFF + r * SBV_ROW + sl * 64 + 16 * hh;
                    bf16x8 kf[4], vf[4];
#pragma unroll
                    for (int s = 0; s < 4; ++s) kf[s] = *(LAS bf16x8*)(kb + 32 * s);
#pragma unroll
                    for (int n = 0; n < 2; ++n)
#pragma unroll
                        for (int ks = 0; ks < 2; ++ks) vf[2 * n + ks] = *(LAS bf16x8*)(vb + (32 * n) * SBV_ROW + 32 * ks);
                    f32x16 x;
#pragma unroll
                    for (int i = 0; i < 16; ++i) x[i] = 0.f;
#pragma unroll
                    for (int s = 0; s < 4; ++s) x = MFMA32(kf[s], qf[g][s], x);
                    const bool diag = (st == 0);
                    f32x16 ee, rr;
#pragma unroll
                    for (int i = 0; i < 16; ++i) {
                        const int key = 16 * (i >> 3) + 8 * hh + (i & 7);
                        const float t = (diag && !(key < r)) ? -1e30f : x[i];
                        ee[i] = __builtin_amdgcn_exp2f(t);
                        rr[i] = __builtin_amdgcn_rcpf(1.f + ee[i]);
                    }
#pragma unroll
                    for (int gg = 0; gg < 2; ++gg)
#pragma unroll
                        for (int e = 6; e >= 0; --e) rr[8 * gg + e] *= rr[8 * gg + e + 1];
                    const float tlo = rr[0], thi = rr[8], plo = __shfl_xor(tlo, 32), phi = __shfl_xor(thi, 32);
                    const float cp = cprod[g];
                    const float blo = cp * (hh == 0 ? (plo * thi) * phi : phi * thi), bhi = hh == 0 ? cp * phi : cp;
                    const float lown = __builtin_amdgcn_logf(tlo) + __builtin_amdgcn_logf(thi);
                    carry[g] -= lown + __shfl_xor(lown, 32);
                    cprod[g] = cp * ((tlo * plo) * (thi * phi));
#pragma unroll
                    for (int i = 0; i < 16; ++i) x[i] = ee[i] * ((i < 8 ? blo : bhi) * rr[i]);
#pragma unroll
                    for (int ks = 0; ks < 2; ++ks) {
                        const bf16x8 pf = pack8(x[8 * ks], x[8 * ks + 1], x[8 * ks + 2], x[8 * ks + 3], x[8 * ks + 4], x[8 * ks + 5], x[8 * ks + 6], x[8 * ks + 7]);
                        o[g][0] = MFMA32(pf, vf[ks], o[g][0]);
                        o[g][1] = MFMA32(pf, vf[2 + ks], o[g][1]);
                    }
                    if (ti == 0 || __all(carry[g] > thresh)) done = true;
                } else done = true;
            }
            if (more) SB_TWRITE(tnew, nv);
            const int alldone = __syncthreads_and((done0 && done1) ? 1 : 0);
            if (alldone) break;
        }
#undef SB_TLOAD
#undef SB_TWRITE
        LAS bf16* os = (LAS bf16*)(L + w * (64 * 144));
#pragma unroll
        for (int g = 0; g < 2; ++g)
#pragma unroll
            for (int i = 0; i < 16; ++i) {
                const int qr = 32 * g + (i & 3) + 8 * (i >> 2) + 4 * hh;
                os[qr * 72 + r] = (bf16)f2bf(o[g][0][i]);
                os[qr * 72 + 32 + r] = (bf16)f2bf(o[g][1][i]);
            }
        CBAR();
        int lane2 = lane; asm volatile("" : "+v"(lane2));
#pragma unroll
        for (int i = 0; i < 8; ++i) {
            const int id = i * 64 + lane2, row = id >> 3, ch = id & 7;
            *(u32x4*)(mix + ((size_t)b * SEQ + q0g + 64 * w + row) * DM + 512 + hd * 64 + ch * 8) = *(LAS u32x4*)(os + row * 72 + ch * 8);
        }
        __syncthreads();
    }
}

__device__ __forceinline__ void ret_kv(const Frame& F, const bf16* T, bf16* KVs) {
    const int tid = opaque_tid(), lane = tid & 63, r = lane & 31, hh = lane >> 5, mt = F.wave >> 1, nt0 = (F.wave & 1) * 2;
    LAS unsigned char* L = F.lds;
    for (int u0 = F.bid; u0 < BATCH * 4 * 32; u0 += 2 * F.G) {
        u32x4 sk[2][4], sv[2][4];
#pragma unroll
        for (int j = 0; j < 2; ++j) {
            const int u = ret_unit(F, min(u0 + j * F.G, BATCH * 4 * 32 - 1)), c = u & 31, h = (u >> 5) & 3, b = u >> 7;
            const bf16* kp = T + ((size_t)b * NT + TC_RK + h * 128) * TS + c * 128;
            const bf16* vp = T + ((size_t)b * NT + TC_RV + h * 128) * TS + c * 128;
#pragma unroll
            for (int i = 0; i < 4; ++i) { const int id = i * NTHR + tid, row = id >> 4, ch = id & 15; sk[j][i] = *(const u32x4*)(kp + (size_t)row * TS + ch * 8); sv[j][i] = *(const u32x4*)(vp + (size_t)row * TS + ch * 8); }
        }
        __syncthreads();
#pragma unroll
        for (int j = 0; j < 2; ++j)
#pragma unroll
            for (int i = 0; i < 4; ++i) { const int id = i * NTHR + tid, row = id >> 4, ch = id & 15; *(LAS u32x4*)(L + j * 69632 + row * 272 + ch * 16) = sk[j][i]; *(LAS u32x4*)(L + j * 69632 + 34816 + row * 272 + ch * 16) = sv[j][i]; }
        __syncthreads();
#pragma unroll
        for (int j = 0; j < 2; ++j) {
            if (u0 + j * F.G < BATCH * 4 * 32) {
                const int u = ret_unit(F, u0 + j * F.G), h = (u >> 5) & 3;
                LAS unsigned char* vb = L + j * 69632 + 34816 + (32 * mt + r) * 272 + 16 * hh;
                LAS unsigned char* kb = L + j * 69632 + (32 * nt0 + r) * 272 + 16 * hh;
                f32x16 a0, a1;
#pragma unroll
                for (int i = 0; i < 16; ++i) { a0[i] = 0.f; a1[i] = 0.f; }
                bf16x8 vf[8], k0f[8], k1f[8];
#pragma unroll
                for (int ks = 0; ks < 8; ++ks) { vf[ks] = *(LAS bf16x8*)(vb + 32 * ks); k0f[ks] = *(LAS bf16x8*)(kb + 32 * ks); k1f[ks] = *(LAS bf16x8*)(kb + 32 * 272 + 32 * ks); }
#pragma unroll
                for (int ks = 0; ks < 8; ++ks) { a0 = MFMA32(vf[ks], k0f[ks], a0); a1 = MFMA32(vf[ks], k1f[ks], a1); }
                const float g128 = __builtin_amdgcn_exp2f(128.f * lg2gamma(h));
                bf16* op = KVs + (size_t)u * 16384 + (size_t)(32 * mt + 4 * hh) * 128 + 32 * nt0 + r;
#pragma unroll
                for (int i = 0; i < 16; ++i) { const int row = (i & 3) + 8 * (i >> 2); op[row * 128] = (bf16)f2bf(a0[i] * g128); op[row * 128 + 32] = (bf16)f2bf(a1[i] * g128); }
            }
        }
    }
    __syncthreads();
}
__device__ __forceinline__ void memk_norm(const Frame& F, bf16* memk, const float* ssqk) {
    const int gw = F.bid * NWAVES + F.wave, GW = F.G * NWAVES;
    for (int r = gw; r < MROWS; r += GW) {
#pragma unroll
        for (int i = 0; i < 2; ++i) {
            const int c = i * 512 + F.lane * 8, h = c >> 8;
            const f32x4 pq = *(const f32x4*)(ssqk + (size_t)r * 16 + h * 4);
            const float sc = rsqrtf(((pq[0] + pq[1]) + (pq[2] + pq[3])) * (1.f / 256.f) + EPS);
            const u32x4 v = *(const u32x4*)(memk + (size_t)r * DM + c);
            const f32x4 g0 = *(const f32x4*)(F.xk_g + c), g1 = *(const f32x4*)(F.xk_g + c + 4);
            u32x4 w;
            w[0] = pk2(bflo(v[0]) * sc * g0[0], bfhi(v[0]) * sc * g0[1]); w[1] = pk2(bflo(v[1]) * sc * g0[2], bfhi(v[1]) * sc * g0[3]);
            w[2] = pk2(bflo(v[2]) * sc * g1[0], bfhi(v[2]) * sc * g1[1]); w[3] = pk2(bflo(v[3]) * sc * g1[2], bfhi(v[3]) * sc * g1[3]);
            *(u32x4*)(memk + (size_t)r * DM + c) = w;
        }
    }
}
__device__ __forceinline__ void ret_scan(const Frame& F, bf16* KVs, int wb, int nwb) {
    for (int it = (F.bid - wb) * NTHR + F.tid; it < 16 * 8192; it += nwb * NTHR) {
        const int bh = it >> 13, e2 = (it & 8191) * 2;
        const float g128 = __builtin_amdgcn_exp2f(128.f * lg2gamma(bh & 3));
        bf16* p = KVs + (size_t)bh * 32 * 16384 + e2;
        float s0 = 0.f, s1 = 0.f;
#pragma unroll 1
        for (int cb = 0; cb < 2; ++cb) {
            unsigned t[16];
#pragma unroll
            for (int c = 0; c < 16; ++c) t[c] = *(const unsigned*)(p + (size_t)(cb * 16 + c) * 16384);
#pragma unroll
            for (int c = 0; c < 16; ++c) { *(unsigned*)(p + (size_t)(cb * 16 + c) * 16384) = cvtpk(s0, s1); s0 = s0 * g128 + bflo(t[c]); s1 = s1 * g128 + bfhi(t[c]); }
        }
    }
}
constexpr int RO_ROW = 272, RO_ST = 0, RO_KT = 128 * RO_ROW, RO_VT = 2 * 128 * RO_ROW, RO_OS = 3 * 128 * RO_ROW, RO_OSW = 32 * 144, RO_SS = RO_OS + 8 * RO_OSW;
__device__ __forceinline__ void ret_out(const Frame& F, const bf16* proj, const bf16* T, const bf16* KVs, bf16* mix) {
    const int tid = F.tid, lane = F.lane, r = lane & 31, hh = lane >> 5, qg = F.wave >> 1, dh = F.wave & 1;
    const int kr = (r & ~12) | ((r & 4) << 1) | ((r & 8) >> 1);
    LAS unsigned char* L = F.lds;
    LAS float* ssx = (LAS float*)(L + RO_SS);
    for (int uu = F.bid; uu < BATCH * 4 * 32; uu += F.G) {
        const int u = ret_unit(F, uu), c = u & 31, h = (u >> 5) & 3, b = u >> 7, q0 = c * 128 + 32 * qg;
        u32x4 sst[4], skt[4], svt[4];
        {
            const bf16* sp = KVs + (size_t)u * 16384;
#pragma unroll
            for (int i = 0; i < 4; ++i) sst[i] = *(const u32x4*)(sp + (size_t)(i * NTHR + tid) * 8);
            const bf16* kp = proj + ((size_t)b * SEQ + c * 128) * NPROJ + P_RK + h * 128;
            const bf16* vp = T + ((size_t)b * NT + TC_RV + h * 128) * TS + c * 128;
#pragma unroll
            for (int i = 0; i < 4; ++i) { const int id = i * NTHR + tid, row = id >> 4, ch = id & 15; skt[i] = *(const u32x4*)(kp + (size_t)row * NPROJ + ch * 8); svt[i] = *(const u32x4*)(vp + (size_t)row * TS + ch * 8); }
        }
        bf16x8 qf[8];
        {
            const bf16* qp = proj + ((size_t)b * SEQ + q0 + r) * NPROJ + P_RQ + h * 128 + 8 * hh;
#pragma unroll
            for (int s = 0; s < 8; ++s) qf[s] = *(const bf16x8*)(qp + 16 * s);
        }
#pragma unroll
        for (int i = 0; i < 4; ++i) { const int id = i * NTHR + tid, row = id >> 4, ch = id & 15; *(LAS u32x4*)(L + RO_ST + row * RO_ROW + ch * 16) = sst[i]; }
#pragma unroll
        for (int i = 0; i < 4; ++i) { const int id = i * NTHR + tid, row = id >> 4, ch = id & 15; *(LAS u32x4*)(L + RO_KT + row * RO_ROW + ch * 16) = skt[i]; *(LAS u32x4*)(L + RO_VT + row * RO_ROW + ch * 16) = svt[i]; }
        __syncthreads();
        f32x16 o[2];
#pragma unroll
        for (int n = 0; n < 2; ++n)
#pragma unroll
            for (int i = 0; i < 16; ++i) o[n][i] = 0.f;
        {
            LAS unsigned char* sb_ = L + RO_ST + (32 * (2 * dh) + r) * RO_ROW + 16 * hh;
            bf16x8 sf[2][4];
#pragma unroll
            for (int jq = 0; jq < 4; ++jq) sf[0][jq] = *(LAS bf16x8*)(sb_ + (32 * (jq & 1)) * RO_ROW + 32 * (jq >> 1));
#pragma unroll
            for (int g = 0; g < 4; ++g) {
                if (g < 3) {
#pragma unroll
                    for (int jq = 0; jq < 4; ++jq) sf[(g + 1) & 1][jq] = *(LAS bf16x8*)(sb_ + (32 * (jq & 1)) * RO_ROW + 32 * (2 * (g + 1) + (jq >> 1)));
                }
                __builtin_amdgcn_sched_barrier(0);
#pragma unroll
                for (int jq = 0; jq < 4; ++jq) o[jq & 1] = MFMA32(qf[2 * g + (jq >> 1)], sf[g & 1][jq], o[jq & 1]);
                __builtin_amdgcn_sched_barrier(0);
            }
        }
        for (int kt = 0; kt <= qg; ++kt) {
            f32x16 x;
#pragma unroll
            for (int i = 0; i < 16; ++i) x[i] = 0.f;
            LAS unsigned char* kb = L + RO_KT + (32 * kt + kr) * RO_ROW + 16 * hh;
            LAS unsigned char* vb = L + RO_VT + (32 * (2 * dh) + r) * RO_ROW + (32 * kt + 8 * hh) * 2;
            bf16x8 kf[2][4], vf[4];
#pragma unroll
            for (int jq = 0; jq < 4; ++jq) kf[0][jq] = *(LAS bf16x8*)(kb + 32 * jq);
#pragma unroll
            for (int jq = 0; jq < 4; ++jq) kf[1][jq] = *(LAS bf16x8*)(kb + 32 * (4 + jq));
            __builtin_amdgcn_sched_barrier(0);
#pragma unroll
            for (int jq = 0; jq < 4; ++jq) x = MFMA32(kf[0][jq], qf[jq], x);
#pragma unroll
            for (int jq = 0; jq < 4; ++jq) vf[jq] = *(LAS bf16x8*)(vb + (32 * (jq & 1)) * RO_ROW + 32 * (jq >> 1));
            __builtin_amdgcn_sched_barrier(0);
#pragma unroll
            for (int jq = 0; jq < 4; ++jq) x = MFMA32(kf[1][jq], qf[4 + jq], x);
            __builtin_amdgcn_sched_barrier(0);
            if (kt == qg) {
#pragma unroll
                for (int i = 0; i < 16; ++i) { const int key = 16 * (i >> 3) + 8 * hh + (i & 7); x[i] = (key <= r) ? x[i] : 0.f; }
            }
#pragma unroll
            for (int ks = 0; ks < 2; ++ks) {
                const bf16x8 pf = pack8(x[8 * ks], x[8 * ks + 1], x[8 * ks + 2], x[8 * ks + 3], x[8 * ks + 4], x[8 * ks + 5], x[8 * ks + 6], x[8 * ks + 7]);
#pragma unroll
                for (int n = 0; n < 2; ++n) o[n] = MFMA32(pf, vf[2 * ks + n], o[n]);
            }
        }
        float ssr[16];
#pragma unroll
        for (int i = 0; i < 16; ++i) {
            float ss = o[0][i] * o[0][i] + o[1][i] * o[1][i];
            ss += __shfl_xor(ss, 1); ss += __shfl_xor(ss, 2); ss += __shfl_xor(ss, 4); ss += __shfl_xor(ss, 8); ss += __shfl_xor(ss, 16);
            ssr[i] = ss;
            if (r == 0) ssx[F.wave * 32 + (i & 3) + 8 * (i >> 2) + 4 * hh] = ss;
        }
        __syncthreads();
        LAS bf16* os = (LAS bf16*)(L + RO_OS + F.wave * RO_OSW);
#pragma unroll
        for (int i = 0; i < 16; ++i) {
            const int qr = (i & 3) + 8 * (i >> 2) + 4 * hh;
            const float inv = rsqrtf((ssr[i] + ssx[(F.wave ^ 1) * 32 + qr]) * (1.f / 128.f) + EPS);
            const size_t row = (size_t)b * SEQ + q0 + qr;
#pragma unroll
            for (int n = 0; n < 2; ++n) {
                const int dv = h * 128 + 64 * dh + 32 * n + r;
                const float g = bf2f(proj[row * NPROJ + P_RG + dv]);
                os[qr * 72 + 32 * n + r] = (bf16)f2bf(o[n][i] * inv * F.ret_gn_g[dv] * (g / (1.f + __expf(-g))));
            }
        }
        CBAR();
#pragma unroll
        for (int i = 0; i < 4; ++i) {
            const int id = i * 64 + lane, row = id >> 3, ch = id & 7;
            *(u32x4*)(mix + ((size_t)b * SEQ + q0 + row) * DM + h * 128 + 64 * dh + ch * 8) = *(LAS u32x4*)(os + row * 72 + ch * 8);
        }
    }
}

constexpr int XK_ROW = 528, XV_ROW = 80, XV_OFF = 32 * XK_ROW, XBUF = XV_OFF + 256 * XV_ROW, XOS = 2 * XBUF, XOSW = 32 * 272;
__device__ __forceinline__ void xattn_mfma(const Frame& F, const bf16* xq, const float* ssqq, const bf16* memk, const bf16* memvT, bf16* xo) {
    const int tid = F.tid, lane = F.lane, r = lane & 31, hh = lane >> 5, qg = F.wave >> 1, dh = F.wave & 1;
    const int kr = (r & ~12) | ((r & 4) << 1) | ((r & 8) >> 1);
    const int kl = (tid >> 5) * XK_ROW + (tid & 31) * 16, vl = XV_OFF + (tid >> 2) * XV_ROW + (tid & 3) * 16;
    LAS bf16* os = (LAS bf16*)(F.lds + XOS + F.wave * XOSW);
    for (int ui = 0; (ui >> 1) * F.G + F.bid < 256; ++ui) {
        int gpm, gpn;
        { const int Lw = (ui >> 1) * F.G + F.bid, wg = (Lw & 7) * 32 + (Lw >> 3), fm = (wg >> 5) * 8; gpm = fm + ((wg & 31) & 7); gpn = (wg & 31) >> 3; }
        const int qblk = (gpm & 15) * 2 + (ui & 1), h = gpn, b = gpm >> 4, q0 = qblk * 128 + 32 * qg;
        const bf16* kgu = memk + (size_t)b * MEML * DM + h * 256;
        const bf16* vgu = memvT + (size_t)(b * 4 + h) * 256 * MEML;
        const unsigned koff = (unsigned)((tid >> 5) * DM + (tid & 31) * 8), voff = (unsigned)((tid >> 2) * MEML + (tid & 3) * 8);
        u32x4 sa[4];
#define XLOAD(S, kt) do { const bf16* kg_ = kgu + (size_t)(kt) * 32 * DM; const bf16* vg_ = vgu + (kt) * 32; \
        S[0] = *(const u32x4*)(kg_ + koff); S[1] = *(const u32x4*)(kg_ + 16 * DM + koff); S[2] = *(const u32x4*)(vg_ + voff); S[3] = *(const u32x4*)(vg_ + 128 * MEML + voff); } while (0)
#define XWRITE(S, bufp) do { *(LAS u32x4*)((bufp) + kl) = S[0]; *(LAS u32x4*)((bufp) + kl + 16 * XK_ROW) = S[1]; *(LAS u32x4*)((bufp) + vl) = S[2]; *(LAS u32x4*)((bufp) + vl + 128 * XV_ROW) = S[3]; } while (0)
        XLOAD(sa, 0);
        bf16x8 qf[16];
        {
            const size_t grow = (size_t)b * SEQ + q0 + r;
            const f32x4 pq = *(const f32x4*)(ssqq + grow * 16 + h * 4);
            const bf16* qp = xq + grow * DM + h * 256 + 8 * hh;
            const float* gp = F.xq_g + h * 256 + 8 * hh;
            const float sc = rsqrtf(((pq[0] + pq[1]) + (pq[2] + pq[3])) * (1.f / 256.f) + EPS) * 0.09016844005556021f;
#pragma unroll
            for (int s = 0; s < 16; ++s) {
                const u32x4 v = *(const u32x4*)(qp + 16 * s);
                const f32x4 g0 = *(const f32x4*)(gp + 16 * s), g1 = *(const f32x4*)(gp + 16 * s + 4);
                qf[s] = pack8(bflo(v[0]) * sc * g0[0], bfhi(v[0]) * sc * g0[1], bflo(v[1]) * sc * g0[2], bfhi(v[1]) * sc * g0[3],
                              bflo(v[2]) * sc * g1[0], bfhi(v[2]) * sc * g1[1], bflo(v[3]) * sc * g1[2], bfhi(v[3]) * sc * g1[3]);
                if ((s & 3) == 3) __builtin_amdgcn_sched_barrier(0);
            }
        }
        XWRITE(sa, F.lds);
        __syncthreads();
        f32x16 o[4];
#pragma unroll
        for (int n = 0; n < 4; ++n)
#pragma unroll
            for (int i = 0; i < 16; ++i) o[n][i] = 0.f;
        float m = 0.f, l = 0.f;
#pragma unroll 1
        for (int kt = 0; kt < 8; ++kt) {
            LAS unsigned char* buf = F.lds + (kt & 1) * XBUF;
            LAS unsigned char* kb = buf + kr * XK_ROW + 16 * hh;
            LAS unsigned char* vb = buf + XV_OFF + (32 * (4 * dh) + r) * XV_ROW + 16 * hh;
            if (kt < 7) XLOAD(sa, kt + 1);
            f32x16 x;
#pragma unroll
            for (int i = 0; i < 16; ++i) x[i] = 0.f;
            bf16x8 kf[2][4], vf[2][4];
#pragma unroll
            for (int jq = 0; jq < 4; ++jq) kf[0][jq] = *(LAS bf16x8*)(kb + 32 * jq);
#pragma unroll
            for (int g = 0; g < 4; ++g) {
                if (g < 3) {
#pragma unroll
                    for (int jq = 0; jq < 4; ++jq) kf[(g + 1) & 1][jq] = *(LAS bf16x8*)(kb + 32 * (4 * (g + 1) + jq));
                } else {
#pragma unroll
                    for (int n = 0; n < 4; ++n) vf[0][n] = *(LAS bf16x8*)(vb + (32 * n) * XV_ROW);
                }
                __builtin_amdgcn_sched_barrier(0);
#pragma unroll
                for (int jq = 0; jq < 4; ++jq) x = MFMA32(kf[g & 1][jq], qf[4 * g + jq], x);
                __builtin_amdgcn_sched_barrier(0);
            }
            float tmax = x[0];
#pragma unroll
            for (int i = 1; i < 16; ++i) tmax = fmaxf(tmax, x[i]);
            tmax = fmaxf(tmax, __shfl_xor(tmax, 32));
            if (kt == 0) m = tmax;
            else if (__any(tmax > m + 8.f)) {
                const float mn = fmaxf(m, tmax), alpha = __builtin_amdgcn_exp2f(m - mn);
                m = mn; l *= alpha;
#pragma unroll
                for (int i = 0; i < 16; ++i) {
                    const float ai = __shfl(alpha, (i & 3) + 8 * (i >> 2) + 4 * hh);
#pragma unroll
                    for (int n = 0; n < 4; ++n) o[n][i] *= ai;
                }
            }
            float ps = 0.f;
#pragma unroll
            for (int i = 0; i < 16; ++i) { x[i] = __builtin_amdgcn_exp2f(x[i] - m); ps += x[i]; }
            ps += __shfl_xor(ps, 32);
            l += ps;
#pragma unroll
            for (int n = 0; n < 4; ++n) vf[1][n] = *(LAS bf16x8*)(vb + (32 * n) * XV_ROW + 32);
            __builtin_amdgcn_sched_barrier(0);
#pragma unroll
            for (int ks = 0; ks < 2; ++ks) {
                const bf16x8 pf = pack8(x[8 * ks], x[8 * ks + 1], x[8 * ks + 2], x[8 * ks + 3], x[8 * ks + 4], x[8 * ks + 5], x[8 * ks + 6], x[8 * ks + 7]);
#pragma unroll
                for (int n = 0; n < 4; ++n) o[n] = MFMA32(pf, vf[ks][n], o[n]);
            }
            if (kt < 7) { LAS unsigned char* nb = F.lds + ((kt + 1) & 1) * XBUF; XWRITE(sa, nb); }
            __syncthreads();
        }
#undef XLOAD
#undef XWRITE
        const float linv = 1.f / l;
        CBAR();
#pragma unroll
        for (int i = 0; i < 16; ++i) {
            const int qr = (i & 3) + 8 * (i >> 2) + 4 * hh;
            const float li = __shfl(linv, qr);
#pragma unroll
            for (int n = 0; n < 4; ++n) os[qr * 136 + 32 * n + r] = (bf16)f2bf(o[n][i] * li);
        }
        CBAR();
        int lane2 = lane, wv2 = F.wave; asm volatile("" : "+v"(lane2), "+s"(wv2));
        const int q02 = qblk * 128 + 32 * (wv2 >> 1), dh2 = wv2 & 1;
#pragma unroll
        for (int i = 0; i < 8; ++i) {
            const int id = i * 64 + lane2, row = id >> 4, ch = id & 15;
            *(u32x4*)(xo + ((size_t)b * SEQ + q02 + row) * DM + h * 256 + 128 * dh2 + ch * 8) = *(LAS u32x4*)(os + row * 136 + ch * 8);
        }
        CBAR();
    }
}

__global__ void __launch_bounds__(NTHR, 2) fwd_kernel(Args args) {
    extern __shared__ __attribute__((aligned(16))) unsigned char lds_raw[];
    Frame F;
    F.lds = (LAS unsigned char*)lds_raw;
    F.tid = threadIdx.x; F.lane = F.tid & 63; F.wave = __builtin_amdgcn_readfirstlane(F.tid >> 6);
    F.G = gridDim.x; F.bid = blockIdx.x;
    F.x = (const float*)args.in[0]; F.mem = (const float*)args.in[1]; F.pos = (const int*)args.in[2];
    F.g_mix = (const float*)args.in[3]; F.w_in = (const float*)args.in[4]; F.ret_gn_g = (const float*)args.in[5];
    F.sb_q_g = (const float*)args.in[6]; F.sb_k_g = (const float*)args.in[7]; F.w_out = (const float*)args.in[8];
    F.g_xattn = (const float*)args.in[9]; F.g_mem = (const float*)args.in[10]; F.w_xq = (const float*)args.in[11];
    F.w_xkv = (const float*)args.in[12]; F.xq_g = (const float*)args.in[13]; F.xk_g = (const float*)args.in[14];
    F.w_xo = (const float*)args.in[15]; F.g_mlp = (const float*)args.in[16]; F.w_up = (const float*)args.in[17]; F.w_down = (const float*)args.in[18];
    F.out = args.out; F.ws = args.ws;
    unsigned char* ws = args.ws;
    volatile LAS unsigned* MISC = (volatile LAS unsigned*)(F.lds + MISC_OFF);
    if (F.tid < 64) MISC[F.tid] = 0u;
    __syncthreads();
    XcdBarrier bar; bar.bar = (unsigned*)(ws + WS_CTL) + 1024 + args.li * 4096; bar.x = 0; bar.st = nullptr;
    if (MK_N_LAUNCHES != NPHASE) bar = xcd_barrier_post(bar.bar, MISC + 8);
#define GRID_BAR() do { if (MK_N_LAUNCHES != NPHASE) xcd_barrier(bar); } while (0)
    const int lo = args.ph_lo, hi = args.ph_hi;
#define IN(k) (lo <= (k) && (k) < hi)
#define BOTH(k) (IN(k) && IN((k) + 1))
#define STAMP(k) STAMPF(F, k)

    bf16* Wt_in = (bf16*)(ws + WS_WIN); bf16* Wt_out = (bf16*)(ws + WS_WOUT); bf16* Wt_xq = (bf16*)(ws + WS_WXQ); bf16* Wt_xkv = (bf16*)(ws + WS_WXKV);
    bf16* Wt_xo = (bf16*)(ws + WS_WXO); bf16* Wt_up = (bf16*)(ws + WS_WUP); bf16* Wt_dn = (bf16*)(ws + WS_WDN);
    float* rinv1 = (float*)(ws + WS_RINV1); float* rinvm = (float*)(ws + WS_RINVM); float* ssq2 = (float*)(ws + WS_SSQ2); float* ssq3 = (float*)(ws + WS_SSQ3); float* ssqq = (float*)(ws + WS_SSQQ); float* ssqk = (float*)(ws + WS_SSQK);
    bf16* memb = (bf16*)(ws + WS_MEMB); bf16* memk = (bf16*)(ws + WS_MEMK); bf16* memvT = (bf16*)(ws + WS_MEMV);
    float2* cs = (float2*)(ws + WS_ROPE);
    bf16* xb = (bf16*)F.out; bf16* mix = (bf16*)(ws + WS_MIX);     bf16* proj = (bf16*)(ws + WS_PROJ);
    bf16* x1b = (bf16*)(ws + WS_X1B); bf16* xq = (bf16*)(ws + WS_XQ); bf16* xo = (bf16*)(ws + WS_XO); bf16* x2b = (bf16*)(ws + WS_X2B); bf16* hid = (bf16*)(ws + WS_HID); bf16* T = (bf16*)(ws + WS_T); bf16* KVs = (bf16*)(ws + WS_KVS);

    STAMP(0); F.tid = opaque_tid(); F.lane = F.tid & 63;
    if (IN(0)) {
#pragma nounroll
        for (int rep = 0; rep < (((PROBE_MASK >> 0) & 1) ? 2 : 1); ++rep) {
            if (rep) GRID_BAR();
            if (F.G == 256) p0_fused(F, Wt_in, Wt_out, Wt_xq, Wt_xkv, Wt_xo, Wt_up, Wt_dn, xb, rinv1, memb, rinvm, cs);
            else {
                conv_weights(F, Wt_in, Wt_out, Wt_xq, Wt_xkv, Wt_xo, Wt_up, Wt_dn);
                rows_prep(F, F.x, xb, rinv1, M);
                rows_prep(F, F.mem, memb, rinvm, MROWS);
                rope_table(F, cs);
            }
        }
        if (BOTH(0)) GRID_BAR();
    }
    STAMP(1); F.tid = opaque_tid(); F.lane = F.tid & 63;
    if (IN(1)) {
#pragma nounroll
        for (int rep = 0; rep < (((PROBE_MASK >> 1) & 1) ? 2 : 1); ++rep) {
            if (rep) GRID_BAR();
            LAS float* rtab = (LAS float*)(F.lds + 131072);
            pg8::Gemm g{xb, Wt_in, M, NIN, DM, memb, Wt_xkv}; pg8::TwoOrder S; S.init(M, NIN, MROWS, 2 * DM, F.G, F.bid);
            LAS int* ptab = (LAS int*)(F.lds + 131072 + 8192);
            LAS float* ftab = (LAS float*)(F.lds + 131072 + 16384);
            if (F.tid < 64) { const double fd = INVF[F.tid] * 0.15915494309189535; const float fhi = __uint_as_float(__float_as_uint((float)fd) & 0xffffe000u); ftab[2 * F.tid] = fhi; ftab[2 * F.tid + 1] = (float)(fd - (double)fhi); }
            { pg8::Unit uu; for (int i = 0; i < 8 && S.next(i, uu); ++i) if (F.tid < 256) { rtab[i * 256 + F.tid] = (uu.prob ? rinvm : rinv1)[uu.pm * 256 + F.tid]; ptab[i * 256 + F.tid] = uu.prob ? 0 : F.pos[uu.pm * 256 + F.tid]; }
              __syncthreads(); }
            EpiInProj E{proj, rtab, ptab, ftab, F.sb_q_g, F.sb_k_g, T, memk, memvT, ssqk};
            pg8::gemm_phase<EpiInProj, pg8::TwoOrder, true, true>(F.lds, g, S, E);
        }
        if (BOTH(1)) GRID_BAR();
    }
    STAMP(2); F.tid = opaque_tid(); F.lane = F.tid & 63;
    if (IN(2)) {
#pragma nounroll
        for (int rep = 0; rep < (((PROBE_MASK >> 2) & 1) ? 2 : 1); ++rep) {
            if (rep) GRID_BAR();
            ret_kv(F, T, KVs);
            if (rep == 0) memk_norm(F, memk, ssqk);
        }
        if (BOTH(2)) GRID_BAR();
    }
    STAMP(3); F.tid = opaque_tid(); F.lane = F.tid & 63;
    if (IN(3)) {
#pragma nounroll
        for (int rep = 0; rep < (((PROBE_MASK >> 3) & 1) ? 2 : 1); ++rep) {
            if (rep) GRID_BAR();
            if (rep == 0) ret_scan(F, KVs, 0, F.G);
            STAMPF(F, 31);
            sb_mfma(F, proj, T, mix);
        }
        if (BOTH(3)) GRID_BAR();
    }
    STAMP(4); F.tid = opaque_tid(); F.lane = F.tid & 63;
    if (IN(4)) {
#pragma nounroll
        for (int rep = 0; rep < (((PROBE_MASK >> 4) & 1) ? 2 : 1); ++rep) {
            if (rep) GRID_BAR();
            ret_out(F, proj, T, KVs, mix);
        }
        if (BOTH(4)) GRID_BAR();
    }
    STAMP(5); F.tid = opaque_tid(); F.lane = F.tid & 63;
    if (IN(5)) {
#pragma nounroll
        for (int rep = 0; rep < (((PROBE_MASK >> 5) & 1) ? 2 : 1); ++rep) {
            if (rep) GRID_BAR();
            EpiResid<true> E{xb, x1b, ssq2}; gemm_big(F, mix, Wt_out, DM, DM, E);
        }
        if (BOTH(5)) GRID_BAR();
    }
    STAMP(6); F.tid = opaque_tid(); F.lane = F.tid & 63;
    if (IN(6)) {
#pragma nounroll
        for (int rep = 0; rep < (((PROBE_MASK >> 6) & 1) ? 2 : 1); ++rep) {
            if (rep) GRID_BAR();
            { LAS float* rtab = (LAS float*)(F.lds + 131072);
              { pg8::StaticOrder S6; S6.init(M, DM, F.G, F.bid); pg8::Unit uu;
                for (int i = 0; i < 8 && S6.next(i, uu); ++i) if (F.tid < 256) rtab[i * 256 + F.tid] = rsqrtf(sum16(ssq2 + (size_t)(uu.pm * 256 + F.tid) * 16) * (1.f / DM) + EPS);
                __syncthreads(); }
              EpiXQ E{xq, rtab, ssqq}; gemm_big(F, x1b, Wt_xq, DM, DM, E); }
            asm volatile("s_waitcnt vmcnt(0)" ::: "memory");
            __syncthreads();
            STAMPF(F, 30);
            xattn_mfma(F, xq, ssqq, memk, memvT, xo);
        }
        if (BOTH(6)) GRID_BAR();
    }
    STAMP(7); F.tid = opaque_tid(); F.lane = F.tid & 63;
    STAMP(8); F.tid = opaque_tid(); F.lane = F.tid & 63;
    if (IN(8)) {
#pragma nounroll
        for (int rep = 0; rep < (((PROBE_MASK >> 8) & 1) ? 2 : 1); ++rep) {
            if (rep) GRID_BAR();
            EpiResid<true> E{x1b, x2b, ssq3}; gemm_big(F, xo, Wt_xo, DM, DM, E);
        }
        if (BOTH(8)) GRID_BAR();
    }
    STAMP(9); F.tid = opaque_tid(); F.lane = F.tid & 63;
    if (IN(9)) {
#pragma nounroll
        for (int rep = 0; rep < (((PROBE_MASK >> 9) & 1) ? 2 : 1); ++rep) {
            if (rep) GRID_BAR();
            LAS float* rtab = (LAS float*)(F.lds + 131072);
            { pg8::StaticOrder S9; S9.init(M, FF, F.G, F.bid); pg8::Unit uu;
              for (int i = 0; i < 8 && S9.next(i, uu); ++i) if (F.tid < 256) rtab[i * 256 + F.tid] = rsqrtf(sum16(ssq3 + (size_t)(uu.pm * 256 + F.tid) * 16) * (1.f / DM) + EPS);
              __syncthreads(); }
            EpiUp E{hid, rtab}; gemm_big(F, x2b, Wt_up, FF, DM, E);
        }
        if (BOTH(9)) GRID_BAR();
    }
    STAMP(10); F.tid = opaque_tid(); F.lane = F.tid & 63;
    if (IN(10)) {
#pragma nounroll
        for (int rep = 0; rep < (((PROBE_MASK >> 10) & 1) ? 2 : 1); ++rep) {
            if (rep) GRID_BAR();
            EpiDown E{x2b, F.out}; gemm_big(F, hid, Wt_dn, DM, FF, E);
        }
    }
    STAMP(11);
    if (PROBE_A >= 0 && F.bid == 0 && threadIdx.x == 0) {
        const unsigned long long t0 = ((unsigned long long)MISC[17] << 32) | MISC[16], t1 = ((unsigned long long)MISC[19] << 32) | MISC[18], d = 4ull * (t1 - t0);
        const unsigned long long w0 = __builtin_amdgcn_s_memrealtime();
        while (__builtin_amdgcn_s_memrealtime() - w0 < d) __builtin_amdgcn_s_sleep(8);
    }
#undef IN
#undef BOTH
}

extern "C" void kernel_launch(void* const* d_in, const int* in_sizes, int n_in, void* d_out, int out_size, void* d_ws, size_t ws_size, hipStream_t stream) {
    static int grid = 0;
    if (grid == 0) {
        if (n_in != 19 || in_sizes[0] != M * DM || out_size != M * DM || ws_size < WS_END) { fprintf(stderr, "kernel_launch: unexpected shapes (n_in %d, in0 %d, out %d, ws %zu); nothing launched\n", n_in, n_in > 0 ? in_sizes[0] : -1, out_size, ws_size); grid = -1; return; }
        int dev = 0, cus = 0, per_cu = 0;
        if (hipGetDevice(&dev) != hipSuccess || hipDeviceGetAttribute(&cus, hipDeviceAttributeMultiprocessorCount, dev) != hipSuccess) { grid = -1; return; }
        if (hipFuncSetAttribute((const void*)fwd_kernel, hipFuncAttributeMaxDynamicSharedMemorySize, LDS_BYTES) != hipSuccess) { fprintf(stderr, "kernel_launch: hipFuncSetAttribute failed\n"); grid = -1; return; }
        if (hipOccupancyMaxActiveBlocksPerMultiprocessor(&per_cu, (const void*)fwd_kernel, NTHR, LDS_BYTES) != hipSuccess || per_cu < 1) fprintf(stderr, "kernel_launch: occupancy query reports %d per CU\n", per_cu);
        (void)hipGetLastError();
        grid = cus;
    }
    if (grid < 0) return;
    (void)hipMemsetAsync((char*)d_ws + WS_CTL, 0, CTL_ZERO_BYTES, stream);
    Args a{};
    for (int i = 0; i < 19; ++i) a.in[i] = d_in[i];
    a.out = (float*)d_out; a.ws = (unsigned char*)d_ws;
    for (int li = 0; li < MK_N_LAUNCHES; ++li) {
        a.ph_lo = (MK_N_LAUNCHES == NPHASE) ? li : 0; a.ph_hi = (MK_N_LAUNCHES == NPHASE) ? li + 1 : NPHASE; a.li = li; a.pad = 0;
        hipLaunchKernelGGL(fwd_kernel, dim3(grid), dim3(NTHR), LDS_BYTES, stream, a);
    }
}
```
